# Optimizing an MI355X kernel written in HIP

```python
import jax, jax.numpy as jnp
from jax import lax
import numpy as np

D_MODEL = 1024
BATCH = 8
SEQ = 4096
DEPTH = 1

SGU_CHUNK = 128
SGU_GROUPS = 4
SGU_GROUP_DIM = 128
SGU_WIDTH = SGU_GROUPS * SGU_GROUP_DIM
N_HEADS = 8
HEAD_DIM = 64
ATTN_WIDTH = N_HEADS * HEAD_DIM
IDX_HEADS = 8
IDX_DIM = 64
TOPK_MAX = 256
Q_BLOCK = 128
ROPE_THETA = 10000.0
D_FF = 4 * D_MODEL
N_BRANCHES = 2
EPS = 1e-6

IN_SIZES = (SGU_WIDTH, SGU_WIDTH, ATTN_WIDTH, ATTN_WIDTH, ATTN_WIDTH,
            IDX_HEADS * IDX_DIM, IDX_DIM, IDX_HEADS, N_BRANCHES * D_MODEL)
D_IN = 2 * SGU_WIDTH + 3 * ATTN_WIDTH + IDX_HEADS * IDX_DIM + IDX_DIM + IDX_HEADS + N_BRANCHES * D_MODEL

kernel_name = "hybrid_gated_gmlp_dsa_block"


def rmsnorm(x, g):
    xf = x.astype(jnp.float32)
    y = xf * lax.rsqrt(jnp.mean(xf * xf, axis=-1, keepdims=True) + EPS)
    return (y * g.astype(jnp.float32)).astype(x.dtype)


def layernorm(x, g, b):
    xf = x.astype(jnp.float32)
    mu = jnp.mean(xf, axis=-1, keepdims=True)
    xc = xf - mu
    y = xc * lax.rsqrt(jnp.mean(xc * xc, axis=-1, keepdims=True) + EPS)
    return (y * g.astype(jnp.float32) + b.astype(jnp.float32)).astype(x.dtype)


def rope_tables(seq_len, dim, dtype):
    pos = jnp.arange(seq_len, dtype=jnp.float32)
    inv_freq = ROPE_THETA ** (-jnp.arange(0, dim, 2, dtype=jnp.float32) / dim)
    ang = pos[:, None] * inv_freq[None, :]
    return jnp.cos(ang).astype(dtype)[:, None, :], jnp.sin(ang).astype(dtype)[:, None, :]


def apply_rope(x, cos, sin):
    x1, x2 = jnp.split(x, 2, axis=-1)
    return jnp.concatenate([x1 * cos - x2 * sin, x2 * cos + x1 * sin], axis=-1)


def split_cols(t, sizes):
    out, start = [], 0
    for s in sizes:
        out.append(t[..., start:start + s])
        start += s
    return out


def sgu_mixer(u, v, w_s, b_s, ln_g, ln_b):
    B, S, _ = u.shape
    n_chunks = S // SGU_CHUNK
    v = layernorm(v, ln_g, ln_b)
    vc = v.reshape(B, n_chunks, SGU_CHUNK, SGU_GROUPS, SGU_GROUP_DIM)
    causal = jnp.tril(jnp.ones((SGU_CHUNK, SGU_CHUNK), dtype=bool))
    ws = jnp.where(causal[None], w_s, jnp.zeros((), w_s.dtype))
    s = jnp.einsum('gts,bcsgd->bctgd', ws, vc) + b_s.T[:, :, None]
    return u * s.reshape(B, S, SGU_WIDTH)


def dsa_attention(q, k, v, q_idx, k_idx, w_idx):
    B, S = q.shape[0], q.shape[1]
    topk = min(TOPK_MAX, S // 4)
    n_blocks = S // Q_BLOCK
    key_pos = jnp.arange(S)
    idx_scale = (IDX_DIM ** -0.5) * (IDX_HEADS ** -0.5)
    attn_scale = HEAD_DIM ** -0.5
    k_idx32 = k_idx.astype(jnp.float32)

    def block(i):
        start = i * Q_BLOCK
        qb = lax.dynamic_slice_in_dim(q, start, Q_BLOCK, axis=1)
        qib = lax.dynamic_slice_in_dim(q_idx, start, Q_BLOCK, axis=1)
        wib = lax.dynamic_slice_in_dim(w_idx, start, Q_BLOCK, axis=1)
        q_pos = start + jnp.arange(Q_BLOCK)
        logits = jnp.einsum('bthd,bsd->bths', qib.astype(jnp.float32), k_idx32)
        score = jnp.einsum('bth,bths->bts', wib.astype(jnp.float32) * idx_scale, jax.nn.relu(logits))
        causal = key_pos[None, :] <= q_pos[:, None]
        score = jnp.where(causal[None], score, -jnp.inf)
        _, sel = lax.top_k(score, topk)
        k_sel = jax.vmap(lambda kk, ii: kk[ii])(k, sel)
        v_sel = jax.vmap(lambda vv, ii: vv[ii])(v, sel)
        valid = sel <= q_pos[None, :, None]
        att = jnp.einsum('bthd,btkhd->bthk', qb, k_sel).astype(jnp.float32) * attn_scale
        att = jnp.where(valid[:, :, None, :], att, -jnp.inf)
        p = jax.nn.softmax(att, axis=-1).astype(v.dtype)
        return jnp.einsum('bthk,btkhd->bthd', p, v_sel)

    out = lax.map(block, jnp.arange(n_blocks))
    return out.transpose(1, 0, 2, 3, 4).reshape(B, S, ATTN_WIDTH)


def setup_inputs(seed: int = 0) -> dict:
    key = jax.random.key(seed)
    ks = jax.random.split(key, 16)
    f32 = jnp.float32
    n = lambda k, shape, scale: jax.random.normal(k, shape, f32) * scale
    return {
        "x": n(ks[0], (BATCH, SEQ, D_MODEL), 1.0),
        "norm1_g": 1.0 + n(ks[1], (DEPTH, D_MODEL), 0.02),
        "w_in": n(ks[2], (DEPTH, D_MODEL, D_IN), D_MODEL ** -0.5),
        "w_s": n(ks[3], (DEPTH, SGU_GROUPS, SGU_CHUNK, SGU_CHUNK), SGU_CHUNK ** -0.5),
        "b_s": 1.0 + n(ks[4], (DEPTH, SGU_GROUPS, SGU_CHUNK), 0.02),
        "sgu_ln_g": 1.0 + n(ks[5], (DEPTH, SGU_WIDTH), 0.02),
        "sgu_ln_b": n(ks[6], (DEPTH, SGU_WIDTH), 0.02),
        "w_out_a": n(ks[7], (DEPTH, SGU_WIDTH, D_MODEL), SGU_WIDTH ** -0.5),
        "w_out_b": n(ks[8], (DEPTH, ATTN_WIDTH, D_MODEL), ATTN_WIDTH ** -0.5),
        "w_o": n(ks[9], (DEPTH, D_MODEL, D_MODEL), D_MODEL ** -0.5),
        "norm2_g": 1.0 + n(ks[10], (DEPTH, D_MODEL), 0.02),
        "w_ff_in": n(ks[11], (DEPTH, D_MODEL, D_FF), D_MODEL ** -0.5),
        "w_ff_out": n(ks[12], (DEPTH, D_FF, D_MODEL), D_FF ** -0.5),
        "norm_f_g": 1.0 + n(ks[13], (D_MODEL,), 0.02),
    }


def reference(x, norm1_g, w_in, w_s, b_s, sgu_ln_g, sgu_ln_b, w_out_a, w_out_b, w_o,
              norm2_g, w_ff_in, w_ff_out, norm_f_g):
    B, S, _ = x.shape
    cos, sin = rope_tables(S, HEAD_DIM, x.dtype)
    for layer in range(DEPTH):
        h = rmsnorm(x, norm1_g[layer])
        proj = h @ w_in[layer]
        u, v_g, q, k, v, q_idx, k_idx, w_idx, gates = split_cols(proj, IN_SIZES)
        u = jax.nn.gelu(u)
        v_g = jax.nn.gelu(v_g)
        y_a = sgu_mixer(u, v_g, w_s[layer], b_s[layer], sgu_ln_g[layer], sgu_ln_b[layer])
        q = apply_rope(q.reshape(B, S, N_HEADS, HEAD_DIM), cos, sin)
        k = apply_rope(k.reshape(B, S, N_HEADS, HEAD_DIM), cos, sin)
        v = v.reshape(B, S, N_HEADS, HEAD_DIM)
        q_idx = apply_rope(q_idx.reshape(B, S, IDX_HEADS, IDX_DIM), cos, sin)
        k_idx = apply_rope(k_idx[:, :, None, :], cos, sin)[:, :, 0, :]
        y_b = dsa_attention(q, k, v, q_idx, k_idx, w_idx)
        g = jax.nn.sigmoid(gates.reshape(B, S, N_BRANCHES, D_MODEL))
        merged = g[:, :, 0, :] * (y_a @ w_out_a[layer]) + g[:, :, 1, :] * (y_b @ w_out_b[layer])
        x = x + merged @ w_o[layer]
        h2 = rmsnorm(x, norm2_g[layer])
        x = x + jnp.square(jax.nn.relu(h2 @ w_ff_in[layer])) @ w_ff_out[layer]
    return rmsnorm(x, norm_f_g)
```

```cpp
#include <hip/hip_runtime.h>
#include <cstdio>
#include <cstdint>

#define LAS __attribute__((address_space(3)))
typedef unsigned short bf16_t;
typedef short bf16x8 __attribute__((ext_vector_type(8)));
typedef _Float16 f16x8 __attribute__((ext_vector_type(8)));
typedef float f32x4 __attribute__((ext_vector_type(4)));
typedef float f32x2 __attribute__((ext_vector_type(2)));
typedef unsigned u32x4 __attribute__((ext_vector_type(4)));
typedef unsigned u32x2 __attribute__((ext_vector_type(2)));

constexpr int BATCH = 8, SEQ = 4096, D = 1024, M = BATCH * SEQ;
constexpr int DIN = 5192, NP = 5376;
constexpr int FF = 4096;
constexpr float EPS = 1e-6f;
constexpr float IDX_SCALE = 0.04419417382415922f;
constexpr float C2 = 0.125f * 1.4426950408889634f;
constexpr int NWAVES = 8, NT = NWAVES * 64;
constexpr int LDS_BYTES = 147456;

constexpr size_t MiB = 1u << 20;
constexpr size_t WS_CTL = 0;
constexpr size_t WS_COS = 1 * MiB;
constexpr size_t WS_SIN = WS_COS + 512 * 1024;
constexpr size_t WS_RS1 = 2 * MiB;
constexpr size_t WS_RS2 = WS_RS1 + 128 * 1024;
constexpr size_t WS_WI = 3 * MiB;
constexpr size_t WS_WSB = 4 * MiB;
constexpr size_t WS_WIN = 5 * MiB;
constexpr size_t WS_WA = 16 * MiB;
constexpr size_t WS_WB = 17 * MiB;
constexpr size_t WS_WO = 18 * MiB;
constexpr size_t WS_W1 = 20 * MiB;
constexpr size_t WS_W2 = 28 * MiB;
constexpr size_t WS_XB = 40 * MiB;
constexpr size_t WS_U = 104 * MiB;
constexpr size_t WS_VG = 136 * MiB;
constexpr size_t WS_Q = 168 * MiB;
constexpr size_t WS_K = 200 * MiB;
constexpr size_t WS_V = 232 * MiB;
constexpr size_t WS_QI = 264 * MiB;
constexpr size_t WS_KI = 296 * MiB;
constexpr size_t WS_MASK = 300 * MiB;
constexpr size_t WS_G = 316 * MiB;
constexpr size_t WS_X1B = 444 * MiB;
constexpr size_t WS_HID = 104 * MiB;
constexpr size_t WS_END = 508 * MiB;

__device__ __forceinline__ unsigned f2bf(float f) { unsigned u = __float_as_uint(f); return (u + 0x7fffu + ((u >> 16) & 1u)) >> 16; }
__device__ __forceinline__ float bf2f(unsigned b) { return __uint_as_float(b << 16); }
__device__ __forceinline__ unsigned pk2(float lo, float hi) { return f2bf(lo) | (f2bf(hi) << 16); }
__device__ __forceinline__ unsigned short f2h(float f) { _Float16 h = (_Float16)f; return __builtin_bit_cast(unsigned short, h); }
__device__ __forceinline__ float h2f(unsigned b) { return (float)__builtin_bit_cast(_Float16, (unsigned short)b); }
__device__ __forceinline__ float wave_sum(float v) {
#pragma unroll
    for (int o = 1; o < 64; o <<= 1) v += __shfl_xor(v, o);
    return v;
}
__device__ __forceinline__ unsigned wave_sum_u(unsigned v) {
#pragma unroll
    for (int o = 1; o < 64; o <<= 1) v += (unsigned)__shfl_xor((int)v, o);
    return v;
}
__device__ __forceinline__ float gelu_tanh(float x) {
    const float z = 1.5957691216057308f * (x + 0.044715f * x * x * x);
    return x / (1.0f + __builtin_amdgcn_exp2f(-1.4426950408889634f * z));
}
__device__ __forceinline__ float sigmoidf(float x) { return 1.0f / (1.0f + __builtin_amdgcn_exp2f(-1.4426950408889634f * x)); }
__device__ __forceinline__ unsigned ukey(float f) { const unsigned u = __float_as_uint(f); return (u & 0x80000000u) ? ~u : (u | 0x80000000u); }

struct Args { const float* in[14]; float* out; unsigned char* ws; int ph_lo, ph_hi; };

struct Frame {
    LAS unsigned char* lds;
    int tid, lane, wave, gw, ngw;
    const float *x, *norm1_g, *w_in, *w_s, *b_s, *ln_g, *ln_b, *w_out_a, *w_out_b, *w_o, *norm2_g, *w_ff_in, *w_ff_out, *norm_f_g;
    float* out; unsigned char* ws;
    float *COS, *SIN, *RS1, *RS2, *WI;
    bf16_t *WSB, *WIN, *WA, *WB, *WO, *W1, *W2, *XB, *U, *VG, *Q, *K, *V, *G, *X1B, *HID;
    unsigned short *QI, *KI;
    unsigned long long* MASK;
};

__device__ __forceinline__ void win_group(int n0, int& src, int& nv) {
    const int pn = n0 >> 8, p = n0 & 255;
    nv = 32;
    if (pn < 4) { src = n0; }
    else if (pn < 8 || (pn >= 10 && pn < 12)) {
        const int base = (pn < 6) ? 1024 + 256 * (pn - 4) : (pn < 8) ? 1536 + 256 * (pn - 6) : 2560 + 256 * (pn - 10);
        src = base + 64 * ((p & 127) >> 5) + 32 * (p >> 7);
    } else if (pn < 10) { src = n0; }
    else if (pn == 12) {
        if (p < 32) src = 3072; else if (p < 64) { src = 3136; nv = 8; } else if (p >= 128 && p < 160) src = 3104; else { src = 0; nv = 0; }
    } else { src = 3144 + (n0 - 3328); }
}
__device__ __forceinline__ void transpose_item(const float* W, int K, int N, int src0, int nv, const float* kscale, bf16_t* WT, int dstrow0, LAS float* scr, int k0, int lane) {
    const int c = lane & 31;
#pragma unroll 8
    for (int i = 0; i < 32; ++i) {
        const int kk = 2 * i + (lane >> 5);
        float v = (c < nv) ? W[(size_t)(k0 + kk) * N + src0 + c] : 0.f;
        if (kscale) v *= kscale[k0 + kk];
        scr[kk * 33 + c] = v;
    }
    asm volatile("s_waitcnt lgkmcnt(0)" ::: "memory");
    const int c8 = lane & 7;
#pragma unroll
    for (int j = 0; j < 4; ++j) {
        const int n = (lane >> 3) + 8 * j; const LAS float* s = scr + (8 * c8) * 33 + n;
        u32x4 o; o.x = pk2(s[0 * 33], s[1 * 33]); o.y = pk2(s[2 * 33], s[3 * 33]); o.z = pk2(s[4 * 33], s[5 * 33]); o.w = pk2(s[6 * 33], s[7 * 33]);
        *(u32x4*)(WT + (size_t)(dstrow0 + n) * K + k0 + 8 * c8) = o;
    }
    asm volatile("s_waitcnt lgkmcnt(0)" ::: "memory");
}
__device__ __forceinline__ void p0_prologue(Frame& F) {
    LAS float* scr = (LAS float*)(F.lds + F.wave * 8704);
    constexpr int I_WIN = 16 * (NP / 32), I_WA = 8 * 32, I_WB = 8 * 32, I_WO = 16 * 32, I_W1 = 16 * 128, I_W2 = 64 * 32;
    constexpr int NITEMS = I_WIN + I_WA + I_WB + I_WO + I_W1 + I_W2;
    for (int it = F.gw; it < NITEMS; it += F.ngw) {
        int r = it;
        if (r < I_WIN) { const int nb = r % (NP / 32), kb = r / (NP / 32); int src, nv; win_group(nb * 32, src, nv);
            transpose_item(F.w_in, 1024, DIN, src, nv, F.norm1_g, F.WIN, nb * 32, scr, kb * 64, F.lane); continue; } r -= I_WIN;
        if (r < I_WA) { const int nb = r % 32, kb = r / 32; transpose_item(F.w_out_a, 512, 1024, nb * 32, 32, nullptr, F.WA, nb * 32, scr, kb * 64, F.lane); continue; } r -= I_WA;
        if (r < I_WB) { const int nb = r % 32, kb = r / 32; transpose_item(F.w_out_b, 512, 1024, nb * 32, 32, nullptr, F.WB, nb * 32, scr, kb * 64, F.lane); continue; } r -= I_WB;
        if (r < I_WO) { const int nb = r % 32, kb = r / 32; transpose_item(F.w_o, 1024, 1024, nb * 32, 32, nullptr, F.WO, nb * 32, scr, kb * 64, F.lane); continue; } r -= I_WO;
        if (r < I_W1) { const int nb = r % 128, kb = r / 128; transpose_item(F.w_ff_in, 1024, 4096, nb * 32, 32, F.norm2_g, F.W1, nb * 32, scr, kb * 64, F.lane); continue; } r -= I_W1;
        { const int nb = r % 32, kb = r / 32; transpose_item(F.w_ff_out, 4096, 1024, nb * 32, 32, nullptr, F.W2, nb * 32, scr, kb * 64, F.lane); }
    }
    for (int m = F.gw; m < M; m += F.ngw) {
        const f32x4* xr = (const f32x4*)(F.x + (size_t)m * D) + F.lane;
        f32x4 v[4]; float s = 0.f;
#pragma unroll
        for (int j = 0; j < 4; ++j) { v[j] = xr[64 * j]; s += (v[j].x * v[j].x + v[j].y * v[j].y) + (v[j].z * v[j].z + v[j].w * v[j].w); }
        s = wave_sum(s);
        if (F.lane == 0) F.RS1[m] = 1.0f / sqrtf(s * (1.0f / D) + EPS);
        u32x2* o = (u32x2*)(F.XB + (size_t)m * D) + F.lane;
#pragma unroll
        for (int j = 0; j < 4; ++j) { u32x2 w; w.x = pk2(v[j].x, v[j].y); w.y = pk2(v[j].z, v[j].w); o[64 * j] = w; }
    }
    const int gt = F.gw * 64 + F.lane, ngt = F.ngw * 64;
    for (int i = gt; i < SEQ * 32; i += ngt) {
        const int pos = i >> 5, j = i & 31;
        const float inv = (float)pow(10000.0, -(double)j / 32.0);
        const float ang = (float)pos * inv;
        F.COS[i] = (float)cos((double)ang); F.SIN[i] = (float)sin((double)ang);
    }
    for (int i = gt; i < 4 * 128 * 128; i += ngt) { const int t = (i >> 7) & 127, s = i & 127; F.WSB[i] = (bf16_t)f2bf(s <= t ? F.w_s[i] : 0.f); }
}

template <class Epi>
__device__ __forceinline__ void sgemm(const bf16_t* A, const bf16_t* Bt, int Mr, int N, int K, const Epi& epi, int gw, int ngw, int lane) {
    const int c = lane & 15, q = lane >> 4;
    const int ntn = (N / 256) * 4, ntiles = (Mr / 64) * ntn;
    for (int t = gw; t < ntiles; t += ngw) {
        const int tm = t / ntn, r = t % ntn, pn = r >> 2, wc = r & 3;
        const int row0 = tm * 64, col0 = pn * 256 + wc * 32;
        f32x4 acc[4][2][2];
#pragma unroll
        for (int m = 0; m < 4; ++m)
#pragma unroll
            for (int bj = 0; bj < 2; ++bj)
#pragma unroll
                for (int n = 0; n < 2; ++n) acc[m][bj][n] = (f32x4){0.f, 0.f, 0.f, 0.f};
        const bf16_t* ap = A + (size_t)(row0 + c) * K + 8 * q;
        const bf16_t* bp = Bt + (size_t)(col0 + c) * K + 8 * q;
        for (int k0 = 0; k0 < K; k0 += 32) {
            bf16x8 a[4], b[2][2];
#pragma unroll
            for (int m = 0; m < 4; ++m) a[m] = *(const bf16x8*)(ap + (size_t)(16 * m) * K + k0);
#pragma unroll
            for (int bj = 0; bj < 2; ++bj)
#pragma unroll
                for (int n = 0; n < 2; ++n) b[bj][n] = *(const bf16x8*)(bp + (size_t)(128 * bj + 16 * n) * K + k0);
#pragma unroll
            for (int m = 0; m < 4; ++m)
#pragma unroll
                for (int bj = 0; bj < 2; ++bj)
#pragma unroll
                    for (int n = 0; n < 2; ++n) acc[m][bj][n] = __builtin_amdgcn_mfma_f32_16x16x32_bf16(a[m], b[bj][n], acc[m][bj][n], 0, 0, 0);
        }
#pragma unroll
        for (int m = 0; m < 4; ++m)
#pragma unroll
            for (int n = 0; n < 2; ++n)
#pragma unroll
                for (int i = 0; i < 4; ++i) epi(row0 + 16 * m + 4 * q + i, col0 + 16 * n + c, acc[m][0][n][i], acc[m][1][n][i]);
    }
}

struct EpiProj {
    const float *RS1, *COS, *SIN; bf16_t *U, *VG, *Q, *K, *V, *G; unsigned short *QI, *KI; float* WI;
    __device__ __forceinline__ void operator()(int row, int pcol, float a0, float a1) const {
        const float rs = RS1[row]; const float v0 = a0 * rs, v1 = a1 * rs;
        const int pn = pcol >> 8, p = pcol & 255;
        if (pn < 2) { bf16_t* o = U + (size_t)row * 512 + pn * 256 + p; o[0] = (bf16_t)f2bf(gelu_tanh(v0)); o[128] = (bf16_t)f2bf(gelu_tanh(v1)); }
        else if (pn < 4) { bf16_t* o = VG + (size_t)row * 512 + (pn - 2) * 256 + p; o[0] = (bf16_t)f2bf(gelu_tanh(v0)); o[128] = (bf16_t)f2bf(gelu_tanh(v1)); }
        else if (pn < 8 || pn == 10 || pn == 11) {
            const int pos = row & (SEQ - 1), d = p & 31, hit = p >> 5;
            const float cs = COS[pos * 32 + d], sn = SIN[pos * 32 + d];
            const float lo = v0 * cs - v1 * sn, hi = v1 * cs + v0 * sn;
            if (pn < 6) { bf16_t* o = Q + (size_t)row * 512 + (pn - 4) * 256 + hit * 64 + d; o[0] = (bf16_t)f2bf(lo * C2); o[32] = (bf16_t)f2bf(hi * C2); }
            else if (pn < 8) { bf16_t* o = K + (size_t)row * 512 + (pn - 6) * 256 + hit * 64 + d; o[0] = (bf16_t)f2bf(lo); o[32] = (bf16_t)f2bf(hi); }
            else { unsigned short* o = QI + (size_t)row * 512 + (pn - 10) * 256 + hit * 64 + d; o[0] = f2h(lo); o[32] = f2h(hi); }
        }
        else if (pn < 10) { bf16_t* o = V + (size_t)row * 512 + (pn - 8) * 256 + p; o[0] = (bf16_t)f2bf(v0); o[128] = (bf16_t)f2bf(v1); }
        else if (pn == 12) {
            if (p < 32) { const int pos = row & (SEQ - 1); const float cs = COS[pos * 32 + p], sn = SIN[pos * 32 + p];
                unsigned short* o = KI + (size_t)row * 64 + p; o[0] = f2h(v0 * cs - v1 * sn); o[32] = f2h(v1 * cs + v0 * sn); }
            else if (p < 40) { WI[(size_t)row * 8 + (p - 32)] = v0 * IDX_SCALE; }
        }
        else { bf16_t* o = G + (size_t)row * 2048 + (pn - 13) * 256 + p; o[0] = (bf16_t)f2bf(sigmoidf(v0)); o[128] = (bf16_t)f2bf(sigmoidf(v1)); }
    }
};
struct EpiMergeA { const bf16_t* G; bf16_t* MG;
    __device__ __forceinline__ void operator()(int row, int col, float a0, float a1) const {
        const bf16_t* g = G + (size_t)row * 2048 + col; bf16_t* o = MG + (size_t)row * 1024 + col;
        o[0] = (bf16_t)f2bf(bf2f(g[0]) * a0); o[128] = (bf16_t)f2bf(bf2f(g[128]) * a1); } };
struct EpiMergeB { const bf16_t* G; bf16_t* MG;
    __device__ __forceinline__ void operator()(int row, int col, float a0, float a1) const {
        const bf16_t* g = G + (size_t)row * 2048 + 1024 + col; bf16_t* o = MG + (size_t)row * 1024 + col;
        o[0] = (bf16_t)f2bf(bf2f(o[0]) + bf2f(g[0]) * a0); o[128] = (bf16_t)f2bf(bf2f(o[128]) + bf2f(g[128]) * a1); } };
struct EpiWo { const float* x; float* X1; bf16_t* X1B;
    __device__ __forceinline__ void operator()(int row, int col, float a0, float a1) const {
        const size_t o = (size_t)row * 1024 + col; const float r0 = x[o] + a0, r1 = x[o + 128] + a1;
        X1[o] = r0; X1[o + 128] = r1; X1B[o] = (bf16_t)f2bf(r0); X1B[o + 128] = (bf16_t)f2bf(r1); } };
struct EpiFF1 { const float* RS2; bf16_t* H;
    __device__ __forceinline__ void operator()(int row, int col, float a0, float a1) const {
        const float rs = RS2[row]; const float h0 = fmaxf(a0 * rs, 0.f), h1 = fmaxf(a1 * rs, 0.f);
        bf16_t* o = H + (size_t)row * 4096 + col; o[0] = (bf16_t)f2bf(h0 * h0); o[128] = (bf16_t)f2bf(h1 * h1); } };
struct EpiFF2 { float* X;
    __device__ __forceinline__ void operator()(int row, int col, float a0, float a1) const {
        const size_t o = (size_t)row * 1024 + col; X[o] += a0; X[o + 128] += a1; } };

__device__ __forceinline__ void sgu_simple(Frame& F) {
    LAS float* vs = (LAS float*)F.lds;
    LAS bf16_t* wsl = (LAS bf16_t*)(F.lds + 65536);
    LAS float* st = (LAS float*)(F.lds + 65536 + 32768);
    for (int bc = blockIdx.x; bc < M / 128; bc += gridDim.x) {
        const int row0 = bc * 128;
        for (int i = 0; i < 16; ++i) {
            const int r = F.wave * 16 + i;
            const u32x4 w = *(const u32x4*)(F.VG + (size_t)(row0 + r) * 512 + F.lane * 8);
            float v[8]; v[0] = bf2f(w.x & 0xffff); v[1] = bf2f(w.x >> 16); v[2] = bf2f(w.y & 0xffff); v[3] = bf2f(w.y >> 16);
            v[4] = bf2f(w.z & 0xffff); v[5] = bf2f(w.z >> 16); v[6] = bf2f(w.w & 0xffff); v[7] = bf2f(w.w >> 16);
            float s = 0.f;
#pragma unroll
            for (int j = 0; j < 8; ++j) s += v[j];
            const float mean = wave_sum(s) * (1.f / 512.f); float q = 0.f;
#pragma unroll
            for (int j = 0; j < 8; ++j) { const float d = v[j] - mean; q += d * d; }
            const float rstd = 1.0f / sqrtf(wave_sum(q) * (1.f / 512.f) + EPS);
            if (F.lane == 0) { st[2 * r] = mean; st[2 * r + 1] = rstd; }
        }
        __syncthreads();
        for (int g = 0; g < 4; ++g) {
            for (int idx = F.tid; idx < 16384; idx += NT) {
                const int s = idx >> 7, d = idx & 127;
                const float v = bf2f(F.VG[(size_t)(row0 + s) * 512 + g * 128 + d]);
                vs[idx] = (v - st[2 * s]) * st[2 * s + 1] * F.ln_g[g * 128 + d] + F.ln_b[g * 128 + d];
                wsl[idx] = F.WSB[g * 16384 + idx];
            }
            __syncthreads();
            for (int idx = F.tid; idx < 16384; idx += NT) {
                const int t = idx >> 7, d = idx & 127; float acc = 0.f;
                for (int s = 0; s <= t; ++s) acc += bf2f(wsl[t * 128 + s]) * vs[s * 128 + d];
                const float sf = acc + F.b_s[g * 128 + t];
                bf16_t* u = F.U + (size_t)(row0 + t) * 512 + g * 128 + d;
                *u = (bf16_t)f2bf(bf2f(*u) * sf);
            }
            __syncthreads();
        }
    }
}

__device__ __forceinline__ void indexer_simple(Frame& F) {
    LAS float* sc = (LAS float*)F.lds;
    LAS float* qf = (LAS float*)(F.lds + 16384);
    LAS float* wl = (LAS float*)(F.lds + 16384 + 2048);
    LAS unsigned* cnt = (LAS unsigned*)(F.lds + 16384 + 2048 + 64);
    LAS unsigned* eqc = (LAS unsigned*)(F.lds + 20480);
    for (int r = blockIdx.x; r < M; r += gridDim.x) {
        const int t = r & (SEQ - 1), b = r >> 12;
        unsigned char* mrow = (unsigned char*)(F.MASK + ((size_t)(b * 64 + (F.tid >> 3)) * SEQ + t)) + (F.tid & 7);
        if (t < 255) {
            unsigned m = 0;
#pragma unroll
            for (int i = 0; i < 8; ++i) m |= ((8 * F.tid + i) <= t) ? (1u << i) : 0u;
            *mrow = (unsigned char)m;
            continue;
        }
        qf[F.tid] = h2f(F.QI[(size_t)r * 512 + F.tid]);
        if (F.tid < 8) wl[F.tid] = F.WI[(size_t)r * 8 + F.tid];
        if (F.tid == 0) { cnt[0] = 0; cnt[1] = 0; }
        __syncthreads();
        for (int s = F.tid; s < SEQ; s += NT) {
            float score = 0.f;
            if (s <= t) {
                const unsigned short* kp = F.KI + (size_t)(b * SEQ + s) * 64;
                float kf[64];
#pragma unroll
                for (int j = 0; j < 8; ++j) { const u32x4 w = *(const u32x4*)(kp + 8 * j);
                    kf[8 * j + 0] = h2f(w.x & 0xffff); kf[8 * j + 1] = h2f(w.x >> 16); kf[8 * j + 2] = h2f(w.y & 0xffff); kf[8 * j + 3] = h2f(w.y >> 16);
                    kf[8 * j + 4] = h2f(w.z & 0xffff); kf[8 * j + 5] = h2f(w.z >> 16); kf[8 * j + 6] = h2f(w.w & 0xffff); kf[8 * j + 7] = h2f(w.w >> 16); }
#pragma unroll 1
                for (int h = 0; h < 8; ++h) {
                    float dot = 0.f;
#pragma unroll
                    for (int d = 0; d < 64; ++d) dot += qf[h * 64 + d] * kf[d];
                    score += wl[h] * fmaxf(dot, 0.f);
                }
            }
            sc[s] = score;
        }
        __syncthreads();
        unsigned key[8];
#pragma unroll
        for (int i = 0; i < 8; ++i) { const int s = 8 * F.tid + i; key[i] = (s <= t) ? ukey(sc[s]) : 0u; }
        unsigned lo = 1u, hi = 0xFFFFFFFFu; int it = 0;
        while (hi - lo > 1u) {
            const unsigned mid = lo + ((hi - lo) >> 1);
            unsigned c = 0;
#pragma unroll
            for (int i = 0; i < 8; ++i) c += (key[i] >= mid) ? 1u : 0u;
            c = wave_sum_u(c);
            __syncthreads();
            if (F.tid == 0) cnt[(it + 1) & 1] = 0;
            if (F.lane == 0) atomicAdd((unsigned*)&cnt[it & 1], c);
            __syncthreads();
            const unsigned tot = cnt[it & 1];
            if (tot >= 256u) lo = mid; else hi = mid;
            ++it;
        }
        const unsigned T = lo;
        unsigned cgt = 0, ceq = 0;
#pragma unroll
        for (int i = 0; i < 8; ++i) { cgt += (key[i] > T) ? 1u : 0u; ceq += (key[i] == T) ? 1u : 0u; }
        eqc[F.tid] = ceq;
        const unsigned cg = wave_sum_u(cgt);
        __syncthreads();
        if (F.tid == 0) cnt[(it + 1) & 1] = 0;
        if (F.lane == 0) atomicAdd((unsigned*)&cnt[it & 1], cg);
        __syncthreads();
        const unsigned need = 256u - cnt[it & 1];
        unsigned before = 0;
        for (int j = 0; j < F.tid; ++j) before += eqc[j];
        unsigned m = 0;
#pragma unroll
        for (int i = 0; i < 8; ++i) {
            bool sel = key[i] > T;
            if (key[i] == T) { sel = before < need; ++before; }
            m |= sel ? (1u << i) : 0u;
        }
        *mrow = (unsigned char)m;
        __syncthreads();
    }
}

__device__ __forceinline__ void attn_simple(Frame& F) {
    for (int task = F.gw; task < M * 8; task += F.ngw) {
        const int row = task >> 3, h = task & 7, t = row & (SEQ - 1), b = row >> 12;
        const float q = bf2f(F.Q[(size_t)row * 512 + h * 64 + F.lane]);
        float m = -INFINITY, l = 0.f, acc = 0.f;
        for (int tile = 0; tile <= (t >> 6); ++tile) {
            unsigned long long w = F.MASK[(size_t)(b * 64 + tile) * SEQ + t];
            w = (unsigned long long)(unsigned)__builtin_amdgcn_readfirstlane((unsigned)w) | ((unsigned long long)(unsigned)__builtin_amdgcn_readfirstlane((unsigned)(w >> 32)) << 32);
            while (w) {
                const int i = __builtin_ctzll(w); w &= w - 1;
                const size_t kr = (size_t)(b * SEQ + tile * 64 + i) * 512 + h * 64 + F.lane;
                const float logit = wave_sum(q * bf2f(F.K[kr]));
                const float mn = fmaxf(m, logit), scl = __builtin_amdgcn_exp2f(m - mn), pe = __builtin_amdgcn_exp2f(logit - mn);
                l = l * scl + pe; acc = acc * scl + pe * bf2f(F.V[kr]); m = mn;
            }
        }
        F.Q[(size_t)row * 512 + h * 64 + F.lane] = (bf16_t)f2bf(acc / l);
    }
}

__device__ __forceinline__ void rs2_rows(Frame& F) {
    for (int m = F.gw; m < M; m += F.ngw) {
        const f32x4* xr = (const f32x4*)(F.out + (size_t)m * D) + F.lane; float s = 0.f;
#pragma unroll
        for (int j = 0; j < 4; ++j) { const f32x4 v = xr[64 * j]; s += (v.x * v.x + v.y * v.y) + (v.z * v.z + v.w * v.w); }
        s = wave_sum(s);
        if (F.lane == 0) F.RS2[m] = 1.0f / sqrtf(s * (1.0f / D) + EPS);
    }
}
__device__ __forceinline__ void final_norm(Frame& F) {
    for (int m = F.gw; m < M; m += F.ngw) {
        f32x4* xr = (f32x4*)(F.out + (size_t)m * D) + F.lane; f32x4 v[4]; float s = 0.f;
#pragma unroll
        for (int j = 0; j < 4; ++j) { v[j] = xr[64 * j]; s += (v[j].x * v[j].x + v[j].y * v[j].y) + (v[j].z * v[j].z + v[j].w * v[j].w); }
        const float rs = 1.0f / sqrtf(wave_sum(s) * (1.0f / D) + EPS);
#pragma unroll
        for (int j = 0; j < 4; ++j) { const f32x4 g = *((const f32x4*)F.norm_f_g + F.lane + 64 * j); xr[64 * j] = v[j] * rs * g; }
    }
}

__global__ void __launch_bounds__(NT, 2) fwd_kernel(Args args) {
    extern __shared__ __attribute__((aligned(16))) unsigned char lds[];
    Frame F;
    F.lds = (LAS unsigned char*)lds;
    F.tid = threadIdx.x; F.lane = F.tid & 63; F.wave = __builtin_amdgcn_readfirstlane(F.tid >> 6);
    F.gw = blockIdx.x * NWAVES + F.wave; F.ngw = gridDim.x * NWAVES;
    F.x = args.in[0]; F.norm1_g = args.in[1]; F.w_in = args.in[2]; F.w_s = args.in[3]; F.b_s = args.in[4]; F.ln_g = args.in[5]; F.ln_b = args.in[6];
    F.w_out_a = args.in[7]; F.w_out_b = args.in[8]; F.w_o = args.in[9]; F.norm2_g = args.in[10]; F.w_ff_in = args.in[11]; F.w_ff_out = args.in[12]; F.norm_f_g = args.in[13];
    F.out = args.out; F.ws = args.ws;
    unsigned char* ws = args.ws;
    F.COS = (float*)(ws + WS_COS); F.SIN = (float*)(ws + WS_SIN); F.RS1 = (float*)(ws + WS_RS1); F.RS2 = (float*)(ws + WS_RS2); F.WI = (float*)(ws + WS_WI);
    F.WSB = (bf16_t*)(ws + WS_WSB); F.WIN = (bf16_t*)(ws + WS_WIN); F.WA = (bf16_t*)(ws + WS_WA); F.WB = (bf16_t*)(ws + WS_WB); F.WO = (bf16_t*)(ws + WS_WO);
    F.W1 = (bf16_t*)(ws + WS_W1); F.W2 = (bf16_t*)(ws + WS_W2); F.XB = (bf16_t*)(ws + WS_XB); F.U = (bf16_t*)(ws + WS_U); F.VG = (bf16_t*)(ws + WS_VG);
    F.Q = (bf16_t*)(ws + WS_Q); F.K = (bf16_t*)(ws + WS_K); F.V = (bf16_t*)(ws + WS_V); F.G = (bf16_t*)(ws + WS_G); F.X1B = (bf16_t*)(ws + WS_X1B); F.HID = (bf16_t*)(ws + WS_HID);
    F.QI = (unsigned short*)(ws + WS_QI); F.KI = (unsigned short*)(ws + WS_KI); F.MASK = (unsigned long long*)(ws + WS_MASK);
    const int lo = args.ph_lo, hi = args.ph_hi;
#define IN(k) (lo <= (k) && (k) < hi)
    if (IN(0)) p0_prologue(F);
    if (IN(1)) { EpiProj E{F.RS1, F.COS, F.SIN, F.U, F.VG, F.Q, F.K, F.V, F.G, F.QI, F.KI, F.WI}; sgemm(F.XB, F.WIN, M, NP, 1024, E, F.gw, F.ngw, F.lane); }
    if (IN(2)) { sgu_simple(F); __syncthreads(); indexer_simple(F); }
    if (IN(3)) attn_simple(F);
    if (IN(4)) { EpiMergeA E{F.G, F.XB}; sgemm(F.U, F.WA, M, 1024, 512, E, F.gw, F.ngw, F.lane); }
    if (IN(5)) { EpiMergeB E{F.G, F.XB}; sgemm(F.Q, F.WB, M, 1024, 512, E, F.gw, F.ngw, F.lane); }
    if (IN(6)) { EpiWo E{F.x, F.out, F.X1B}; sgemm(F.XB, F.WO, M, 1024, 1024, E, F.gw, F.ngw, F.lane); }
    if (IN(7)) rs2_rows(F);
    if (IN(8)) { EpiFF1 E{F.RS2, F.HID}; sgemm(F.X1B, F.W1, M, 4096, 1024, E, F.gw, F.ngw, F.lane); }
    if (IN(9)) { EpiFF2 E{F.out}; sgemm(F.HID, F.W2, M, 1024, 4096, E, F.gw, F.ngw, F.lane); }
    if (IN(10)) final_norm(F);
#undef IN
}

extern "C" void kernel_launch(void* const* d_in, const int* in_sizes, int n_in, void* d_out, int out_size, void* d_ws, size_t ws_size, hipStream_t stream) {
    static int grid = 0;
    if (grid == 0) {
        if (n_in != 14 || out_size != M * D || ws_size < WS_END) { fprintf(stderr, "kernel_launch: unexpected shapes (n_in %d out %d ws %zu)\n", n_in, out_size, ws_size); grid = -1; return; }
        int dev = 0, cus = 0, per_cu = 0;
        hipGetDevice(&dev); hipDeviceGetAttribute(&cus, hipDeviceAttributeMultiprocessorCount, dev);
        hipFuncSetAttribute((const void*)fwd_kernel, hipFuncAttributeMaxDynamicSharedMemorySize, LDS_BYTES);
        hipOccupancyMaxActiveBlocksPerMultiprocessor(&per_cu, (const void*)fwd_kernel, NT, LDS_BYTES);
        if (per_cu < 1) { fprintf(stderr, "kernel_launch: occupancy query says %d blocks per CU\n", per_cu); per_cu = 1; }
        (void)hipGetLastError();
        grid = cus;
    }
    if (grid < 0) return;
    Args a{};
    for (int i = 0; i < 14; ++i) a.in[i] = (const float*)d_in[i];
    a.out = (float*)d_out; a.ws = (unsigned char*)d_ws;
    for (int ph = 0; ph <= 10; ++ph) {
        a.ph_lo = ph; a.ph_hi = ph + 1;
        hipLaunchKernelGGL(fwd_kernel, dim3(grid), dim3(NT), LDS_BYTES, stream, a);
    }
}
```

```cpp
#include <hip/hip_runtime.h>
#include <hip/hip_cooperative_groups.h>
#include <cstdio>
#include <cstdint>

namespace cg = cooperative_groups;
#ifndef ONE_LAUNCH
#define ONE_LAUNCH 1
#endif
#define LAS __attribute__((address_space(3)))
typedef unsigned short bf16_t;
typedef short bf16x8 __attribute__((ext_vector_type(8)));
typedef _Float16 f16x8 __attribute__((ext_vector_type(8)));
typedef float f32x4 __attribute__((ext_vector_type(4)));
typedef float f32x2 __attribute__((ext_vector_type(2)));
typedef unsigned u32x4 __attribute__((ext_vector_type(4)));
typedef unsigned u32x2 __attribute__((ext_vector_type(2)));

constexpr int BATCH = 8, SEQ = 4096, D = 1024, M = BATCH * SEQ;
constexpr int DIN = 5192, NP = 5376;
constexpr int FF = 4096;
constexpr float EPS = 1e-6f;
constexpr float IDX_SCALE = 0.04419417382415922f;
constexpr float C2 = 0.125f * 1.4426950408889634f;
constexpr int NWAVES = 8, NT = NWAVES * 64;
constexpr int LDS_BYTES = 147456;

constexpr size_t MiB = 1u << 20;
constexpr size_t WS_CTL = 0;
constexpr size_t WS_COS = 1 * MiB;
constexpr size_t WS_SIN = WS_COS + 512 * 1024;
constexpr size_t WS_RS1 = 2 * MiB;
constexpr size_t WS_RS2 = WS_RS1 + 128 * 1024;
constexpr size_t WS_WI = 3 * MiB;
constexpr size_t WS_WSB = 4 * MiB;
constexpr size_t WS_WIN = 5 * MiB;
constexpr size_t WS_WA = 16 * MiB;
constexpr size_t WS_WB = 17 * MiB;
constexpr size_t WS_WO = 18 * MiB;
constexpr size_t WS_W1 = 20 * MiB;
constexpr size_t WS_W2 = 28 * MiB;
constexpr size_t WS_XB = 40 * MiB;
constexpr size_t WS_U = 104 * MiB;
constexpr size_t WS_VG = 136 * MiB;
constexpr size_t WS_Q = 168 * MiB;
constexpr size_t WS_K = 200 * MiB;
constexpr size_t WS_V = 232 * MiB;
constexpr size_t WS_QI = 264 * MiB;
constexpr size_t WS_KI = 296 * MiB;
constexpr size_t WS_MASK = 300 * MiB;
constexpr size_t WS_G = 316 * MiB;
constexpr size_t WS_X1B = 444 * MiB;
constexpr size_t WS_HID = 104 * MiB;
constexpr size_t WS_END = 508 * MiB;

__device__ __forceinline__ unsigned f2bf(float f) { unsigned u = __float_as_uint(f); return (u + 0x7fffu + ((u >> 16) & 1u)) >> 16; }
__device__ __forceinline__ float bf2f(unsigned b) { return __uint_as_float(b << 16); }
__device__ __forceinline__ unsigned pk2(float lo, float hi) { return f2bf(lo) | (f2bf(hi) << 16); }
__device__ __forceinline__ unsigned short f2h(float f) { _Float16 h = (_Float16)f; return __builtin_bit_cast(unsigned short, h); }
__device__ __forceinline__ float h2f(unsigned b) { return (float)__builtin_bit_cast(_Float16, (unsigned short)b); }
__device__ __forceinline__ float wave_sum(float v) {
#pragma unroll
    for (int o = 1; o < 64; o <<= 1) v += __shfl_xor(v, o);
    return v;
}
__device__ __forceinline__ unsigned wave_sum_u(unsigned v) {
#pragma unroll
    for (int o = 1; o < 64; o <<= 1) v += (unsigned)__shfl_xor((int)v, o);
    return v;
}
__device__ __forceinline__ float gelu_tanh(float x) {
    const float z = 1.5957691216057308f * (x + 0.044715f * x * x * x);
    return x / (1.0f + __builtin_amdgcn_exp2f(-1.4426950408889634f * z));
}
__device__ __forceinline__ float sigmoidf(float x) { return 1.0f / (1.0f + __builtin_amdgcn_exp2f(-1.4426950408889634f * x)); }
__device__ __forceinline__ unsigned ukey(float f) { const unsigned u = __float_as_uint(f); return (u & 0x80000000u) ? ~u : (u | 0x80000000u); }

struct Args { const float* in[14]; float* out; unsigned char* ws; int ph_lo, ph_hi; };

struct Frame {
    LAS unsigned char* lds;
    int tid, lane, wave, gw, ngw;
    const float *x, *norm1_g, *w_in, *w_s, *b_s, *ln_g, *ln_b, *w_out_a, *w_out_b, *w_o, *norm2_g, *w_ff_in, *w_ff_out, *norm_f_g;
    float* out; unsigned char* ws;
    float *COS, *SIN, *RS1, *RS2, *WI;
    bf16_t *WSB, *WIN, *WA, *WB, *WO, *W1, *W2, *XB, *U, *VG, *Q, *K, *V, *G, *X1B, *HID;
    unsigned short *QI, *KI;
    unsigned long long* MASK;
};

__device__ __forceinline__ void win_group(int n0, int& src, int& nv) {
    const int pn = n0 >> 8, p = n0 & 255;
    nv = 32;
    if (pn < 4) { src = n0; }
    else if (pn < 8 || (pn >= 10 && pn < 12)) {
        const int base = (pn < 6) ? 1024 + 256 * (pn - 4) : (pn < 8) ? 1536 + 256 * (pn - 6) : 2560 + 256 * (pn - 10);
        src = base + 64 * ((p & 127) >> 5) + 32 * (p >> 7);
    } else if (pn < 10) { src = n0; }
    else if (pn == 12) {
        if (p < 32) src = 3072; else if (p < 64) { src = 3136; nv = 8; } else if (p >= 128 && p < 160) src = 3104; else { src = 0; nv = 0; }
    } else { src = 3144 + (n0 - 3328); }
}
__device__ __forceinline__ void transpose_item(const float* W, int K, int N, int src0, int nv, const float* kscale, bf16_t* WT, int dstrow0, LAS float* scr, int k0, int lane) {
    const int c = lane & 31;
#pragma unroll 8
    for (int i = 0; i < 32; ++i) {
        const int kk = 2 * i + (lane >> 5);
        float v = (c < nv) ? W[(size_t)(k0 + kk) * N + src0 + c] : 0.f;
        if (kscale) v *= kscale[k0 + kk];
        scr[kk * 33 + c] = v;
    }
    asm volatile("s_waitcnt lgkmcnt(0)" ::: "memory");
    const int c8 = lane & 7;
#pragma unroll
    for (int j = 0; j < 4; ++j) {
        const int n = (lane >> 3) + 8 * j; const LAS float* s = scr + (8 * c8) * 33 + n;
        u32x4 o; o.x = pk2(s[0 * 33], s[1 * 33]); o.y = pk2(s[2 * 33], s[3 * 33]); o.z = pk2(s[4 * 33], s[5 * 33]); o.w = pk2(s[6 * 33], s[7 * 33]);
        *(u32x4*)(WT + (size_t)(dstrow0 + n) * K + k0 + 8 * c8) = o;
    }
    asm volatile("s_waitcnt lgkmcnt(0)" ::: "memory");
}
__device__ __forceinline__ void p0_prologue(Frame& F) {
    LAS float* scr = (LAS float*)(F.lds + F.wave * 8704);
    constexpr int I_WIN = 16 * (NP / 32), I_WA = 8 * 32, I_WB = 8 * 32, I_WO = 16 * 32, I_W1 = 16 * 128, I_W2 = 64 * 32;
    constexpr int NITEMS = I_WIN + I_WA + I_WB + I_WO + I_W1 + I_W2;
    for (int it = F.gw; it < NITEMS; it += F.ngw) {
        int r = it;
        if (r < I_WIN) { const int nb = r % (NP / 32), kb = r / (NP / 32); int src, nv; win_group(nb * 32, src, nv);
            transpose_item(F.w_in, 1024, DIN, src, nv, F.norm1_g, F.WIN, nb * 32, scr, kb * 64, F.lane); continue; } r -= I_WIN;
        if (r < I_WA) { const int nb = r % 32, kb = r / 32; transpose_item(F.w_out_a, 512, 1024, nb * 32, 32, nullptr, F.WA, nb * 32, scr, kb * 64, F.lane); continue; } r -= I_WA;
        if (r < I_WB) { const int nb = r % 32, kb = r / 32; transpose_item(F.w_out_b, 512, 1024, nb * 32, 32, nullptr, F.WB, nb * 32, scr, kb * 64, F.lane); continue; } r -= I_WB;
        if (r < I_WO) { const int nb = r % 32, kb = r / 32; transpose_item(F.w_o, 1024, 1024, nb * 32, 32, nullptr, F.WO, nb * 32, scr, kb * 64, F.lane); continue; } r -= I_WO;
        if (r < I_W1) { const int nb = r % 128, kb = r / 128; transpose_item(F.w_ff_in, 1024, 4096, nb * 32, 32, F.norm2_g, F.W1, nb * 32, scr, kb * 64, F.lane); continue; } r -= I_W1;
        { const int nb = r % 32, kb = r / 32; transpose_item(F.w_ff_out, 4096, 1024, nb * 32, 32, nullptr, F.W2, nb * 32, scr, kb * 64, F.lane); }
    }
    for (int m = F.gw; m < M; m += F.ngw) {
        const f32x4* xr = (const f32x4*)(F.x + (size_t)m * D) + F.lane;
        f32x4 v[4]; float s = 0.f;
#pragma unroll
        for (int j = 0; j < 4; ++j) { v[j] = xr[64 * j]; s += (v[j].x * v[j].x + v[j].y * v[j].y) + (v[j].z * v[j].z + v[j].w * v[j].w); }
        s = wave_sum(s);
        if (F.lane == 0) F.RS1[m] = 1.0f / sqrtf(s * (1.0f / D) + EPS);
        u32x2* o = (u32x2*)(F.XB + (size_t)m * D) + F.lane;
#pragma unroll
        for (int j = 0; j < 4; ++j) { u32x2 w; w.x = pk2(v[j].x, v[j].y); w.y = pk2(v[j].z, v[j].w); o[64 * j] = w; }
    }
    const int gt = F.gw * 64 + F.lane, ngt = F.ngw * 64;
    for (int i = gt; i < SEQ * 32; i += ngt) {
        const int pos = i >> 5, j = i & 31;
        const float inv = (float)pow(10000.0, -(double)j / 32.0);
        const float ang = (float)pos * inv;
        F.COS[i] = (float)cos((double)ang); F.SIN[i] = (float)sin((double)ang);
    }
    for (int i = gt; i < 4 * 128 * 128; i += ngt) { const int t = (i >> 7) & 127, s = i & 127; F.WSB[i] = (bf16_t)f2bf(s <= t ? F.w_s[i] : 0.f); }
}

template <class Epi>
__device__ __forceinline__ void sgemm(const bf16_t* A, const bf16_t* Bt, int Mr, int N, int K, const Epi& epi, int gw, int ngw, int lane) {
    const int c = lane & 15, q = lane >> 4;
    const int ntn = (N / 256) * 4, ntiles = (Mr / 64) * ntn;
    for (int t = gw; t < ntiles; t += ngw) {
        const int tm = t / ntn, r = t % ntn, pn = r >> 2, wc = r & 3;
        const int row0 = tm * 64, col0 = pn * 256 + wc * 32;
        f32x4 acc[4][2][2];
#pragma unroll
        for (int m = 0; m < 4; ++m)
#pragma unroll
            for (int bj = 0; bj < 2; ++bj)
#pragma unroll
                for (int n = 0; n < 2; ++n) acc[m][bj][n] = (f32x4){0.f, 0.f, 0.f, 0.f};
        const bf16_t* ap = A + (size_t)(row0 + c) * K + 8 * q;
        const bf16_t* bp = Bt + (size_t)(col0 + c) * K + 8 * q;
        for (int k0 = 0; k0 < K; k0 += 32) {
            bf16x8 a[4], b[2][2];
#pragma unroll
            for (int m = 0; m < 4; ++m) a[m] = *(const bf16x8*)(ap + (size_t)(16 * m) * K + k0);
#pragma unroll
            for (int bj = 0; bj < 2; ++bj)
#pragma unroll
                for (int n = 0; n < 2; ++n) b[bj][n] = *(const bf16x8*)(bp + (size_t)(128 * bj + 16 * n) * K + k0);
#pragma unroll
            for (int m = 0; m < 4; ++m)
#pragma unroll
                for (int bj = 0; bj < 2; ++bj)
#pragma unroll
                    for (int n = 0; n < 2; ++n) acc[m][bj][n] = __builtin_amdgcn_mfma_f32_16x16x32_bf16(a[m], b[bj][n], acc[m][bj][n], 0, 0, 0);
        }
#pragma unroll
        for (int m = 0; m < 4; ++m)
#pragma unroll
            for (int n = 0; n < 2; ++n)
#pragma unroll
                for (int i = 0; i < 4; ++i) epi(row0 + 16 * m + 4 * q + i, col0 + 16 * n + c, acc[m][0][n][i], acc[m][1][n][i]);
    }
}

struct EpiProj {
    const float *RS1, *COS, *SIN; bf16_t *U, *VG, *Q, *K, *V, *G; unsigned short *QI, *KI; float* WI;
    __device__ __forceinline__ void operator()(int row, int pcol, float a0, float a1) const {
        const float rs = RS1[row]; const float v0 = a0 * rs, v1 = a1 * rs;
        const int pn = pcol >> 8, p = pcol & 255;
        if (pn < 2) { bf16_t* o = U + (size_t)row * 512 + pn * 256 + p; o[0] = (bf16_t)f2bf(gelu_tanh(v0)); o[128] = (bf16_t)f2bf(gelu_tanh(v1)); }
        else if (pn < 4) { bf16_t* o = VG + (size_t)row * 512 + (pn - 2) * 256 + p; o[0] = (bf16_t)f2bf(gelu_tanh(v0)); o[128] = (bf16_t)f2bf(gelu_tanh(v1)); }
        else if (pn < 8 || pn == 10 || pn == 11) {
            const int pos = row & (SEQ - 1), d = p & 31, hit = p >> 5;
            const float cs = COS[pos * 32 + d], sn = SIN[pos * 32 + d];
            const float lo = v0 * cs - v1 * sn, hi = v1 * cs + v0 * sn;
            if (pn < 6) { bf16_t* o = Q + (size_t)row * 512 + (pn - 4) * 256 + hit * 64 + d; o[0] = (bf16_t)f2bf(lo * C2); o[32] = (bf16_t)f2bf(hi * C2); }
            else if (pn < 8) { bf16_t* o = K + (size_t)row * 512 + (pn - 6) * 256 + hit * 64 + d; o[0] = (bf16_t)f2bf(lo); o[32] = (bf16_t)f2bf(hi); }
            else { unsigned short* o = QI + (size_t)row * 512 + (pn - 10) * 256 + hit * 64 + d; o[0] = f2h(lo); o[32] = f2h(hi); }
        }
        else if (pn < 10) { bf16_t* o = V + (size_t)row * 512 + (pn - 8) * 256 + p; o[0] = (bf16_t)f2bf(v0); o[128] = (bf16_t)f2bf(v1); }
        else if (pn == 12) {
            if (p < 32) { const int pos = row & (SEQ - 1); const float cs = COS[pos * 32 + p], sn = SIN[pos * 32 + p];
                unsigned short* o = KI + (size_t)row * 64 + p; o[0] = f2h(v0 * cs - v1 * sn); o[32] = f2h(v1 * cs + v0 * sn); }
            else if (p < 40) { WI[(size_t)row * 8 + (p - 32)] = v0 * IDX_SCALE; }
        }
        else { bf16_t* o = G + (size_t)row * 2048 + (pn - 13) * 256 + p; o[0] = (bf16_t)f2bf(sigmoidf(v0)); o[128] = (bf16_t)f2bf(sigmoidf(v1)); }
    }
};
struct EpiMergeA { const bf16_t* G; bf16_t* MG;
    __device__ __forceinline__ void operator()(int row, int col, float a0, float a1) const {
        const bf16_t* g = G + (size_t)row * 2048 + col; bf16_t* o = MG + (size_t)row * 1024 + col;
        o[0] = (bf16_t)f2bf(bf2f(g[0]) * a0); o[128] = (bf16_t)f2bf(bf2f(g[128]) * a1); } };
struct EpiMergeB { const bf16_t* G; bf16_t* MG;
    __device__ __forceinline__ void operator()(int row, int col, float a0, float a1) const {
        const bf16_t* g = G + (size_t)row * 2048 + 1024 + col; bf16_t* o = MG + (size_t)row * 1024 + col;
        o[0] = (bf16_t)f2bf(bf2f(o[0]) + bf2f(g[0]) * a0); o[128] = (bf16_t)f2bf(bf2f(o[128]) + bf2f(g[128]) * a1); } };
struct EpiWo { const float* x; float* X1; bf16_t* X1B;
    __device__ __forceinline__ void operator()(int row, int col, float a0, float a1) const {
        const size_t o = (size_t)row * 1024 + col; const float r0 = x[o] + a0, r1 = x[o + 128] + a1;
        X1[o] = r0; X1[o + 128] = r1; X1B[o] = (bf16_t)f2bf(r0); X1B[o + 128] = (bf16_t)f2bf(r1); } };
struct EpiFF1 { const float* RS2; bf16_t* H;
    __device__ __forceinline__ void operator()(int row, int col, float a0, float a1) const {
        const float rs = RS2[row]; const float h0 = fmaxf(a0 * rs, 0.f), h1 = fmaxf(a1 * rs, 0.f);
        bf16_t* o = H + (size_t)row * 4096 + col; o[0] = (bf16_t)f2bf(h0 * h0); o[128] = (bf16_t)f2bf(h1 * h1); } };
struct EpiFF2 { float* X;
    __device__ __forceinline__ void operator()(int row, int col, float a0, float a1) const {
        const size_t o = (size_t)row * 1024 + col; X[o] += a0; X[o + 128] += a1; } };

__device__ __forceinline__ void sgu_simple(Frame& F) {
    LAS float* vs = (LAS float*)F.lds;
    LAS bf16_t* wsl = (LAS bf16_t*)(F.lds + 65536);
    LAS float* st = (LAS float*)(F.lds + 65536 + 32768);
    for (int bc = blockIdx.x; bc < M / 128; bc += gridDim.x) {
        const int row0 = bc * 128;
        for (int i = 0; i < 16; ++i) {
            const int r = F.wave * 16 + i;
            const u32x4 w = *(const u32x4*)(F.VG + (size_t)(row0 + r) * 512 + F.lane * 8);
            float v[8]; v[0] = bf2f(w.x & 0xffff); v[1] = bf2f(w.x >> 16); v[2] = bf2f(w.y & 0xffff); v[3] = bf2f(w.y >> 16);
            v[4] = bf2f(w.z & 0xffff); v[5] = bf2f(w.z >> 16); v[6] = bf2f(w.w & 0xffff); v[7] = bf2f(w.w >> 16);
            float s = 0.f;
#pragma unroll
            for (int j = 0; j < 8; ++j) s += v[j];
            const float mean = wave_sum(s) * (1.f / 512.f); float q = 0.f;
#pragma unroll
            for (int j = 0; j < 8; ++j) { const float d = v[j] - mean; q += d * d; }
            const float rstd = 1.0f / sqrtf(wave_sum(q) * (1.f / 512.f) + EPS);
            if (F.lane == 0) { st[2 * r] = mean; st[2 * r + 1] = rstd; }
        }
        __syncthreads();
        for (int g = 0; g < 4; ++g) {
            for (int idx = F.tid; idx < 16384; idx += NT) {
                const int s = idx >> 7, d = idx & 127;
                const float v = bf2f(F.VG[(size_t)(row0 + s) * 512 + g * 128 + d]);
                vs[idx] = (v - st[2 * s]) * st[2 * s + 1] * F.ln_g[g * 128 + d] + F.ln_b[g * 128 + d];
                wsl[idx] = F.WSB[g * 16384 + idx];
            }
            __syncthreads();
            for (int idx = F.tid; idx < 16384; idx += NT) {
                const int t = idx >> 7, d = idx & 127; float acc = 0.f;
                for (int s = 0; s <= t; ++s) acc += bf2f(wsl[t * 128 + s]) * vs[s * 128 + d];
                const float sf = acc + F.b_s[g * 128 + t];
                bf16_t* u = F.U + (size_t)(row0 + t) * 512 + g * 128 + d;
                *u = (bf16_t)f2bf(bf2f(*u) * sf);
            }
            __syncthreads();
        }
    }
}

__device__ __forceinline__ void indexer_simple(Frame& F) {
    LAS float* sc = (LAS float*)F.lds;
    LAS float* qf = (LAS float*)(F.lds + 16384);
    LAS float* wl = (LAS float*)(F.lds + 16384 + 2048);
    LAS unsigned* cnt = (LAS unsigned*)(F.lds + 16384 + 2048 + 64);
    LAS unsigned* eqc = (LAS unsigned*)(F.lds + 20480);
    for (int r = blockIdx.x; r < M; r += gridDim.x) {
        const int t = r & (SEQ - 1), b = r >> 12;
        unsigned char* mrow = (unsigned char*)(F.MASK + ((size_t)(b * 64 + (F.tid >> 3)) * SEQ + t)) + (F.tid & 7);
        if (t < 255) {
            unsigned m = 0;
#pragma unroll
            for (int i = 0; i < 8; ++i) m |= ((8 * F.tid + i) <= t) ? (1u << i) : 0u;
            *mrow = (unsigned char)m;
            continue;
        }
        qf[F.tid] = h2f(F.QI[(size_t)r * 512 + F.tid]);
        if (F.tid < 8) wl[F.tid] = F.WI[(size_t)r * 8 + F.tid];
        if (F.tid == 0) { cnt[0] = 0; cnt[1] = 0; }
        __syncthreads();
        for (int s = F.tid; s < SEQ; s += NT) {
            float score = 0.f;
            if (s <= t) {
                const unsigned short* kp = F.KI + (size_t)(b * SEQ + s) * 64;
                float kf[64];
#pragma unroll
                for (int j = 0; j < 8; ++j) { const u32x4 w = *(const u32x4*)(kp + 8 * j);
                    kf[8 * j + 0] = h2f(w.x & 0xffff); kf[8 * j + 1] = h2f(w.x >> 16); kf[8 * j + 2] = h2f(w.y & 0xffff); kf[8 * j + 3] = h2f(w.y >> 16);
                    kf[8 * j + 4] = h2f(w.z & 0xffff); kf[8 * j + 5] = h2f(w.z >> 16); kf[8 * j + 6] = h2f(w.w & 0xffff); kf[8 * j + 7] = h2f(w.w >> 16); }
#pragma unroll 1
                for (int h = 0; h < 8; ++h) {
                    float dot = 0.f;
#pragma unroll
                    for (int d = 0; d < 64; ++d) dot += qf[h * 64 + d] * kf[d];
                    score += wl[h] * fmaxf(dot, 0.f);
                }
            }
            sc[s] = score;
        }
        __syncthreads();
        unsigned key[8];
#pragma unroll
        for (int i = 0; i < 8; ++i) { const int s = 8 * F.tid + i; key[i] = (s <= t) ? ukey(sc[s]) : 0u; }
        unsigned lo = 1u, hi = 0xFFFFFFFFu; int it = 0;
        while (hi - lo > 1u) {
            const unsigned mid = lo + ((hi - lo) >> 1);
            unsigned c = 0;
#pragma unroll
            for (int i = 0; i < 8; ++i) c += (key[i] >= mid) ? 1u : 0u;
            c = wave_sum_u(c);
            __syncthreads();
            if (F.tid == 0) cnt[(it + 1) & 1] = 0;
            if (F.lane == 0) atomicAdd((unsigned*)&cnt[it & 1], c);
            __syncthreads();
            const unsigned tot = cnt[it & 1];
            if (tot >= 256u) lo = mid; else hi = mid;
            ++it;
        }
        const unsigned T = lo;
        unsigned cgt = 0, ceq = 0;
#pragma unroll
        for (int i = 0; i < 8; ++i) { cgt += (key[i] > T) ? 1u : 0u; ceq += (key[i] == T) ? 1u : 0u; }
        eqc[F.tid] = ceq;
        const unsigned cg = wave_sum_u(cgt);
        __syncthreads();
        if (F.tid == 0) cnt[(it + 1) & 1] = 0;
        if (F.lane == 0) atomicAdd((unsigned*)&cnt[it & 1], cg);
        __syncthreads();
        const unsigned need = 256u - cnt[it & 1];
        unsigned before = 0;
        for (int j = 0; j < F.tid; ++j) before += eqc[j];
        unsigned m = 0;
#pragma unroll
        for (int i = 0; i < 8; ++i) {
            bool sel = key[i] > T;
            if (key[i] == T) { sel = before < need; ++before; }
            m |= sel ? (1u << i) : 0u;
        }
        *mrow = (unsigned char)m;
        __syncthreads();
    }
}

__device__ __forceinline__ void attn_simple(Frame& F) {
    for (int task = F.gw; task < M * 8; task += F.ngw) {
        const int row = task >> 3, h = task & 7, t = row & (SEQ - 1), b = row >> 12;
        const float q = bf2f(F.Q[(size_t)row * 512 + h * 64 + F.lane]);
        float m = -INFINITY, l = 0.f, acc = 0.f;
        for (int tile = 0; tile <= (t >> 6); ++tile) {
            unsigned long long w = F.MASK[(size_t)(b * 64 + tile) * SEQ + t];
            w = (unsigned long long)(unsigned)__builtin_amdgcn_readfirstlane((unsigned)w) | ((unsigned long long)(unsigned)__builtin_amdgcn_readfirstlane((unsigned)(w >> 32)) << 32);
            while (w) {
                const int i = __builtin_ctzll(w); w &= w - 1;
                const size_t kr = (size_t)(b * SEQ + tile * 64 + i) * 512 + h * 64 + F.lane;
                const float logit = wave_sum(q * bf2f(F.K[kr]));
                const float mn = fmaxf(m, logit), scl = __builtin_amdgcn_exp2f(m - mn), pe = __builtin_amdgcn_exp2f(logit - mn);
                l = l * scl + pe; acc = acc * scl + pe * bf2f(F.V[kr]); m = mn;
            }
        }
        F.Q[(size_t)row * 512 + h * 64 + F.lane] = (bf16_t)f2bf(acc / l);
    }
}

__device__ __forceinline__ void rs2_rows(Frame& F) {
    for (int m = F.gw; m < M; m += F.ngw) {
        const f32x4* xr = (const f32x4*)(F.out + (size_t)m * D) + F.lane; float s = 0.f;
#pragma unroll
        for (int j = 0; j < 4; ++j) { const f32x4 v = xr[64 * j]; s += (v.x * v.x + v.y * v.y) + (v.z * v.z + v.w * v.w); }
        s = wave_sum(s);
        if (F.lane == 0) F.RS2[m] = 1.0f / sqrtf(s * (1.0f / D) + EPS);
    }
}
__device__ __forceinline__ void final_norm(Frame& F) {
    for (int m = F.gw; m < M; m += F.ngw) {
        f32x4* xr = (f32x4*)(F.out + (size_t)m * D) + F.lane; f32x4 v[4]; float s = 0.f;
#pragma unroll
        for (int j = 0; j < 4; ++j) { v[j] = xr[64 * j]; s += (v[j].x * v[j].x + v[j].y * v[j].y) + (v[j].z * v[j].z + v[j].w * v[j].w); }
        const float rs = 1.0f / sqrtf(wave_sum(s) * (1.0f / D) + EPS);
#pragma unroll
        for (int j = 0; j < 4; ++j) { const f32x4 g = *((const f32x4*)F.norm_f_g + F.lane + 64 * j); xr[64 * j] = v[j] * rs * g; }
    }
}

__global__ void __launch_bounds__(NT, 2) fwd_kernel(Args args) {
    extern __shared__ __attribute__((aligned(16))) unsigned char lds[];
    Frame F;
    F.lds = (LAS unsigned char*)lds;
    F.tid = threadIdx.x; F.lane = F.tid & 63; F.wave = __builtin_amdgcn_readfirstlane(F.tid >> 6);
    F.gw = blockIdx.x * NWAVES + F.wave; F.ngw = gridDim.x * NWAVES;
    F.x = args.in[0]; F.norm1_g = args.in[1]; F.w_in = args.in[2]; F.w_s = args.in[3]; F.b_s = args.in[4]; F.ln_g = args.in[5]; F.ln_b = args.in[6];
    F.w_out_a = args.in[7]; F.w_out_b = args.in[8]; F.w_o = args.in[9]; F.norm2_g = args.in[10]; F.w_ff_in = args.in[11]; F.w_ff_out = args.in[12]; F.norm_f_g = args.in[13];
    F.out = args.out; F.ws = args.ws;
    unsigned char* ws = args.ws;
    F.COS = (float*)(ws + WS_COS); F.SIN = (float*)(ws + WS_SIN); F.RS1 = (float*)(ws + WS_RS1); F.RS2 = (float*)(ws + WS_RS2); F.WI = (float*)(ws + WS_WI);
    F.WSB = (bf16_t*)(ws + WS_WSB); F.WIN = (bf16_t*)(ws + WS_WIN); F.WA = (bf16_t*)(ws + WS_WA); F.WB = (bf16_t*)(ws + WS_WB); F.WO = (bf16_t*)(ws + WS_WO);
    F.W1 = (bf16_t*)(ws + WS_W1); F.W2 = (bf16_t*)(ws + WS_W2); F.XB = (bf16_t*)(ws + WS_XB); F.U = (bf16_t*)(ws + WS_U); F.VG = (bf16_t*)(ws + WS_VG);
    F.Q = (bf16_t*)(ws + WS_Q); F.K = (bf16_t*)(ws + WS_K); F.V = (bf16_t*)(ws + WS_V); F.G = (bf16_t*)(ws + WS_G); F.X1B = (bf16_t*)(ws + WS_X1B); F.HID = (bf16_t*)(ws + WS_HID);
    F.QI = (unsigned short*)(ws + WS_QI); F.KI = (unsigned short*)(ws + WS_KI); F.MASK = (unsigned long long*)(ws + WS_MASK);
    const int lo = args.ph_lo, hi = args.ph_hi;
#define IN(k) (lo <= (k) && (k) < hi)
#define SEAM(k) do { if (IN(k) && IN((k) + 1)) { __threadfence(); cg::this_grid().sync(); } } while (0)
    if (IN(0)) p0_prologue(F);
    SEAM(0);
    if (IN(1)) { EpiProj E{F.RS1, F.COS, F.SIN, F.U, F.VG, F.Q, F.K, F.V, F.G, F.QI, F.KI, F.WI}; sgemm(F.XB, F.WIN, M, NP, 1024, E, F.gw, F.ngw, F.lane); }
    SEAM(1);
    if (IN(2)) { sgu_simple(F); __syncthreads(); indexer_simple(F); }
    SEAM(2);
    if (IN(3)) attn_simple(F);
    SEAM(3);
    if (IN(4)) { EpiMergeA E{F.G, F.XB}; sgemm(F.U, F.WA, M, 1024, 512, E, F.gw, F.ngw, F.lane); }
    SEAM(4);
    if (IN(5)) { EpiMergeB E{F.G, F.XB}; sgemm(F.Q, F.WB, M, 1024, 512, E, F.gw, F.ngw, F.lane); }
    SEAM(5);
    if (IN(6)) { EpiWo E{F.x, F.out, F.X1B}; sgemm(F.XB, F.WO, M, 1024, 1024, E, F.gw, F.ngw, F.lane); }
    SEAM(6);
    if (IN(7)) rs2_rows(F);
    SEAM(7);
    if (IN(8)) { EpiFF1 E{F.RS2, F.HID}; sgemm(F.X1B, F.W1, M, 4096, 1024, E, F.gw, F.ngw, F.lane); }
    SEAM(8);
    if (IN(9)) { EpiFF2 E{F.out}; sgemm(F.HID, F.W2, M, 1024, 4096, E, F.gw, F.ngw, F.lane); }
    SEAM(9);
    if (IN(10)) final_norm(F);
#undef SEAM
#undef IN
}

extern "C" void kernel_launch(void* const* d_in, const int* in_sizes, int n_in, void* d_out, int out_size, void* d_ws, size_t ws_size, hipStream_t stream) {
    static int grid = 0;
    if (grid == 0) {
        if (n_in != 14 || out_size != M * D || ws_size < WS_END) { fprintf(stderr, "kernel_launch: unexpected shapes (n_in %d out %d ws %zu)\n", n_in, out_size, ws_size); grid = -1; return; }
        int dev = 0, cus = 0, per_cu = 0;
        hipGetDevice(&dev); hipDeviceGetAttribute(&cus, hipDeviceAttributeMultiprocessorCount, dev);
        hipFuncSetAttribute((const void*)fwd_kernel, hipFuncAttributeMaxDynamicSharedMemorySize, LDS_BYTES);
        hipOccupancyMaxActiveBlocksPerMultiprocessor(&per_cu, (const void*)fwd_kernel, NT, LDS_BYTES);
        if (per_cu < 1) { fprintf(stderr, "kernel_launch: occupancy query says %d blocks per CU\n", per_cu); per_cu = 1; }
        (void)hipGetLastError();
        grid = cus * (per_cu < 1 ? 1 : 1);
    }
    if (grid < 0) return;
    Args a{};
    for (int i = 0; i < 14; ++i) a.in[i] = (const float*)d_in[i];
    a.out = (float*)d_out; a.ws = (unsigned char*)d_ws;
#if ONE_LAUNCH
    a.ph_lo = 0; a.ph_hi = 11;
    void* kargs[] = {&a};
    hipError_t e = hipLaunchCooperativeKernel((const void*)fwd_kernel, dim3(grid), dim3(NT), kargs, LDS_BYTES, stream);
    if (e != hipSuccess) fprintf(stderr, "cooperative launch failed: %s (grid %d)\n", hipGetErrorString(e), grid);
#else
    for (int ph = 0; ph <= 10; ++ph) {
        a.ph_lo = ph; a.ph_hi = ph + 1;
        hipLaunchKernelGGL(fwd_kernel, dim3(grid), dim3(NT), LDS_BYTES, stream, a);
    }
#endif
}
```

```cpp
#include <hip/hip_runtime.h>
#include <hip/hip_cooperative_groups.h>
#include <cstdio>
#include <cstdint>

namespace cg = cooperative_groups;
#ifndef ONE_LAUNCH
#define ONE_LAUNCH 1
#endif
#ifndef FAST_G1
#define FAST_G1 1
#endif
#ifndef FAST_ATTN
#define FAST_ATTN 1
#endif
#ifndef FAST_SGU
#define FAST_SGU 1
#endif
#ifndef FAST_IDX
#define FAST_IDX 1
#endif
#ifndef FAST_MERGE
#define FAST_MERGE 1
#endif
#ifndef FAST_WO
#define FAST_WO 1
#endif
#ifndef FAST_FF1
#define FAST_FF1 1
#endif
#ifndef FAST_FF2
#define FAST_FF2 1
#endif
#define LAS __attribute__((address_space(3)))
typedef unsigned short bf16_t;
typedef short bf16x8 __attribute__((ext_vector_type(8)));
typedef _Float16 f16x8 __attribute__((ext_vector_type(8)));
typedef float f32x4 __attribute__((ext_vector_type(4)));
typedef float f32x2 __attribute__((ext_vector_type(2)));
typedef unsigned u32x4 __attribute__((ext_vector_type(4)));
typedef unsigned u32x2 __attribute__((ext_vector_type(2)));

constexpr int BATCH = 8, SEQ = 4096, D = 1024, M = BATCH * SEQ;
constexpr int DIN = 5192, NP = 5376;
constexpr int FF = 4096;
constexpr float EPS = 1e-6f;
constexpr float IDX_SCALE = 0.04419417382415922f;
constexpr float C2 = 0.125f * 1.4426950408889634f;
constexpr int NWAVES = 8, NT = NWAVES * 64;
constexpr int LDS_BYTES = 147456;

constexpr size_t MiB = 1u << 20;
constexpr size_t WS_CTL = 0;
constexpr size_t WS_COS = 1 * MiB;
constexpr size_t WS_SIN = WS_COS + 512 * 1024;
constexpr size_t WS_RS1 = 2 * MiB;
constexpr size_t WS_RS2 = WS_RS1 + 128 * 1024;
constexpr size_t WS_WI = 3 * MiB;
constexpr size_t WS_WSB = 4 * MiB;
constexpr size_t WS_WIN = 5 * MiB;
constexpr size_t WS_WA = 16 * MiB;
constexpr size_t WS_WB = 17 * MiB;
constexpr size_t WS_WO = 18 * MiB;
constexpr size_t WS_W1 = 20 * MiB;
constexpr size_t WS_W2 = 28 * MiB;
constexpr size_t WS_SS2 = 36 * MiB;
constexpr size_t WS_XB = 40 * MiB;
constexpr size_t WS_U = 104 * MiB;
constexpr size_t WS_VG = 136 * MiB;
constexpr size_t WS_Q = 168 * MiB;
constexpr size_t WS_K = 200 * MiB;
constexpr size_t WS_V = 232 * MiB;
constexpr size_t WS_QI = 264 * MiB;
constexpr size_t WS_KI = 296 * MiB;
constexpr size_t WS_MASK = 300 * MiB;
constexpr size_t WS_G = 316 * MiB;
constexpr size_t WS_X1B = 444 * MiB;
constexpr size_t WS_HID = 104 * MiB;
constexpr size_t WS_END = 508 * MiB;

__device__ __forceinline__ unsigned f2bf(float f) { unsigned u = __float_as_uint(f); return (u + 0x7fffu + ((u >> 16) & 1u)) >> 16; }
__device__ __forceinline__ float bf2f(unsigned b) { return __uint_as_float(b << 16); }
__device__ __forceinline__ unsigned pk2(float lo, float hi) { return f2bf(lo) | (f2bf(hi) << 16); }
__device__ __forceinline__ unsigned short f2h(float f) { _Float16 h = (_Float16)f; return __builtin_bit_cast(unsigned short, h); }
__device__ __forceinline__ float h2f(unsigned b) { return (float)__builtin_bit_cast(_Float16, (unsigned short)b); }
__device__ __forceinline__ float wave_sum(float v) {
#pragma unroll
    for (int o = 1; o < 64; o <<= 1) v += __shfl_xor(v, o);
    return v;
}
__device__ __forceinline__ unsigned wave_sum_u(unsigned v) {
#pragma unroll
    for (int o = 1; o < 64; o <<= 1) v += (unsigned)__shfl_xor((int)v, o);
    return v;
}
__device__ __forceinline__ float gelu_tanh(float x) {
    const float z = 1.5957691216057308f * (x + 0.044715f * x * x * x);
    return x / (1.0f + __builtin_amdgcn_exp2f(-1.4426950408889634f * z));
}
__device__ __forceinline__ float sigmoidf(float x) { return 1.0f / (1.0f + __builtin_amdgcn_exp2f(-1.4426950408889634f * x)); }
__device__ __forceinline__ unsigned ukey(float f) { const unsigned u = __float_as_uint(f); return (u & 0x80000000u) ? ~u : (u | 0x80000000u); }

struct Args { const float* in[14]; float* out; unsigned char* ws; int ph_lo, ph_hi; };

struct Frame {
    LAS unsigned char* lds;
    int tid, lane, wave, gw, ngw;
    const float *x, *norm1_g, *w_in, *w_s, *b_s, *ln_g, *ln_b, *w_out_a, *w_out_b, *w_o, *norm2_g, *w_ff_in, *w_ff_out, *norm_f_g;
    float* out; unsigned char* ws;
    float *COS, *SIN, *RS1, *RS2, *WI, *SS2;
    bf16_t *WSB, *WIN, *WA, *WB, *WO, *W1, *W2, *XB, *U, *VG, *Q, *K, *V, *G, *X1B, *HID;
    unsigned short *QI, *KI;
    unsigned long long* MASK;
};

__device__ __forceinline__ void win_group(int n0, int& src, int& nv) {
    const int pn = n0 >> 8, p = n0 & 255;
    nv = 32;
    if (pn < 4) { src = n0; }
    else if (pn < 8 || (pn >= 10 && pn < 12)) {
        const int base = (pn < 6) ? 1024 + 256 * (pn - 4) : (pn < 8) ? 1536 + 256 * (pn - 6) : 2560 + 256 * (pn - 10);
        src = base + 64 * ((p & 127) >> 5) + 32 * (p >> 7);
    } else if (pn < 10) { src = n0; }
    else if (pn == 12) {
        if (p < 32) src = 3072; else if (p < 64) { src = 3136; nv = 8; } else if (p >= 128 && p < 160) src = 3104; else { src = 0; nv = 0; }
    } else { src = 3144 + (n0 - 3328); }
}
__device__ __forceinline__ void transpose_item(const float* W, int K, int N, int src0, int nv, const float* kscale, bf16_t* WT, int dstrow0, LAS float* scr, int k0, int lane) {
    const int c = lane & 31;
#pragma unroll 8
    for (int i = 0; i < 32; ++i) {
        const int kk = 2 * i + (lane >> 5);
        float v = (c < nv) ? W[(size_t)(k0 + kk) * N + src0 + c] : 0.f;
        if (kscale) v *= kscale[k0 + kk];
        scr[kk * 33 + c] = v;
    }
    asm volatile("s_waitcnt lgkmcnt(0)" ::: "memory");
    const int c8 = lane & 7;
#pragma unroll
    for (int j = 0; j < 4; ++j) {
        const int n = (lane >> 3) + 8 * j; const LAS float* s = scr + (8 * c8) * 33 + n;
        u32x4 o; o.x = pk2(s[0 * 33], s[1 * 33]); o.y = pk2(s[2 * 33], s[3 * 33]); o.z = pk2(s[4 * 33], s[5 * 33]); o.w = pk2(s[6 * 33], s[7 * 33]);
        *(u32x4*)(WT + (size_t)(dstrow0 + n) * K + k0 + 8 * c8) = o;
    }
    asm volatile("s_waitcnt lgkmcnt(0)" ::: "memory");
}
__device__ __forceinline__ void p0_prologue(Frame& F) {
    LAS float* scr = (LAS float*)(F.lds + F.wave * 8704);
    constexpr int I_WIN = 16 * (NP / 32), I_WA = 8 * 32, I_WB = 8 * 32, I_WO = 16 * 32, I_W1 = 16 * 128, I_W2 = 64 * 32;
    constexpr int NITEMS = I_WIN + I_WA + I_WB + I_WO + I_W1 + I_W2;
    for (int it = F.gw; it < NITEMS; it += F.ngw) {
        int r = it;
        if (r < I_WIN) { const int nb = r % (NP / 32), kb = r / (NP / 32); int src, nv; win_group(nb * 32, src, nv);
            transpose_item(F.w_in, 1024, DIN, src, nv, F.norm1_g, F.WIN, nb * 32, scr, kb * 64, F.lane); continue; } r -= I_WIN;
        if (r < I_WA) { const int nb = r % 32, kb = r / 32; transpose_item(F.w_out_a, 512, 1024, nb * 32, 32, nullptr, F.WA, nb * 32, scr, kb * 64, F.lane); continue; } r -= I_WA;
        if (r < I_WB) { const int nb = r % 32, kb = r / 32; transpose_item(F.w_out_b, 512, 1024, nb * 32, 32, nullptr, F.WB, nb * 32, scr, kb * 64, F.lane); continue; } r -= I_WB;
        if (r < I_WO) { const int nb = r % 32, kb = r / 32; transpose_item(F.w_o, 1024, 1024, nb * 32, 32, nullptr, F.WO, nb * 32, scr, kb * 64, F.lane); continue; } r -= I_WO;
        if (r < I_W1) { const int nb = r % 128, kb = r / 128; transpose_item(F.w_ff_in, 1024, 4096, nb * 32, 32, F.norm2_g, F.W1, nb * 32, scr, kb * 64, F.lane); continue; } r -= I_W1;
        { const int nb = r % 32, kb = r / 32; transpose_item(F.w_ff_out, 4096, 1024, nb * 32, 32, nullptr, F.W2, nb * 32, scr, kb * 64, F.lane); }
    }
    for (int m = F.gw; m < M; m += F.ngw) {
        const f32x4* xr = (const f32x4*)(F.x + (size_t)m * D) + F.lane;
        f32x4 v[4]; float s = 0.f;
#pragma unroll
        for (int j = 0; j < 4; ++j) { v[j] = xr[64 * j]; s += (v[j].x * v[j].x + v[j].y * v[j].y) + (v[j].z * v[j].z + v[j].w * v[j].w); }
        s = wave_sum(s);
        if (F.lane == 0) F.RS1[m] = 1.0f / sqrtf(s * (1.0f / D) + EPS);
        u32x2* o = (u32x2*)(F.XB + (size_t)m * D) + F.lane;
#pragma unroll
        for (int j = 0; j < 4; ++j) { u32x2 w; w.x = pk2(v[j].x, v[j].y); w.y = pk2(v[j].z, v[j].w); o[64 * j] = w; }
    }
    const int gt = F.gw * 64 + F.lane, ngt = F.ngw * 64;
    for (int i = gt; i < SEQ * 32; i += ngt) {
        const int pos = i >> 5, j = i & 31;
        const float inv = (float)pow(10000.0, -(double)j / 32.0);
        const float ang = (float)pos * inv;
        F.COS[i] = (float)cos((double)ang); F.SIN[i] = (float)sin((double)ang);
    }
    for (int i = gt; i < 4 * 128 * 128; i += ngt) { const int t = (i >> 7) & 127, s = i & 127; F.WSB[i] = (bf16_t)f2bf(s <= t ? F.w_s[i] : 0.f); }
}

template <class Epi>
__device__ __forceinline__ void sgemm(const bf16_t* A, const bf16_t* Bt, int Mr, int N, int K, const Epi& epi, int gw, int ngw, int lane) {
    const int c = lane & 15, q = lane >> 4;
    const int ntn = (N / 256) * 4, ntiles = (Mr / 64) * ntn;
    for (int t = gw; t < ntiles; t += ngw) {
        const int tm = t / ntn, r = t % ntn, pn = r >> 2, wc = r & 3;
        const int row0 = tm * 64, col0 = pn * 256 + wc * 32;
        f32x4 acc[4][2][2];
#pragma unroll
        for (int m = 0; m < 4; ++m)
#pragma unroll
            for (int bj = 0; bj < 2; ++bj)
#pragma unroll
                for (int n = 0; n < 2; ++n) acc[m][bj][n] = (f32x4){0.f, 0.f, 0.f, 0.f};
        const bf16_t* ap = A + (size_t)(row0 + c) * K + 8 * q;
        const bf16_t* bp = Bt + (size_t)(col0 + c) * K + 8 * q;
        for (int k0 = 0; k0 < K; k0 += 32) {
            bf16x8 a[4], b[2][2];
#pragma unroll
            for (int m = 0; m < 4; ++m) a[m] = *(const bf16x8*)(ap + (size_t)(16 * m) * K + k0);
#pragma unroll
            for (int bj = 0; bj < 2; ++bj)
#pragma unroll
                for (int n = 0; n < 2; ++n) b[bj][n] = *(const bf16x8*)(bp + (size_t)(128 * bj + 16 * n) * K + k0);
#pragma unroll
            for (int m = 0; m < 4; ++m)
#pragma unroll
                for (int bj = 0; bj < 2; ++bj)
#pragma unroll
                    for (int n = 0; n < 2; ++n) acc[m][bj][n] = __builtin_amdgcn_mfma_f32_16x16x32_bf16(a[m], b[bj][n], acc[m][bj][n], 0, 0, 0);
        }
#pragma unroll
        for (int m = 0; m < 4; ++m)
#pragma unroll
            for (int n = 0; n < 2; ++n)
#pragma unroll
                for (int i = 0; i < 4; ++i) epi(row0 + 16 * m + 4 * q + i, col0 + 16 * n + c, acc[m][0][n][i], acc[m][1][n][i]);
    }
}

struct EpiProj {
    const float *RS1, *COS, *SIN; bf16_t *U, *VG, *Q, *K, *V, *G; unsigned short *QI, *KI; float* WI;
    __device__ __forceinline__ void operator()(int row, int pcol, float a0, float a1) const {
        const float rs = RS1[row]; const float v0 = a0 * rs, v1 = a1 * rs;
        const int pn = pcol >> 8, p = pcol & 255;
        if (pn < 2) { bf16_t* o = U + (size_t)row * 512 + pn * 256 + p; o[0] = (bf16_t)f2bf(gelu_tanh(v0)); o[128] = (bf16_t)f2bf(gelu_tanh(v1)); }
        else if (pn < 4) { bf16_t* o = VG + (size_t)row * 512 + (pn - 2) * 256 + p; o[0] = (bf16_t)f2bf(gelu_tanh(v0)); o[128] = (bf16_t)f2bf(gelu_tanh(v1)); }
        else if (pn < 8 || pn == 10 || pn == 11) {
            const int pos = row & (SEQ - 1), d = p & 31, hit = p >> 5;
            const float cs = COS[pos * 32 + d], sn = SIN[pos * 32 + d];
            const float lo = v0 * cs - v1 * sn, hi = v1 * cs + v0 * sn;
            if (pn < 6) { bf16_t* o = Q + (size_t)row * 512 + (pn - 4) * 256 + hit * 64 + d; o[0] = (bf16_t)f2bf(lo * C2); o[32] = (bf16_t)f2bf(hi * C2); }
            else if (pn < 8) { bf16_t* o = K + (size_t)row * 512 + (pn - 6) * 256 + hit * 64 + d; o[0] = (bf16_t)f2bf(lo); o[32] = (bf16_t)f2bf(hi); }
            else { unsigned short* o = QI + (size_t)row * 512 + (pn - 10) * 256 + hit * 64 + d; o[0] = f2h(lo); o[32] = f2h(hi); }
        }
        else if (pn < 10) { bf16_t* o = V + (size_t)row * 512 + (pn - 8) * 256 + p; o[0] = (bf16_t)f2bf(v0); o[128] = (bf16_t)f2bf(v1); }
        else if (pn == 12) {
            if (p < 32) { const int pos = row & (SEQ - 1); const float cs = COS[pos * 32 + p], sn = SIN[pos * 32 + p];
                unsigned short* o = KI + (size_t)row * 64 + p; o[0] = f2h(v0 * cs - v1 * sn); o[32] = f2h(v1 * cs + v0 * sn); }
            else if (p < 40) { WI[(size_t)row * 8 + (p - 32)] = v0 * IDX_SCALE; }
        }
        else { bf16_t* o = G + (size_t)row * 2048 + (pn - 13) * 256 + p; o[0] = (bf16_t)f2bf(sigmoidf(v0)); o[128] = (bf16_t)f2bf(sigmoidf(v1)); }
    }
};
struct EpiMergeA { const bf16_t* G; bf16_t* MG;
    __device__ __forceinline__ void operator()(int row, int col, float a0, float a1) const {
        const bf16_t* g = G + (size_t)row * 2048 + col; bf16_t* o = MG + (size_t)row * 1024 + col;
        o[0] = (bf16_t)f2bf(bf2f(g[0]) * a0); o[128] = (bf16_t)f2bf(bf2f(g[128]) * a1); } };
struct EpiMergeB { const bf16_t* G; bf16_t* MG;
    __device__ __forceinline__ void operator()(int row, int col, float a0, float a1) const {
        const bf16_t* g = G + (size_t)row * 2048 + 1024 + col; bf16_t* o = MG + (size_t)row * 1024 + col;
        o[0] = (bf16_t)f2bf(bf2f(o[0]) + bf2f(g[0]) * a0); o[128] = (bf16_t)f2bf(bf2f(o[128]) + bf2f(g[128]) * a1); } };
struct EpiWo { const float* x; float* X1; bf16_t* X1B;
    __device__ __forceinline__ void operator()(int row, int col, float a0, float a1) const {
        const size_t o = (size_t)row * 1024 + col; const float r0 = x[o] + a0, r1 = x[o + 128] + a1;
        X1[o] = r0; X1[o + 128] = r1; X1B[o] = (bf16_t)f2bf(r0); X1B[o + 128] = (bf16_t)f2bf(r1); } };
struct EpiFF1 { const float* RS2; bf16_t* H;
    __device__ __forceinline__ void operator()(int row, int col, float a0, float a1) const {
        const float rs = RS2[row]; const float h0 = fmaxf(a0 * rs, 0.f), h1 = fmaxf(a1 * rs, 0.f);
        bf16_t* o = H + (size_t)row * 4096 + col; o[0] = (bf16_t)f2bf(h0 * h0); o[128] = (bf16_t)f2bf(h1 * h1); } };
struct EpiFF2 { float* X;
    __device__ __forceinline__ void operator()(int row, int col, float a0, float a1) const {
        const size_t o = (size_t)row * 1024 + col; X[o] += a0; X[o + 128] += a1; } };

__device__ __forceinline__ void sgu_simple(Frame& F) {
    LAS float* vs = (LAS float*)F.lds;
    LAS bf16_t* wsl = (LAS bf16_t*)(F.lds + 65536);
    LAS float* st = (LAS float*)(F.lds + 65536 + 32768);
    for (int bc = blockIdx.x; bc < M / 128; bc += gridDim.x) {
        const int row0 = bc * 128;
        for (int i = 0; i < 16; ++i) {
            const int r = F.wave * 16 + i;
            const u32x4 w = *(const u32x4*)(F.VG + (size_t)(row0 + r) * 512 + F.lane * 8);
            float v[8]; v[0] = bf2f(w.x & 0xffff); v[1] = bf2f(w.x >> 16); v[2] = bf2f(w.y & 0xffff); v[3] = bf2f(w.y >> 16);
            v[4] = bf2f(w.z & 0xffff); v[5] = bf2f(w.z >> 16); v[6] = bf2f(w.w & 0xffff); v[7] = bf2f(w.w >> 16);
            float s = 0.f;
#pragma unroll
            for (int j = 0; j < 8; ++j) s += v[j];
            const float mean = wave_sum(s) * (1.f / 512.f); float q = 0.f;
#pragma unroll
            for (int j = 0; j < 8; ++j) { const float d = v[j] - mean; q += d * d; }
            const float rstd = 1.0f / sqrtf(wave_sum(q) * (1.f / 512.f) + EPS);
            if (F.lane == 0) { st[2 * r] = mean; st[2 * r + 1] = rstd; }
        }
        __syncthreads();
        for (int g = 0; g < 4; ++g) {
            for (int idx = F.tid; idx < 16384; idx += NT) {
                const int s = idx >> 7, d = idx & 127;
                const float v = bf2f(F.VG[(size_t)(row0 + s) * 512 + g * 128 + d]);
                vs[idx] = (v - st[2 * s]) * st[2 * s + 1] * F.ln_g[g * 128 + d] + F.ln_b[g * 128 + d];
                wsl[idx] = F.WSB[g * 16384 + idx];
            }
            __syncthreads();
            for (int idx = F.tid; idx < 16384; idx += NT) {
                const int t = idx >> 7, d = idx & 127; float acc = 0.f;
                for (int s = 0; s <= t; ++s) acc += bf2f(wsl[t * 128 + s]) * vs[s * 128 + d];
                const float sf = acc + F.b_s[g * 128 + t];
                bf16_t* u = F.U + (size_t)(row0 + t) * 512 + g * 128 + d;
                *u = (bf16_t)f2bf(bf2f(*u) * sf);
            }
            __syncthreads();
        }
    }
}

__device__ __forceinline__ void indexer_simple(Frame& F) {
    LAS float* sc = (LAS float*)F.lds;
    LAS float* qf = (LAS float*)(F.lds + 16384);
    LAS float* wl = (LAS float*)(F.lds + 16384 + 2048);
    LAS unsigned* cnt = (LAS unsigned*)(F.lds + 16384 + 2048 + 64);
    LAS unsigned* eqc = (LAS unsigned*)(F.lds + 20480);
    for (int r = blockIdx.x; r < M; r += gridDim.x) {
        const int t = r & (SEQ - 1), b = r >> 12;
        unsigned char* mrow = (unsigned char*)(F.MASK + ((size_t)(b * 64 + (F.tid >> 3)) * SEQ + t)) + (F.tid & 7);
        if (t < 255) {
            unsigned m = 0;
#pragma unroll
            for (int i = 0; i < 8; ++i) m |= ((8 * F.tid + i) <= t) ? (1u << i) : 0u;
            *mrow = (unsigned char)m;
            continue;
        }
        qf[F.tid] = h2f(F.QI[(size_t)r * 512 + F.tid]);
        if (F.tid < 8) wl[F.tid] = F.WI[(size_t)r * 8 + F.tid];
        if (F.tid == 0) { cnt[0] = 0; cnt[1] = 0; }
        __syncthreads();
        for (int s = F.tid; s < SEQ; s += NT) {
            float score = 0.f;
            if (s <= t) {
                const unsigned short* kp = F.KI + (size_t)(b * SEQ + s) * 64;
                float kf[64];
#pragma unroll
                for (int j = 0; j < 8; ++j) { const u32x4 w = *(const u32x4*)(kp + 8 * j);
                    kf[8 * j + 0] = h2f(w.x & 0xffff); kf[8 * j + 1] = h2f(w.x >> 16); kf[8 * j + 2] = h2f(w.y & 0xffff); kf[8 * j + 3] = h2f(w.y >> 16);
                    kf[8 * j + 4] = h2f(w.z & 0xffff); kf[8 * j + 5] = h2f(w.z >> 16); kf[8 * j + 6] = h2f(w.w & 0xffff); kf[8 * j + 7] = h2f(w.w >> 16); }
#pragma unroll 1
                for (int h = 0; h < 8; ++h) {
                    float dot = 0.f;
#pragma unroll
                    for (int d = 0; d < 64; ++d) dot += qf[h * 64 + d] * kf[d];
                    score += wl[h] * fmaxf(dot, 0.f);
                }
            }
            sc[s] = score;
        }
        __syncthreads();
        unsigned key[8];
#pragma unroll
        for (int i = 0; i < 8; ++i) { const int s = 8 * F.tid + i; key[i] = (s <= t) ? ukey(sc[s]) : 0u; }
        unsigned lo = 1u, hi = 0xFFFFFFFFu; int it = 0;
        while (hi - lo > 1u) {
            const unsigned mid = lo + ((hi - lo) >> 1);
            unsigned c = 0;
#pragma unroll
            for (int i = 0; i < 8; ++i) c += (key[i] >= mid) ? 1u : 0u;
            c = wave_sum_u(c);
            __syncthreads();
            if (F.tid == 0) cnt[(it + 1) & 1] = 0;
            if (F.lane == 0) atomicAdd((unsigned*)&cnt[it & 1], c);
            __syncthreads();
            const unsigned tot = cnt[it & 1];
            if (tot >= 256u) lo = mid; else hi = mid;
            ++it;
        }
        const unsigned T = lo;
        unsigned cgt = 0, ceq = 0;
#pragma unroll
        for (int i = 0; i < 8; ++i) { cgt += (key[i] > T) ? 1u : 0u; ceq += (key[i] == T) ? 1u : 0u; }
        eqc[F.tid] = ceq;
        const unsigned cg = wave_sum_u(cgt);
        __syncthreads();
        if (F.tid == 0) cnt[(it + 1) & 1] = 0;
        if (F.lane == 0) atomicAdd((unsigned*)&cnt[it & 1], cg);
        __syncthreads();
        const unsigned need = 256u - cnt[it & 1];
        unsigned before = 0;
        for (int j = 0; j < F.tid; ++j) before += eqc[j];
        unsigned m = 0;
#pragma unroll
        for (int i = 0; i < 8; ++i) {
            bool sel = key[i] > T;
            if (key[i] == T) { sel = before < need; ++before; }
            m |= sel ? (1u << i) : 0u;
        }
        *mrow = (unsigned char)m;
        __syncthreads();
    }
}

__device__ __forceinline__ void attn_simple(Frame& F) {
    for (int task = F.gw; task < M * 8; task += F.ngw) {
        const int row = task >> 3, h = task & 7, t = row & (SEQ - 1), b = row >> 12;
        const float q = bf2f(F.Q[(size_t)row * 512 + h * 64 + F.lane]);
        float m = -INFINITY, l = 0.f, acc = 0.f;
        for (int tile = 0; tile <= (t >> 6); ++tile) {
            unsigned long long w = F.MASK[(size_t)(b * 64 + tile) * SEQ + t];
            w = (unsigned long long)(unsigned)__builtin_amdgcn_readfirstlane((unsigned)w) | ((unsigned long long)(unsigned)__builtin_amdgcn_readfirstlane((unsigned)(w >> 32)) << 32);
            while (w) {
                const int i = __builtin_ctzll(w); w &= w - 1;
                const size_t kr = (size_t)(b * SEQ + tile * 64 + i) * 512 + h * 64 + F.lane;
                const float logit = wave_sum(q * bf2f(F.K[kr]));
                const float mn = fmaxf(m, logit), scl = __builtin_amdgcn_exp2f(m - mn), pe = __builtin_amdgcn_exp2f(logit - mn);
                l = l * scl + pe; acc = acc * scl + pe * bf2f(F.V[kr]); m = mn;
            }
        }
        F.Q[(size_t)row * 512 + h * 64 + F.lane] = (bf16_t)f2bf(acc / l);
    }
}

__device__ __forceinline__ void rs2_rows(Frame& F) {
    for (int m = F.gw; m < M; m += F.ngw) {
        const f32x4* xr = (const f32x4*)(F.out + (size_t)m * D) + F.lane; float s = 0.f;
#pragma unroll
        for (int j = 0; j < 4; ++j) { const f32x4 v = xr[64 * j]; s += (v.x * v.x + v.y * v.y) + (v.z * v.z + v.w * v.w); }
        s = wave_sum(s);
        if (F.lane == 0) F.RS2[m] = 1.0f / sqrtf(s * (1.0f / D) + EPS);
        if (F.lane < 16) F.SS2[(size_t)m * 16 + F.lane] = F.lane == 0 ? s : 0.f;
    }
}
__device__ __forceinline__ void final_norm(Frame& F) {
    for (int m = F.gw; m < M; m += F.ngw) {
        f32x4* xr = (f32x4*)(F.out + (size_t)m * D) + F.lane; f32x4 v[4]; float s = 0.f;
#pragma unroll
        for (int j = 0; j < 4; ++j) { v[j] = xr[64 * j]; s += (v[j].x * v[j].x + v[j].y * v[j].y) + (v[j].z * v[j].z + v[j].w * v[j].w); }
        const float rs = 1.0f / sqrtf(wave_sum(s) * (1.0f / D) + EPS);
#pragma unroll
        for (int j = 0; j < 4; ++j) { const f32x4 g = *((const f32x4*)F.norm_f_g + F.lane + 64 * j); xr[64 * j] = v[j] * rs * g; }
    }
}


typedef float f32x16 __attribute__((ext_vector_type(16)));
__device__ __forceinline__ void indexer_fast(Frame& F) {
    LAS float* sc = (LAS float*)F.lds;
    const int lane = F.lane, w = F.wave, c = lane & 31, hf = lane >> 5;
    const int qr = ((c >> 2) & 1) * 2 + (c >> 4), hr = (c & 3) + 4 * ((c >> 3) & 1);
    for (int g = blockIdx.x; g < BATCH * (SEQ / 8); g += gridDim.x) {
        const int b = g & 7, t0 = (g >> 3) * 8, t = t0 + w;
        const size_t rowbase = (size_t)b * SEQ;
        unsigned long long myword = 0ull;
        if (t0 + 7 <= 255) {
            const int jm = t >> 6;
            myword = lane < jm ? ~0ull : (lane == jm ? ((2ull << (t & 63)) - 1ull) : 0ull);
        } else {
            float wq[2][2][8];
#pragma unroll
            for (int s = 0; s < 2; ++s)
#pragma unroll
                for (int g2 = 0; g2 < 2; ++g2) { const f32x4* wp = (const f32x4*)(F.WI + (rowbase + t0 + 4 * s + 2 * hf + g2) * 8); const f32x4 a = wp[0], bb = wp[1];
                    wq[s][g2][0] = a[0]; wq[s][g2][1] = a[1]; wq[s][g2][2] = a[2]; wq[s][g2][3] = a[3]; wq[s][g2][4] = bb[0]; wq[s][g2][5] = bb[1]; wq[s][g2][6] = bb[2]; wq[s][g2][7] = bb[3]; }
            f16x8 af[2][4];
#pragma unroll
            for (int s = 0; s < 2; ++s)
#pragma unroll
                for (int ks = 0; ks < 4; ++ks) af[s][ks] = *(const f16x8*)(F.QI + (rowbase + t0 + 4 * s + qr) * 512 + hr * 64 + 16 * ks + 8 * hf);
            const int ntile = (t0 + 8 + 31) >> 5;
            for (int tile = w; tile < ntile; tile += 8) {
                const unsigned short* kp = F.KI + (rowbase + tile * 32 + c) * 64 + 8 * hf;
                f16x8 bfr[4];
#pragma unroll
                for (int ks = 0; ks < 4; ++ks) bfr[ks] = *(const f16x8*)(kp + 16 * ks);
#pragma unroll
                for (int s = 0; s < 2; ++s) {
                    f32x16 d = {0.f, 0.f, 0.f, 0.f, 0.f, 0.f, 0.f, 0.f, 0.f, 0.f, 0.f, 0.f, 0.f, 0.f, 0.f, 0.f};
#pragma unroll
                    for (int ks = 0; ks < 4; ++ks) d = __builtin_amdgcn_mfma_f32_32x32x16_f16(af[s][ks], bfr[ks], d, 0, 0, 0);
#pragma unroll
                    for (int g2 = 0; g2 < 2; ++g2) { float sco = 0.f;
#pragma unroll
                        for (int h = 0; h < 8; ++h) sco += wq[s][g2][h] * fmaxf(d[8 * g2 + h], 0.f);
                        sc[(4 * s + 2 * hf + g2) * 4096 + tile * 32 + c] = sco; }
                }
            }
            __syncthreads();
            unsigned key[64];
            const int jm = t >> 6;
#pragma unroll
            for (int blk = 0; blk < 4; ++blk) {
                if (jm >= 16 * blk) {
#pragma unroll
                    for (int jj = 0; jj < 16; ++jj) { const int j = 16 * blk + jj, idx = j * 64 + lane; const float v = sc[w * 4096 + idx]; key[j] = (idx <= t) ? ukey(v) : 0u; }
                } else {
#pragma unroll
                    for (int jj = 0; jj < 16; ++jj) key[16 * blk + jj] = 0u;
                }
            }
            unsigned lo = 1u, hi = 0xFFFFFFFFu; bool exact = false;
            while (hi - lo > 1u) {
                const unsigned mid = lo + ((hi - lo) >> 1);
                unsigned cnt = 0;
#pragma unroll
                for (int blk = 0; blk < 4; ++blk) if (jm >= 16 * blk) {
#pragma unroll
                    for (int jj = 0; jj < 16; ++jj) cnt += (unsigned)__builtin_popcountll(__ballot(key[16 * blk + jj] >= mid)); }
                if (cnt == 256u) { lo = mid; exact = true; break; }
                if (cnt > 256u) lo = mid; else hi = mid;
            }
            const unsigned T = lo;
            if (exact) {
#pragma unroll
                for (int j = 0; j < 64; ++j) { const unsigned long long m = __ballot(key[j] >= T); if (lane == j) myword = m; }
            } else {
                unsigned cgt = 0;
#pragma unroll
                for (int j = 0; j < 64; ++j) cgt += (unsigned)__builtin_popcountll(__ballot(key[j] > T));
                unsigned need = 256u - cgt;
#pragma unroll
                for (int j = 0; j < 64; ++j) { const unsigned long long gt = __ballot(key[j] > T); unsigned long long eq = __ballot(key[j] == T), take = 0ull;
                    while (need != 0u && eq != 0ull) { const unsigned long long low = eq & (0ull - eq); take |= low; eq ^= low; --need; }
                    if (lane == j) myword = gt | take; }
            }
            __syncthreads();
        }
        F.MASK[((size_t)(b * 64 + lane)) * SEQ + t] = myword;
    }
}

__device__ __forceinline__ void sgu_fast(Frame& F) {
    constexpr int PITCH = 136;
    LAS bf16_t* vT = (LAS bf16_t*)F.lds;
    LAS float* st = (LAS float*)(F.lds + 128 * PITCH * 2);
    const int lane = F.lane, w = F.wave, fr = lane & 15, fq = lane >> 4;
    for (int bc = blockIdx.x; bc < M / 128; bc += gridDim.x) {
        const int row0 = bc * 128;
        for (int i = 0; i < 16; ++i) {
            const int r = w * 16 + i;
            const u32x4 ww = *(const u32x4*)(F.VG + (size_t)(row0 + r) * 512 + lane * 8);
            float v[8]; v[0] = bf2f(ww.x & 0xffff); v[1] = bf2f(ww.x >> 16); v[2] = bf2f(ww.y & 0xffff); v[3] = bf2f(ww.y >> 16);
            v[4] = bf2f(ww.z & 0xffff); v[5] = bf2f(ww.z >> 16); v[6] = bf2f(ww.w & 0xffff); v[7] = bf2f(ww.w >> 16);
            float s = 0.f;
#pragma unroll
            for (int j = 0; j < 8; ++j) s += v[j];
            const float mean = wave_sum(s) * (1.f / 512.f); float q = 0.f;
#pragma unroll
            for (int j = 0; j < 8; ++j) { const float d = v[j] - mean; q += d * d; }
            const float rstd = 1.0f / sqrtf(wave_sum(q) * (1.f / 512.f) + EPS);
            if (lane == 0) { st[2 * r] = mean; st[2 * r + 1] = rstd; }
        }
        __syncthreads();
        const int tb = w >> 1, dh = w & 1;
        for (int g = 0; g < 4; ++g) {
#pragma unroll
            for (int i = 0; i < 4; ++i) { const int idx = F.tid + NT * i, s = idx & 127, d8 = (idx >> 7) * 8;
                const u32x4 ww = *(const u32x4*)(F.VG + (size_t)(row0 + s) * 512 + g * 128 + d8);
                const f32x4 g0 = *(const f32x4*)(F.ln_g + g * 128 + d8), g1 = *(const f32x4*)(F.ln_g + g * 128 + d8 + 4), b0 = *(const f32x4*)(F.ln_b + g * 128 + d8), b1 = *(const f32x4*)(F.ln_b + g * 128 + d8 + 4);
                const float mean = st[2 * s], rstd = st[2 * s + 1];
                float v[8]; v[0] = bf2f(ww.x & 0xffff); v[1] = bf2f(ww.x >> 16); v[2] = bf2f(ww.y & 0xffff); v[3] = bf2f(ww.y >> 16);
                v[4] = bf2f(ww.z & 0xffff); v[5] = bf2f(ww.z >> 16); v[6] = bf2f(ww.w & 0xffff); v[7] = bf2f(ww.w >> 16);
#pragma unroll
                for (int e = 0; e < 8; ++e) { const float gg = e < 4 ? g0[e & 3] : g1[e & 3], bb = e < 4 ? b0[e & 3] : b1[e & 3];
                    vT[(d8 + e) * PITCH + s] = (bf16_t)f2bf((v[e] - mean) * rstd * gg + bb); } }
            __syncthreads();
            f32x4 acc[4][2];
#pragma unroll
            for (int nd = 0; nd < 4; ++nd)
#pragma unroll
                for (int mt = 0; mt < 2; ++mt) acc[nd][mt] = (f32x4){0.f, 0.f, 0.f, 0.f};
            for (int ks = 0; ks <= tb; ++ks) {
                bf16x8 vf[4], wf[2];
#pragma unroll
                for (int nd = 0; nd < 4; ++nd) vf[nd] = *(const LAS bf16x8*)(vT + (dh * 64 + nd * 16 + fr) * PITCH + ks * 32 + 8 * fq);
#pragma unroll
                for (int mt = 0; mt < 2; ++mt) wf[mt] = *(const bf16x8*)(F.WSB + g * 16384 + (tb * 32 + mt * 16 + fr) * 128 + ks * 32 + 8 * fq);
#pragma unroll
                for (int nd = 0; nd < 4; ++nd)
#pragma unroll
                    for (int mt = 0; mt < 2; ++mt) acc[nd][mt] = __builtin_amdgcn_mfma_f32_16x16x32_bf16(vf[nd], wf[mt], acc[nd][mt], 0, 0, 0);
            }
#pragma unroll
            for (int mt = 0; mt < 2; ++mt) { const int tl = tb * 32 + mt * 16 + fr; const float bs = F.b_s[g * 128 + tl];
#pragma unroll
                for (int nd = 0; nd < 4; ++nd) { bf16_t* up = F.U + (size_t)(row0 + tl) * 512 + g * 128 + dh * 64 + nd * 16 + 4 * fq;
                    const u32x2 uu = *(const u32x2*)up; u32x2 o;
                    o.x = pk2(bf2f(uu.x & 0xffff) * (acc[nd][mt][0] + bs), bf2f(uu.x >> 16) * (acc[nd][mt][1] + bs));
                    o.y = pk2(bf2f(uu.y & 0xffff) * (acc[nd][mt][2] + bs), bf2f(uu.y >> 16) * (acc[nd][mt][3] + bs));
                    *(u32x2*)up = o; } }
            __syncthreads();
        }
    }
}

namespace pg8 {
#define PG8_LAS __attribute__((address_space(3)))
typedef unsigned short bf16_t;
typedef short bf16x8 __attribute__((ext_vector_type(8)));
typedef float f32x4 __attribute__((ext_vector_type(4)));
typedef unsigned u32x4 __attribute__((ext_vector_type(4)));
constexpr int BM = 256, BK = 64, HALF = 128, HTB = HALF * BK * 2  , STAGE_BYTES = 8 * HTB, NXCD = 8, WGM = 8;

__host__ __device__ __forceinline__ int lds_byte(int r, int c) { const int st = (r >> 4) * 2 + (c >> 5), rr = r & 15, cc = c & 31, ob = rr * 64 + cc * 2; return st * 1024 + (ob ^ (((ob >> 9) & 1) << 5)); }
__host__ __device__ __forceinline__ void stage_rc(int b, int& R, int& C) { const int st = b / 1024, sb = b % 1024, swz = sb ^ (((sb >> 9) & 1) << 5); R = (st >> 1) * 16 + swz / 64; C = (st & 1) * 32 + (swz % 64) / 2; }
__host__ __device__ __forceinline__ int perm32(int rho) { const int n = rho >> 4, i = rho & 15; return 8 * (i >> 2) + 4 * n + (i & 3); }

struct Unit { int pm, pn; };
struct Gemm { const bf16_t* A; const bf16_t* Bt; int M, N, K; };

struct StaticOrder {
    int nM, nN, nwg, G, c;
    __host__ __device__ void init(int M, int N, int G_, int c_) { nM = M / BM; nN = N / BM; nwg = nM * nN; G = G_; c = c_; }
    __host__ __device__ bool next(int i, Unit& u) const {
        const long L = (long)i * G + c; if (L >= nwg) return false;
        int wgid = (int)L; { const int q = nwg / NXCD, r = nwg % NXCD, xcd = wgid % NXCD, off = wgid / NXCD; wgid = (xcd < r ? xcd * (q + 1) : r * (q + 1) + (xcd - r) * q) + off; }
        const int nig = WGM * nN, gid = wgid / nig, fm = gid * WGM, gsz = (nM - fm) < WGM ? (nM - fm) : WGM;
        u.pm = fm + ((wgid % nig) % gsz); u.pn = (wgid % nig) / gsz; return true;
    }
    __device__ __forceinline__ void a_ready(const Unit&) const {}
    __device__ __forceinline__ void done(const Unit&) const {}
};
template <class Epi, class Sched, bool ALIGN_EPI = false, bool SP2 = false>
__device__ __forceinline__ void gemm_phase(PG8_LAS unsigned char* lds, const Gemm g, const Sched& S, const Epi& E) {
    const int tid = threadIdx.x, wid = __builtin_amdgcn_readfirstlane(tid >> 6), lane = tid & 63, wr = wid >> 2, wc = wid & 3, fr = lane & 15, fq = lane >> 4;
    const int K = g.K, nt = K / BK;
    unsigned voffA[2], voffB[2];
#pragma unroll
    for (int i = 0; i < 2; ++i) { int R, C; stage_rc(tid * 16 + i * 8192, R, C); const int Rb = Epi::PERM ? ((R & ~31) + perm32(R & 31)) : R;
        voffA[i] = (unsigned)(R * K + C) * 2u; voffB[i] = (unsigned)(Rb * K + C) * 2u; }
    const size_t kstep = (size_t)(BK * 2);
    const size_t hstep = (size_t)HALF * K * 2;
    const size_t tstep = 2 * hstep;
    const unsigned ldsw = (unsigned)wid * 1024u;
    const int aoff = lds_byte(wr * 64 + fr, fq * 8), boff = lds_byte(wc * 32 + fr, fq * 8);
#define PG8_SA(b, h) (((b) * 2 + (h)) * HTB)
#define PG8_SB(b, h) ((4 + (b) * 2 + (h)) * HTB)
#define PG8_STAGE(bufoff, gbase, voff) do { _Pragma("unroll") for (int _i = 0; _i < 2; ++_i) \
        __builtin_amdgcn_global_load_lds((const unsigned*)((const char*)(gbase) + (voff)[_i]), (PG8_LAS unsigned*)(lds + (bufoff) + ldsw + _i * 8192), 16, 0, 0); } while (0)
#define PG8_LDA(dst, b, h) do { _Pragma("unroll") for (int m = 0; m < 4; ++m) _Pragma("unroll") for (int k = 0; k < 2; ++k) dst[m][k] = *(const PG8_LAS bf16x8*)(lds + PG8_SA(b, h) + aoff + m * 2048 + k * 1024); } while (0)
#define PG8_LDB(dst, b, h) do { _Pragma("unroll") for (int n = 0; n < 2; ++n) _Pragma("unroll") for (int k = 0; k < 2; ++k) dst[n][k] = *(const PG8_LAS bf16x8*)(lds + PG8_SB(b, h) + boff + n * 2048 + k * 1024); } while (0)
#define PG8_MMA(ai, bj, At, Bt) do { __builtin_amdgcn_s_setprio(1); _Pragma("unroll") for (int m = 0; m < 4; ++m) _Pragma("unroll") for (int n = 0; n < 2; ++n) _Pragma("unroll") for (int k = 0; k < 2; ++k) \
        acc[ai][bj][m][n] = __builtin_amdgcn_mfma_f32_16x16x32_bf16(Bt[n][k], At[m][k], acc[ai][bj][m][n], 0, 0, 0); __builtin_amdgcn_s_setprio(0); } while (0)
#define PG8_WAIT_V(n) asm volatile("s_waitcnt vmcnt(" #n ")" ::: "memory")
#define PG8_WAIT_L(n) asm volatile("s_waitcnt lgkmcnt(" #n ")" ::: "memory")
#define PG8_BAR __builtin_amdgcn_s_barrier()
#define PG8_SCHED __builtin_amdgcn_sched_barrier(0)
    Unit cur, nxt; int ui = 0;
    if (!S.next(0, cur)) return;
    f32x4 acc[2][2][4][2];
#pragma unroll
    for (int a = 0; a < 2; ++a)
#pragma unroll
        for (int b = 0; b < 2; ++b)
#pragma unroll
            for (int m = 0; m < 4; ++m)
#pragma unroll
                for (int n = 0; n < 2; ++n) acc[a][b][m][n] = (f32x4){0.f, 0.f, 0.f, 0.f};
    bf16x8 At[4][2], B0[2][2], B1[2][2];
    const char* cA = (const char*)g.A + (size_t)cur.pm * tstep; const char* cB = (const char*)g.Bt + (size_t)cur.pn * tstep;
    S.a_ready(cur);
    if constexpr (SP2) {
        PG8_STAGE(PG8_SB(0, 0), cB, voffB); PG8_STAGE(PG8_SB(0, 1), cB + hstep, voffB); PG8_STAGE(PG8_SA(0, 0), cA, voffA); PG8_STAGE(PG8_SA(0, 1), cA + hstep, voffA);
        if (wr == 1) PG8_BAR;
        PG8_WAIT_V(2); PG8_BAR;
        PG8_STAGE(PG8_SB(1, 0), cB + kstep, voffB); PG8_STAGE(PG8_SA(1, 0), cA + kstep, voffA); PG8_STAGE(PG8_SB(1, 1), cB + hstep + kstep, voffB);
        PG8_WAIT_V(6); PG8_BAR;
    } else {
        PG8_STAGE(PG8_SB(0, 0), cB, voffB); PG8_STAGE(PG8_SA(0, 0), cA, voffA); PG8_STAGE(PG8_SB(0, 1), cB + hstep, voffB); PG8_STAGE(PG8_SA(0, 1), cA + hstep, voffA);
        if (wr == 1) PG8_BAR;
        PG8_WAIT_V(4); PG8_BAR;
        PG8_STAGE(PG8_SB(1, 0), cB + kstep, voffB); PG8_STAGE(PG8_SA(1, 0), cA + kstep, voffA); PG8_STAGE(PG8_SB(1, 1), cB + hstep + kstep, voffB);
        PG8_WAIT_V(6); PG8_BAR;
    }
    for (;;) {
        const bool has_next = S.next(ui + 1, nxt);
        const char* nA = has_next ? (const char*)g.A + (size_t)nxt.pm * tstep : cA; const char* nB = has_next ? (const char*)g.Bt + (size_t)nxt.pn * tstep : cB;
        for (int t = 0; t < nt; t += 2) {
            const bool last = (t == nt - 2);
            const char* a1 = cA + (size_t)(t + 1) * kstep;
            const char* a2 = last ? nA : cA + (size_t)(t + 2) * kstep; const char* b2 = last ? nB : cB + (size_t)(t + 2) * kstep;
            const char* a3 = a2 + kstep; const char* b3 = b2 + kstep;
            if (last && has_next) S.a_ready(nxt);
            if constexpr (SP2) {
            PG8_LDB(B0, 0, 0); PG8_LDB(B1, 0, 1); PG8_SCHED; PG8_LDA(At, 0, 0); PG8_STAGE(PG8_SA(1, 1), a1 + hstep, voffA);
            PG8_WAIT_V(8); PG8_WAIT_L(0); PG8_BAR; PG8_MMA(0, 0, At, B0); PG8_MMA(0, 1, At, B1); PG8_BAR; PG8_SCHED;
            PG8_LDA(At, 0, 1); PG8_STAGE(PG8_SB(0, 0), b2, voffB); PG8_STAGE(PG8_SB(0, 1), b2 + hstep, voffB); PG8_STAGE(PG8_SA(0, 0), a2, voffA);
            PG8_WAIT_V(8); PG8_WAIT_L(0); PG8_BAR; PG8_MMA(1, 0, At, B0); PG8_MMA(1, 1, At, B1); PG8_BAR; PG8_SCHED;
            PG8_LDB(B0, 1, 0); PG8_LDB(B1, 1, 1); PG8_SCHED; PG8_LDA(At, 1, 0); PG8_STAGE(PG8_SA(0, 1), a2 + hstep, voffA);
            PG8_WAIT_V(8); PG8_WAIT_L(0); PG8_BAR; PG8_MMA(0, 0, At, B0); PG8_MMA(0, 1, At, B1); PG8_BAR; PG8_SCHED;
            PG8_LDA(At, 1, 1); PG8_STAGE(PG8_SB(1, 0), b3, voffB); PG8_STAGE(PG8_SB(1, 1), b3 + hstep, voffB); PG8_STAGE(PG8_SA(1, 0), a3, voffA);
            PG8_WAIT_V(8); PG8_WAIT_L(0); PG8_BAR; PG8_MMA(1, 0, At, B0); PG8_MMA(1, 1, At, B1); PG8_BAR; PG8_SCHED;
            } else {
            PG8_LDB(B0, 0, 0); PG8_SCHED; PG8_LDA(At, 0, 0); PG8_STAGE(PG8_SA(1, 1), a1 + hstep, voffA);
            PG8_WAIT_L(8); PG8_BAR; PG8_WAIT_L(0); PG8_MMA(0, 0, At, B0); PG8_BAR; PG8_SCHED;
            PG8_LDB(B1, 0, 1); PG8_STAGE(PG8_SB(0, 0), b2, voffB);
            PG8_BAR; PG8_WAIT_L(0); PG8_MMA(0, 1, At, B1); PG8_BAR;
            PG8_LDA(At, 0, 1); PG8_STAGE(PG8_SA(0, 0), a2, voffA);
            PG8_BAR; PG8_WAIT_L(0); PG8_MMA(1, 0, At, B0); PG8_BAR; PG8_SCHED;
            PG8_STAGE(PG8_SB(0, 1), b2 + hstep, voffB);
            PG8_WAIT_V(6); PG8_BAR; PG8_MMA(1, 1, At, B1); PG8_BAR;
            PG8_LDB(B0, 1, 0); PG8_SCHED; PG8_LDA(At, 1, 0); PG8_STAGE(PG8_SA(0, 1), a2 + hstep, voffA);
            PG8_WAIT_L(8); PG8_BAR; PG8_WAIT_L(0); PG8_MMA(0, 0, At, B0); PG8_BAR; PG8_SCHED;
            PG8_LDB(B1, 1, 1); PG8_STAGE(PG8_SB(1, 0), b3, voffB);
            PG8_BAR; PG8_WAIT_L(0); PG8_MMA(0, 1, At, B1); PG8_BAR;
            PG8_LDA(At, 1, 1); PG8_STAGE(PG8_SA(1, 0), a3, voffA);
            PG8_BAR; PG8_WAIT_L(0); PG8_MMA(1, 0, At, B0); PG8_BAR; PG8_SCHED;
            PG8_STAGE(PG8_SB(1, 1), b3 + hstep, voffB);
            PG8_WAIT_V(6); PG8_BAR; PG8_MMA(1, 1, At, B1); PG8_BAR;
            }
        }
        if constexpr (ALIGN_EPI) { if (wr == 0) PG8_BAR; }
        if constexpr (!Epi::AFTER_DRAIN) { E(acc, cur, wr, wc, fr, fq); S.done(cur); }
        if (!has_next) break;
#pragma unroll
        for (int a = 0; a < 2; ++a)
#pragma unroll
            for (int b = 0; b < 2; ++b)
#pragma unroll
                for (int m = 0; m < 4; ++m)
#pragma unroll
                    for (int n = 0; n < 2; ++n) acc[a][b][m][n] = (f32x4){0.f, 0.f, 0.f, 0.f};
        cur = nxt; cA = nA; cB = nB; ++ui;
        if constexpr (ALIGN_EPI) { if (wr == 1) PG8_BAR; }
    }
    PG8_WAIT_V(0);
    if constexpr (!ALIGN_EPI) { if (wr == 0) PG8_BAR; }
    PG8_BAR;
    if constexpr (Epi::AFTER_DRAIN) { E.fused(acc, cur, wr, wc, fr, fq, lds, wid, lane); S.done(cur); }
#undef PG8_SA
#undef PG8_SB
#undef PG8_STAGE
#undef PG8_LDA
#undef PG8_LDB
#undef PG8_MMA
#undef PG8_WAIT_V
#undef PG8_WAIT_L
#undef PG8_BAR
#undef PG8_SCHED
}
}

#define PG8_SP2 true
#define PG8_ALIGN true
namespace pg8 {
__device__ __forceinline__ unsigned cvt_pk_bf16(float lo, float hi) { unsigned r; asm volatile("v_cvt_pk_bf16_f32 %0, %1, %2" : "=v"(r) : "v"(lo), "v"(hi)); return r; }
__device__ __forceinline__ unsigned cvt_pk_f16(float lo, float hi) { const _Float16 a = (_Float16)lo, b = (_Float16)hi; return (unsigned)__builtin_bit_cast(unsigned short, a) | ((unsigned)__builtin_bit_cast(unsigned short, b) << 16); }
__device__ __forceinline__ u32x4 pack8_bf16(const f32x4& a, const f32x4& b) { u32x4 w; w.x = cvt_pk_bf16(a[0], a[1]); w.y = cvt_pk_bf16(a[2], a[3]); w.z = cvt_pk_bf16(b[0], b[1]); w.w = cvt_pk_bf16(b[2], b[3]); return w; }
__device__ __forceinline__ u32x4 pack8_f16(const f32x4& a, const f32x4& b) { u32x4 w; w.x = cvt_pk_f16(a[0], a[1]); w.y = cvt_pk_f16(a[2], a[3]); w.z = cvt_pk_f16(b[0], b[1]); w.w = cvt_pk_f16(b[2], b[3]); return w; }
__device__ __forceinline__ f32x4 bf_lo4(const u32x4& w) { return (f32x4){__uint_as_float(w.x << 16), __uint_as_float(w.x & 0xffff0000u), __uint_as_float(w.y << 16), __uint_as_float(w.y & 0xffff0000u)}; }
__device__ __forceinline__ f32x4 bf_hi4(const u32x4& w) { return (f32x4){__uint_as_float(w.z << 16), __uint_as_float(w.z & 0xffff0000u), __uint_as_float(w.w << 16), __uint_as_float(w.w & 0xffff0000u)}; }
__device__ __forceinline__ f32x4 gelu4(const f32x4& x) { f32x4 r;
#pragma unroll
    for (int i = 0; i < 4; ++i) { const float z = 1.5957691216057308f * (x[i] + 0.044715f * x[i] * x[i] * x[i]); r[i] = x[i] * __builtin_amdgcn_rcpf(1.0f + __builtin_amdgcn_exp2f(-1.4426950408889634f * z)); }
    return r; }
__device__ __forceinline__ f32x4 sigm4(const f32x4& x) { f32x4 r;
#pragma unroll
    for (int i = 0; i < 4; ++i) r[i] = __builtin_amdgcn_rcpf(1.0f + __builtin_amdgcn_exp2f(-1.4426950408889634f * x[i]));
    return r; }

struct EpiProjF {
    static constexpr bool PERM = true, AFTER_DRAIN = false;
    unsigned char* ws;
    __device__ __forceinline__ void operator()(const f32x4 (&acc)[2][2][4][2], const Unit& u, int wr, int wc, int fr, int fq) const {
        const int pn = u.pn, row0 = u.pm * BM + wr * 64 + fr, cb = 32 * wc + 8 * fq;
        const float* RS1 = (const float*)(ws + WS_RS1); const float* COS = (const float*)(ws + WS_COS); const float* SIN = (const float*)(ws + WS_SIN);
        unsigned short* KI = (unsigned short*)(ws + WS_KI); float* WI = (float*)(ws + WS_WI);
        if (pn < 4 || pn == 8 || pn == 9 || pn >= 13) {
            size_t boff; int ld, colt;
            if (pn < 2) { boff = WS_U; ld = 512; colt = pn * 256; } else if (pn < 4) { boff = WS_VG; ld = 512; colt = (pn - 2) * 256; }
            else if (pn < 10) { boff = WS_V; ld = 512; colt = (pn - 8) * 256; } else { boff = WS_G; ld = 2048; colt = (pn - 13) * 256; }
            bf16_t* base = (bf16_t*)(ws + boff);
            const int act = pn < 4 ? 1 : (pn >= 13 ? 2 : 0);
#pragma unroll
            for (int ai = 0; ai < 2; ++ai)
#pragma unroll
                for (int m = 0; m < 4; ++m) { const int r = row0 + ai * HALF + m * 16; const float rs = RS1[r]; bf16_t* rowp = base + (size_t)r * ld + colt + cb;
#pragma unroll
                    for (int bj = 0; bj < 2; ++bj) { f32x4 v0 = acc[ai][bj][m][0] * rs, v1 = acc[ai][bj][m][1] * rs;
                        if (act == 1) { v0 = gelu4(v0); v1 = gelu4(v1); } else if (act == 2) { v0 = sigm4(v0); v1 = sigm4(v1); }
                        *(u32x4*)(rowp + bj * HALF) = pack8_bf16(v0, v1); } }
        } else if (pn == 12) {
            if (wc == 0) {
                const int pos0 = row0 & (SEQ - 1);
                f32x4 c0 = *(const f32x4*)(COS + pos0 * 32 + 8 * fq), c1 = *(const f32x4*)(COS + pos0 * 32 + 8 * fq + 4), s0 = *(const f32x4*)(SIN + pos0 * 32 + 8 * fq), s1 = *(const f32x4*)(SIN + pos0 * 32 + 8 * fq + 4);
                const f32x4 dc0 = *(const f32x4*)(COS + 16 * 32 + 8 * fq), dc1 = *(const f32x4*)(COS + 16 * 32 + 8 * fq + 4), ds0 = *(const f32x4*)(SIN + 16 * 32 + 8 * fq), ds1 = *(const f32x4*)(SIN + 16 * 32 + 8 * fq + 4);
#pragma unroll
                for (int ai = 0; ai < 2; ++ai) {
#pragma unroll
                    for (int m = 0; m < 4; ++m) { const int r = row0 + ai * HALF + m * 16; const float rs = RS1[r];
                        const f32x4 a0 = acc[ai][0][m][0] * rs, a1 = acc[ai][0][m][1] * rs, b0 = acc[ai][1][m][0] * rs, b1 = acc[ai][1][m][1] * rs;
                        unsigned short* rowp = KI + (size_t)r * 64 + 8 * fq;
                        *(u32x4*)rowp = pack8_f16(a0 * c0 - b0 * s0, a1 * c1 - b1 * s1);
                        *(u32x4*)(rowp + 32) = pack8_f16(b0 * c0 + a0 * s0, b1 * c1 + a1 * s1);
                        { const f32x4 t0 = c0 * dc0 - s0 * ds0, t1 = c1 * dc1 - s1 * ds1; s0 = s0 * dc0 + c0 * ds0; s1 = s1 * dc1 + c1 * ds1; c0 = t0; c1 = t1; } }
                    if (ai == 0) {
#pragma unroll
                        for (int k = 0; k < 4; ++k) { const f32x4 t0 = c0 * dc0 - s0 * ds0, t1 = c1 * dc1 - s1 * ds1; s0 = s0 * dc0 + c0 * ds0; s1 = s1 * dc1 + c1 * ds1; c0 = t0; c1 = t1; } }
                }
            } else if (wc == 1) {
                if (fq == 0) {
#pragma unroll
                    for (int ai = 0; ai < 2; ++ai)
#pragma unroll
                        for (int m = 0; m < 4; ++m) { const int r = row0 + ai * HALF + m * 16; const float rs = RS1[r] * IDX_SCALE;
                            *(f32x4*)(WI + (size_t)r * 8) = acc[ai][0][m][0] * rs; *(f32x4*)(WI + (size_t)r * 8 + 4) = acc[ai][0][m][1] * rs; }
                }
            }
        } else {
            const int kind = pn < 6 ? 0 : (pn < 8 ? 1 : 2);
            const int colt = (kind == 0 ? (pn - 4) : kind == 1 ? (pn - 6) : (pn - 10)) * 256 + 64 * wc + 8 * fq;
            unsigned short* base = (unsigned short*)(ws + (kind == 0 ? WS_Q : kind == 1 ? WS_K : WS_QI));
            const float sc = kind == 0 ? C2 : 1.0f;
            const int pos0 = row0 & (SEQ - 1);
            f32x4 c0 = *(const f32x4*)(COS + pos0 * 32 + 8 * fq), c1 = *(const f32x4*)(COS + pos0 * 32 + 8 * fq + 4), s0 = *(const f32x4*)(SIN + pos0 * 32 + 8 * fq), s1 = *(const f32x4*)(SIN + pos0 * 32 + 8 * fq + 4);
            const f32x4 dc0 = *(const f32x4*)(COS + 16 * 32 + 8 * fq), dc1 = *(const f32x4*)(COS + 16 * 32 + 8 * fq + 4), ds0 = *(const f32x4*)(SIN + 16 * 32 + 8 * fq), ds1 = *(const f32x4*)(SIN + 16 * 32 + 8 * fq + 4);
#pragma unroll
            for (int ai = 0; ai < 2; ++ai) {
#pragma unroll
                for (int m = 0; m < 4; ++m) { const int r = row0 + ai * HALF + m * 16; const float rs = RS1[r] * sc;
                    const f32x4 a0 = acc[ai][0][m][0] * rs, a1 = acc[ai][0][m][1] * rs, b0 = acc[ai][1][m][0] * rs, b1 = acc[ai][1][m][1] * rs;
                    unsigned short* rowp = base + (size_t)r * 512 + colt;
                    if (kind == 2) { *(u32x4*)rowp = pack8_f16(a0 * c0 - b0 * s0, a1 * c1 - b1 * s1); *(u32x4*)(rowp + 32) = pack8_f16(b0 * c0 + a0 * s0, b1 * c1 + a1 * s1); }
                    else { *(u32x4*)rowp = pack8_bf16(a0 * c0 - b0 * s0, a1 * c1 - b1 * s1); *(u32x4*)(rowp + 32) = pack8_bf16(b0 * c0 + a0 * s0, b1 * c1 + a1 * s1); }
                    { const f32x4 t0 = c0 * dc0 - s0 * ds0, t1 = c1 * dc1 - s1 * ds1; s0 = s0 * dc0 + c0 * ds0; s1 = s1 * dc1 + c1 * ds1; c0 = t0; c1 = t1; } }
                if (ai == 0) {
#pragma unroll
                    for (int k = 0; k < 4; ++k) { const f32x4 t0 = c0 * dc0 - s0 * ds0, t1 = c1 * dc1 - s1 * ds1; s0 = s0 * dc0 + c0 * ds0; s1 = s1 * dc1 + c1 * ds1; c0 = t0; c1 = t1; } }
            }
        }
    }
};
template <int BR> struct EpiMergeF {
    static constexpr bool PERM = true, AFTER_DRAIN = false;
    const bf16_t* G; bf16_t* MG;
    __device__ __forceinline__ void operator()(const f32x4 (&acc)[2][2][4][2], const Unit& u, int wr, int wc, int fr, int fq) const {
        const int row0 = u.pm * BM + wr * 64 + fr, col0 = u.pn * BM + 32 * wc + 8 * fq;
#pragma unroll
        for (int ai = 0; ai < 2; ++ai)
#pragma unroll
            for (int m = 0; m < 4; ++m) { const int r = row0 + ai * HALF + m * 16; const bf16_t* gp = G + (size_t)r * 2048 + BR * 1024 + col0; bf16_t* op = MG + (size_t)r * 1024 + col0;
#pragma unroll
                for (int bj = 0; bj < 2; ++bj) { const u32x4 g = *(const u32x4*)(gp + bj * HALF);
                    f32x4 v0 = bf_lo4(g) * acc[ai][bj][m][0], v1 = bf_hi4(g) * acc[ai][bj][m][1];
                    if (BR == 1) { const u32x4 o = *(const u32x4*)(op + bj * HALF); v0 = v0 + bf_lo4(o); v1 = v1 + bf_hi4(o); }
                    *(u32x4*)(op + bj * HALF) = pack8_bf16(v0, v1); } }
    }
};
struct EpiWoF {
    static constexpr bool PERM = true, AFTER_DRAIN = false;
    const float* x; float* X1; bf16_t* X1B; float* SS2;
    __device__ __forceinline__ void operator()(const f32x4 (&acc)[2][2][4][2], const Unit& u, int wr, int wc, int fr, int fq) const {
        const int row0 = u.pm * BM + wr * 64 + fr, col0 = u.pn * BM + 32 * wc + 8 * fq;
#pragma unroll
        for (int ai = 0; ai < 2; ++ai)
#pragma unroll
            for (int m = 0; m < 4; ++m) { const int r = row0 + ai * HALF + m * 16; const size_t o = (size_t)r * 1024 + col0; float ss = 0.f;
#pragma unroll
                for (int bj = 0; bj < 2; ++bj) { const f32x4 r0 = *(const f32x4*)(x + o + bj * HALF) + acc[ai][bj][m][0], r1 = *(const f32x4*)(x + o + bj * HALF + 4) + acc[ai][bj][m][1];
                    *(f32x4*)(X1 + o + bj * HALF) = r0; *(f32x4*)(X1 + o + bj * HALF + 4) = r1; *(u32x4*)(X1B + o + bj * HALF) = pack8_bf16(r0, r1);
                    ss += (r0[0] * r0[0] + r0[1] * r0[1]) + (r0[2] * r0[2] + r0[3] * r0[3]) + (r1[0] * r1[0] + r1[1] * r1[1]) + (r1[2] * r1[2] + r1[3] * r1[3]); }
                ss += __shfl_xor(ss, 16); ss += __shfl_xor(ss, 32);
                if (fq == 0) SS2[(size_t)r * 16 + u.pn * 4 + wc] = ss; }
    }
};
struct EpiFF1F {
    static constexpr bool PERM = true, AFTER_DRAIN = false;
    const float* SS2; bf16_t* H;
    __device__ __forceinline__ void operator()(const f32x4 (&acc)[2][2][4][2], const Unit& u, int wr, int wc, int fr, int fq) const {
        const int row0 = u.pm * BM + wr * 64 + fr, col0 = u.pn * BM + 32 * wc + 8 * fq;
#pragma unroll
        for (int ai = 0; ai < 2; ++ai)
#pragma unroll
            for (int m = 0; m < 4; ++m) { const int r = row0 + ai * HALF + m * 16; const f32x4* sp = (const f32x4*)(SS2 + (size_t)r * 16);
                const f32x4 t = (sp[0] + sp[1]) + (sp[2] + sp[3]); const float rq = 1.0f / (((t[0] + t[1]) + (t[2] + t[3])) * (1.0f / 1024.f) + EPS);
                bf16_t* hp = H + (size_t)r * 4096 + col0;
#pragma unroll
                for (int bj = 0; bj < 2; ++bj) { f32x4 v0 = __builtin_elementwise_max(acc[ai][bj][m][0], (f32x4){0.f, 0.f, 0.f, 0.f}), v1 = __builtin_elementwise_max(acc[ai][bj][m][1], (f32x4){0.f, 0.f, 0.f, 0.f});
                    v0 = v0 * v0 * rq; v1 = v1 * v1 * rq; *(u32x4*)(hp + bj * HALF) = pack8_bf16(v0, v1); } }
    }
};
struct EpiFF2F {
    static constexpr bool PERM = true, AFTER_DRAIN = false;
    float* X;
    __device__ __forceinline__ void operator()(const f32x4 (&acc)[2][2][4][2], const Unit& u, int wr, int wc, int fr, int fq) const {
        const int row0 = u.pm * BM + wr * 64 + fr, col0 = u.pn * BM + 32 * wc + 8 * fq;
#pragma unroll
        for (int ai = 0; ai < 2; ++ai)
#pragma unroll
            for (int m = 0; m < 4; ++m) { float* p = X + (size_t)(row0 + ai * HALF + m * 16) * 1024 + col0;
#pragma unroll
                for (int bj = 0; bj < 2; ++bj) { const f32x4 r0 = *(const f32x4*)(p + bj * HALF) + acc[ai][bj][m][0], r1 = *(const f32x4*)(p + bj * HALF + 4) + acc[ai][bj][m][1];
                    *(f32x4*)(p + bj * HALF) = r0; *(f32x4*)(p + bj * HALF + 4) = r1; } }
    }
};
}

#include <hip/hip_bf16.h>
#include <cmath>
namespace attn_body {
using bf16=__hip_bfloat16;
using bf16x8=__attribute__((ext_vector_type(8)))short;
using s16x4=__attribute__((ext_vector_type(4)))short;
using f32x16=__attribute__((ext_vector_type(16)))float;
using u32x4=__attribute__((ext_vector_type(4)))unsigned;
constexpr int BATCH=8,NHEAD=8,SEQ=4096,D=64,DM=NHEAD*D;
constexpr int NW=8,QBLK=32,QB=QBLK*NW,KVBLK=64,NQB=SEQ/QB;
constexpr int ATTN_PITCH=DM, ATTN_UNIT_ROWS=QB;
__device__ __forceinline__ int crow(int r,int hi){return (r&3)+8*(r>>2)+4*hi;}
#define SBAR() __builtin_amdgcn_sched_barrier(0)
constexpr int NSLOT=3, SLOTB=8192;
constexpr int LDS_K=0, LDS_V=NSLOT*SLOTB, LDS_WS=2*NSLOT*SLOTB, LDS_OST=LDS_WS+NW*64*4, LDS_MASK=LDS_OST+NW*4096, LDS_BYTES=LDS_MASK+NW*768;
constexpr float C2=0.125f*1.4426950408889634f;
__device__ __forceinline__ void glds16(const void*gsrc,unsigned lds_dst){unsigned keep;
  asm volatile("s_mov_b32 %0, m0\n\ts_mov_b32 m0, %2\n\ts_nop 0\n\tglobal_load_lds_dwordx4 %1, off\n\ts_mov_b32 m0, %0":"=&s"(keep):"v"(gsrc),"s"(lds_dst):"memory");}
__device__ __forceinline__ void glds4(const void*gsrc,unsigned lds_dst){unsigned keep;
  asm volatile("s_mov_b32 %0, m0\n\ts_mov_b32 m0, %2\n\ts_nop 0\n\tglobal_load_lds_dword %1, off\n\ts_mov_b32 m0, %0":"=&s"(keep):"v"(gsrc),"s"(lds_dst):"memory");}
__device__ __forceinline__ float mk1(float x,unsigned m,int pos){return __uint_as_float(__float_as_uint(x)&(unsigned)__builtin_amdgcn_sbfe((int)m,pos,1));}
__device__ __forceinline__ float max3f(float a,float b,float c){float r;asm("v_max3_f32 %0, %1, %2, %3":"=v"(r):"v"(a),"v"(b),"v"(c));return r;}
__device__ __forceinline__ float max2f(float a,float b){float r;asm("v_max_f32_e32 %0, %1, %2":"=v"(r):"v"(a),"v"(b));return r;}
__device__ __forceinline__ float fadd_s(float a,float b){float r;asm("v_add_f32_e32 %0, %1, %2":"=v"(r):"v"(a),"v"(b));return r;}
__device__ __forceinline__ float fsub_s(float a,float b){float r;asm("v_sub_f32_e32 %0, %1, %2":"=v"(r):"v"(a),"v"(b));return r;}
typedef float f32x2_t __attribute__((ext_vector_type(2))); typedef __bf16 bf16x2_t __attribute__((ext_vector_type(2)));
__device__ __forceinline__ unsigned cvtpk_s(float lo,float hi){f32x2_t v={lo,hi};bf16x2_t b=__builtin_convertvector(v,bf16x2_t);return __builtin_bit_cast(unsigned,b);}
#define WAIT_BAR(N) asm volatile("s_waitcnt vmcnt(" #N ") lgkmcnt(0)\n\ts_barrier":::"memory")

__device__ __forceinline__ void qkt(f32x16&p0,f32x16&p1,const char*Kslot,const bf16x8*qr,const f32x16&negm,int r32,int hi){
  const char*kb=Kslot+hi*1024+r32*16;
  #pragma unroll
  for(int d0=0;d0<4;++d0){
    const bf16x8 b0=*reinterpret_cast<const bf16x8*>(kb+d0*2048);
    const bf16x8 b1=*reinterpret_cast<const bf16x8*>(kb+d0*2048+512);
    if(d0==0){p0=__builtin_amdgcn_mfma_f32_32x32x16_bf16(b0,qr[0],negm,0,0,0);p1=__builtin_amdgcn_mfma_f32_32x32x16_bf16(b1,qr[0],negm,0,0,0);}
    else{p0=__builtin_amdgcn_mfma_f32_32x32x16_bf16(b0,qr[d0],p0,0,0,0);p1=__builtin_amdgcn_mfma_f32_32x32x16_bf16(b1,qr[d0],p1,0,0,0);}}
}
typedef __attribute__((address_space(3))) const char* lds_cptr;
typedef short v4i16_t __attribute__((ext_vector_type(4)));
__device__ __forceinline__ void kload8(bf16x8*kf,lds_cptr kp){
  kf[0]=*(const __attribute__((address_space(3))) bf16x8*)(kp);      kf[1]=*(const __attribute__((address_space(3))) bf16x8*)(kp+512);
  kf[2]=*(const __attribute__((address_space(3))) bf16x8*)(kp+2048); kf[3]=*(const __attribute__((address_space(3))) bf16x8*)(kp+2560);
  kf[4]=*(const __attribute__((address_space(3))) bf16x8*)(kp+4096); kf[5]=*(const __attribute__((address_space(3))) bf16x8*)(kp+4608);
  kf[6]=*(const __attribute__((address_space(3))) bf16x8*)(kp+6144); kf[7]=*(const __attribute__((address_space(3))) bf16x8*)(kp+6656);
}
__device__ __forceinline__ void kload2(bf16x8*kf,lds_cptr kp,int j){ kf[2*j]=*(const __attribute__((address_space(3))) bf16x8*)(kp+j*2048); kf[2*j+1]=*(const __attribute__((address_space(3))) bf16x8*)(kp+j*2048+512); }
__device__ __forceinline__ s16x4 vtr(lds_cptr p){ return __builtin_bit_cast(s16x4,__builtin_amdgcn_ds_read_tr16_b64_v4i16((__attribute__((address_space(3))) v4i16_t*)p)); }
__device__ __forceinline__ float rowmax(const f32x16&p0,const f32x16&p1){
  float a=max3f(p0[0],p0[1],p1[0]),b=max3f(p0[2],p0[3],p1[1]);a=max3f(a,p1[2],p1[3]);
  #pragma unroll
  for(int r=4;r<16;r+=4){a=max3f(a,p0[r],p0[r+1]);b=max3f(b,p0[r+2],p0[r+3]);a=max3f(a,p1[r],p1[r+1]);b=max3f(b,p1[r+2],p1[r+3]);}
  const float m=max2f(a,b);
  auto rr=__builtin_amdgcn_permlane32_swap(__float_as_uint(m),__float_as_uint(m),false,false);
  return max2f(__uint_as_float(rr[0]),__uint_as_float(rr[1]));
}
__device__ __forceinline__ void pv(f32x16*o,int vb,bf16x8 pa0,bf16x8 pa1,bf16x8 pa2,bf16x8 pa3){
  #pragma unroll
  for(int d0=0;d0<2;++d0){s16x4 lo[4],hi[4];
    #pragma unroll
    for(int ks=0;ks<4;++ks){
      asm volatile("ds_read_b64_tr_b16 %0,%1 offset:%c2":"=&v"(lo[ks]):"v"(vb),"i"(d0*4096+ks*1024):"memory");
      asm volatile("ds_read_b64_tr_b16 %0,%1 offset:%c2":"=&v"(hi[ks]):"v"(vb),"i"(d0*4096+ks*1024+512):"memory");}
    asm volatile("s_waitcnt lgkmcnt(0)":::"memory");SBAR();
    #define PK(k) (bf16x8){lo[k][0],lo[k][1],lo[k][2],lo[k][3],hi[k][0],hi[k][1],hi[k][2],hi[k][3]}
    o[d0]=__builtin_amdgcn_mfma_f32_32x32x16_bf16(pa0,PK(0),o[d0],0,0,0);
    o[d0]=__builtin_amdgcn_mfma_f32_32x32x16_bf16(pa1,PK(1),o[d0],0,0,0);
    o[d0]=__builtin_amdgcn_mfma_f32_32x32x16_bf16(pa2,PK(2),o[d0],0,0,0);
    o[d0]=__builtin_amdgcn_mfma_f32_32x32x16_bf16(pa3,PK(3),o[d0],0,0,0);
    #undef PK
  }
}

#ifndef ATTN_STORE16
#define ATTN_STORE16(p,v) (*(u32x4*)(p)=(v))
#endif
template<int THRL> __device__ __forceinline__ void attn_unit(int b,int h,int qb,const bf16*Q,const bf16*__restrict__ K,const bf16*__restrict__ V,bf16*O,const unsigned long long*MK,char*shm){
  const int tid=threadIdx.x,lane=tid&63,r32=lane&31,hi=lane>>5; const int wid=__builtin_amdgcn_readfirstlane(tid>>6);
  const long rowbase=(long)b*SEQ; const int q0=qb*QB;
  const bf16*Qw=Q+(rowbase+q0+wid*QBLK)*DM+h*D;
  const bf16*Kh=K+rowbase*DM+h*D,*Vh=V+rowbase*DM+h*D;
  const unsigned lds0=(unsigned)(uintptr_t)shm;
  float*wsf=(float*)(shm+LDS_WS)+wid*64;
  const bf16*ksrc=Kh+(long)lane*DM+wid*8;
  const bf16*vsrc=Vh+(long)(16*(wid&3)+(lane>>2))*DM+(wid>>2)*32+(lane&3)*8;
  const unsigned kdst=lds0+LDS_K+wid*1024, vdst=lds0+LDS_V+wid*1024;
  #define DMA_K(t,slot) glds16(ksrc+(long)(t)*KVBLK*DM,(unsigned)__builtin_amdgcn_readfirstlane(kdst+(slot)))
  #define DMA_V(t,slot) glds16(vsrc+(long)(t)*KVBLK*DM,(unsigned)__builtin_amdgcn_readfirstlane(vdst+(slot)))
  const char*msrc=(const char*)MK+((size_t)b*64*SEQ+q0+wid*QBLK)*8+lane*4;
  const unsigned mdst=lds0+LDS_MASK+wid*768;
  #define DMA_M(t,slot) glds4(msrc+(size_t)(t)*SEQ*8,(unsigned)__builtin_amdgcn_readfirstlane(mdst+((slot)>>5)))
  typedef __attribute__((address_space(3))) const unsigned long long* lds_u64p;
  const lds_cptr mp0=(lds_cptr)shm+LDS_MASK+wid*768+8*r32;
  unsigned mlo,mhi;
  #define MRD(slot) do{ const unsigned long long mw_=*(lds_u64p)(mp0+((slot)>>5)); mlo=((unsigned)mw_)>>(4*hi); mhi=((unsigned)(mw_>>32))>>(4*hi); }while(0)
  const int vb0=(int)(lds0+LDS_V)+((lane>>4)&1)*32+(lane&3)*8+(4*hi+((lane&15)>>2))*64;
  const char*Kbase=shm+LDS_K; bf16x8 kf[8];
  const lds_cptr shm3=(lds_cptr)shm; const lds_cptr kp0=shm3+LDS_K+hi*1024+r32*16; const lds_cptr vp0=shm3+LDS_V+((lane>>4)&1)*32+(lane&3)*8+(4*hi+((lane&15)>>2))*64;
  const int NT=(q0+QB)/KVBLK;
  DMA_M(0,0);DMA_K(0,0);DMA_V(0,0);DMA_K(1,SLOTB);
  bf16x8 qr[4];
  #pragma unroll
  for(int d0=0;d0<4;++d0)qr[d0]=*reinterpret_cast<const bf16x8*>(&Qw[(long)r32*DM+d0*16+hi*8]);
  float mhat=0.f,l_reg=0.f;f32x16 o[2];o[0]=f32x16{};o[1]=f32x16{};f32x16 negm=f32x16{};asm volatile("":"+v"(negm));
  const int qrel=wid*QBLK+r32;
  bool resc=false;
  #define START(P0,P1) do{ const float rm=rowmax(P0,P1); resc=false; \
    { const float dl=rm; mhat=fadd_s(mhat,dl); \
      _Pragma("unroll") for(int r=0;r<16;++r){P0[r]=fsub_s(P0[r],dl);P1[r]=fsub_s(P1[r],dl);} \
      _Pragma("unroll") for(int r=0;r<16;++r)negm[r]=-mhat; asm volatile("":"+v"(negm)); } \
    _Pragma("unroll") for(int r=0;r<16;++r)P0[r]=__builtin_amdgcn_exp2f(P0[r]); }while(0)
  #define RESC() do{ if(resc){ asm volatile("s_waitcnt lgkmcnt(0)":::"memory"); \
      _Pragma("unroll") for(int d_=0;d_<2;++d_) _Pragma("unroll") for(int r=0;r<16;++r)o[d_][r]*=wsf[crow(r,hi)]; } }while(0)
  f32x16 pA0,pA1,pB0,pB1;
  int sl_prev=0,sl_cur=0,sl_next=SLOTB;
  #define ROT() do{sl_prev=sl_cur;sl_cur=sl_next;sl_next=(sl_next==(NSLOT-1)*SLOTB)?0:sl_next+SLOTB;}while(0)
  DMA_K(2,2*SLOTB);
  WAIT_BAR(3);
  qkt(pA0,pA1,Kbase,qr,negm,r32,hi);asm volatile("s_nop 15\n\ts_nop 7":"+v"(pA0),"+v"(pA1));
  START(pA0,pA1);
  _Pragma("unroll") for(int r=0;r<16;++r)pA1[r]=__builtin_amdgcn_exp2f(pA1[r]);
  MRD(0);
  _Pragma("unroll") for(int r=0;r<16;++r){pA0[r]=mk1(pA0[r],mlo,(r&3)+8*(r>>2));pA1[r]=mk1(pA1[r],mhi,(r&3)+8*(r>>2));}
  WAIT_BAR(0);
  DMA_M(1,SLOTB);DMA_M(2,2*SLOTB);DMA_K(3,0);DMA_V(1,SLOTB);
  ROT();
  kload8(kf,kp0+sl_cur);
  WAIT_BAR(2);
  s16x4 vlo[8],vhi[8]; u32x4 pw0,pw1,pw2,pw3;
  #define PKW(P,B) cvtpk_s(P[B],P[B+1])
  #define PAF(k) __builtin_bit_cast(bf16x8,pw##k)
  #define VFR(i) (bf16x8){vlo[i][0],vlo[i][1],vlo[i][2],vlo[i][3],vhi[i][0],vhi[i][1],vhi[i][2],vhi[i][3]}
  #define PIN(x) asm volatile("":"+v"(x))
  #define MX3(a,b,c) __builtin_fmaxf(__builtin_fmaxf((a),(b)),(c))
  #define GAPA(MF,A0,A1,A2,A3,W0,W1,PW) do{ MF; sacc+=A0; sacc+=A1; sacc+=A2; sacc+=A3; PIN(sacc); W0; W1; PIN(PW); SBAR(); }while(0)
  #define EX(v) __builtin_amdgcn_exp2f(v)
  #define GAPB(MF,X,B,MW) do{ MF; X[B]=mk1(EX(X[B]),MW,2*(B)); X[B+1]=mk1(EX(X[B+1]),MW,2*(B)+1); X[B+2]=mk1(EX(X[B+2]),MW,2*(B)+2); X[B+3]=mk1(EX(X[B+3]),MW,2*(B)+3); PIN(X); SBAR(); }while(0)
  #define VRD(i) do{ vlo[i]=vtr(vp_+(((i)>>2)*4096+((i)&3)*1024)); vhi[i]=vtr(vp_+(((i)>>2)*4096+((i)&3)*1024+512)); }while(0)
  #define KRD(G,j) do{ if(G){ kload2(kf,kp0+sl_next,j); SBAR(); } }while(0)
  #define STEP(C0,C1,P0,P1,t,GK,GV,GL,GM) do{ SBAR(); \
    const lds_cptr vp_=vp0+sl_prev; MRD(sl_cur); \
    VRD(0); SBAR(); float sacc=(P0[0]+P0[1]); \
    GAPA(C0=__builtin_amdgcn_mfma_f32_32x32x16_bf16(kf[0],qr[0],negm,0,0,0), P0[2],P0[3],P0[4],P0[5],     pw0[0]=PKW(P0,0), pw0[1]=PKW(P0,2), pw0); \
    VRD(4); SBAR(); GAPA(C1=__builtin_amdgcn_mfma_f32_32x32x16_bf16(kf[1],qr[0],negm,0,0,0), P0[6],P0[7],P0[8],P0[9],     pw0[2]=PKW(P0,4), pw0[3]=PKW(P0,6), pw0); \
    VRD(1); SBAR(); GAPA(C0=__builtin_amdgcn_mfma_f32_32x32x16_bf16(kf[2],qr[1],C0,0,0,0),   P0[10],P0[11],P0[12],P0[13], pw1[0]=PKW(P0,8), pw1[1]=PKW(P0,10), pw1); \
    VRD(5); SBAR(); GAPA(C1=__builtin_amdgcn_mfma_f32_32x32x16_bf16(kf[3],qr[1],C1,0,0,0),   P0[14],P0[15],P1[0],P1[1],   pw1[2]=PKW(P0,12),pw1[3]=PKW(P0,14), pw1); \
    VRD(2); SBAR(); GAPA(C0=__builtin_amdgcn_mfma_f32_32x32x16_bf16(kf[4],qr[2],C0,0,0,0),   P1[2],P1[3],P1[4],P1[5],     pw2[0]=PKW(P1,0), pw2[1]=PKW(P1,2), pw2); \
    VRD(6); SBAR(); GAPA(C1=__builtin_amdgcn_mfma_f32_32x32x16_bf16(kf[5],qr[2],C1,0,0,0),   P1[6],P1[7],P1[8],P1[9],     pw2[2]=PKW(P1,4), pw2[3]=PKW(P1,6), pw2); \
    VRD(3); SBAR(); GAPA(C0=__builtin_amdgcn_mfma_f32_32x32x16_bf16(kf[6],qr[3],C0,0,0,0),   P1[10],P1[11],P1[12],P1[13], pw3[0]=PKW(P1,8), pw3[1]=PKW(P1,10), pw3); \
    VRD(7); SBAR(); GAPA(C1=__builtin_amdgcn_mfma_f32_32x32x16_bf16(kf[7],qr[3],C1,0,0,0),   P1[14],P1[15],0.f,0.f,       pw3[2]=PKW(P1,12),pw3[3]=PKW(P1,14), pw3); \
    l_reg+=sacc; \
    if(GK){DMA_K((t)+3,sl_cur);} if(GV){DMA_V((t)+1,sl_next);} if(GM){DMA_M((t)+2,sl_prev);} \
    { float a=MX3(C0[0],C0[1],C1[0]),b=MX3(C0[2],C0[3],C1[1]); a=MX3(a,C1[2],C1[3]); \
      _Pragma("unroll") for(int r=4;r<16;r+=4){a=MX3(a,C0[r],C0[r+1]);b=MX3(b,C0[r+2],C0[r+3]);a=MX3(a,C1[r],C1[r+1]);b=MX3(b,C1[r+2],C1[r+3]);} \
      float rm=__builtin_fmaxf(a,b); { auto rr=__builtin_amdgcn_permlane32_swap(__float_as_uint(rm),__float_as_uint(rm),false,false); rm=__builtin_fmaxf(__uint_as_float(rr[0]),__uint_as_float(rr[1])); } \
      resc=false; \
      if(__builtin_expect(__any(rm>(float)THRL),0)){ const float dl=__builtin_fmaxf(rm,0.f); mhat+=dl; \
        _Pragma("unroll") for(int r=0;r<16;++r){C0[r]-=dl;C1[r]-=dl;} \
        _Pragma("unroll") for(int r=0;r<16;++r)negm[r]=-mhat; asm volatile("":"+v"(negm)); \
        const float f=__builtin_amdgcn_exp2f(-dl); l_reg*=f; if(hi==0)wsf[r32]=f; resc=true; } } \
    SBAR(); \
    GAPB(o[0]=__builtin_amdgcn_mfma_f32_32x32x16_bf16(PAF(0),VFR(0),o[0],0,0,0), C0,0,mlo); \
    GAPB(o[1]=__builtin_amdgcn_mfma_f32_32x32x16_bf16(PAF(0),VFR(4),o[1],0,0,0), C0,4,mlo); \
    KRD(GL,0); GAPB(o[0]=__builtin_amdgcn_mfma_f32_32x32x16_bf16(PAF(1),VFR(1),o[0],0,0,0), C0,8,mlo); \
    KRD(GL,1); GAPB(o[1]=__builtin_amdgcn_mfma_f32_32x32x16_bf16(PAF(1),VFR(5),o[1],0,0,0), C0,12,mlo); \
    KRD(GL,2); GAPB(o[0]=__builtin_amdgcn_mfma_f32_32x32x16_bf16(PAF(2),VFR(2),o[0],0,0,0), C1,0,mhi); \
    KRD(GL,3); GAPB(o[1]=__builtin_amdgcn_mfma_f32_32x32x16_bf16(PAF(2),VFR(6),o[1],0,0,0), C1,4,mhi); \
    GAPB(o[0]=__builtin_amdgcn_mfma_f32_32x32x16_bf16(PAF(3),VFR(3),o[0],0,0,0), C1,8,mhi); \
    GAPB(o[1]=__builtin_amdgcn_mfma_f32_32x32x16_bf16(PAF(3),VFR(7),o[1],0,0,0), C1,12,mhi); \
    }while(0)
  int t=1;
  for(;t+5<NT;t+=2){
    STEP(pB0,pB1,pA0,pA1,t,true,true,true,true);     WAIT_BAR(3); RESC(); ROT();
    STEP(pA0,pA1,pB0,pB1,t+1,true,true,true,true);   WAIT_BAR(3); RESC(); ROT();
  }
  #define ENDW(tt) do{ if((tt)+3<NT){WAIT_BAR(3);} else if((tt)+2<NT){WAIT_BAR(2);} else {WAIT_BAR(0);} }while(0)
  for(;t+1<NT;t+=2){
    STEP(pB0,pB1,pA0,pA1,t,(t+3<NT),(t+1<NT),(t+1<NT),(t+2<NT));       ENDW(t);   RESC(); ROT();
    STEP(pA0,pA1,pB0,pB1,t+1,(t+4<NT),(t+2<NT),(t+2<NT),(t+3<NT));     ENDW(t+1); RESC(); ROT();
  }
  STEP(pB0,pB1,pA0,pA1,NT-1,false,false,false,false); RESC();
  { float sacc=pB0[0]+pB0[1]; _Pragma("unroll") for(int r=2;r<16;++r)sacc+=pB0[r]; _Pragma("unroll") for(int r=0;r<16;++r)sacc+=pB1[r]; l_reg+=sacc;
    pw0=(u32x4){PKW(pB0,0),PKW(pB0,2),PKW(pB0,4),PKW(pB0,6)};pw1=(u32x4){PKW(pB0,8),PKW(pB0,10),PKW(pB0,12),PKW(pB0,14)};pw2=(u32x4){PKW(pB1,0),PKW(pB1,2),PKW(pB1,4),PKW(pB1,6)};pw3=(u32x4){PKW(pB1,8),PKW(pB1,10),PKW(pB1,12),PKW(pB1,14)};
    SBAR(); pv(o,vb0+sl_cur,PAF(0),PAF(1),PAF(2),PAF(3)); }
  #undef PKW
  #undef PAF
  #undef VFR
  #undef PIN
  #undef MX3
  #undef GAPA
  #undef GAPB
  #undef EX
  #undef VRD
  #undef KRD
  #undef STEP
  #undef ENDW
  {auto rr=__builtin_amdgcn_permlane32_swap(__float_as_uint(l_reg),__float_as_uint(l_reg),false,false);l_reg=__uint_as_float(rr[0])+__uint_as_float(rr[1]);}
  if(hi==0)wsf[32+r32]=l_reg;asm volatile("s_waitcnt lgkmcnt(0)":::"memory");
  float rli[16];
  #pragma unroll
  for(int r=0;r<16;++r)rli[r]=__builtin_amdgcn_rcpf(wsf[32+crow(r,hi)]);
  bf16*Ow=O+(rowbase+q0+wid*QBLK)*DM+h*D;
  { bf16*stg=(bf16*)(shm+LDS_OST)+wid*2048;
    #pragma unroll
    for(int r=0;r<16;++r){const int orow=crow(r,hi);
      #pragma unroll
      for(int d0=0;d0<2;++d0)stg[orow*64+d0*32+r32]=__float2bfloat16(o[d0][r]*rli[r]);}
    asm volatile("s_waitcnt lgkmcnt(0)":::"memory");
    #pragma unroll
    for(int i=0;i<4;++i){const int row=i*8+(lane>>3),ch=lane&7; const u32x4 v=*(const u32x4*)(stg+row*64+ch*8); ATTN_STORE16(Ow+(long)row*DM+ch*8,v);} }
  asm volatile("s_waitcnt lgkmcnt(0)\n\ts_barrier":::"memory");
  #undef DMA_K
  #undef DMA_V
  #undef DMA_M
  #undef MRD
  #undef START
  #undef RESC
  #undef ROT
}
constexpr int ATTN_LDS_BYTES=LDS_BYTES;
struct AttnTensors { const bf16* Q; const bf16* K; const bf16* V; bf16* O; const unsigned long long* MK; };
struct AttnUnit { int bh; int qb; };
struct StaticOrder {
  int vcu, G;
  __device__ __forceinline__ explicit StaticOrder(int grid,int block):vcu((grid%8==0)?(block%8)*(grid/8)+block/8:block),G(grid){}
  __device__ __forceinline__ bool next(int i,AttnUnit&u)const{
    if(G==256){ if(i>=4)return false; const int s=vcu&3; u.bh=vcu>>2; u.qb=(i==0)?s:(i==1)?15-s:(i==2)?4+s:11-s; return true; }
    const int id=i*G+vcu; if(id>=BATCH*NHEAD*NQB)return false; u.bh=id/NQB; u.qb=NQB-1-(id%NQB); return true; }
  __device__ __forceinline__ void a_ready(const AttnUnit&)const{}
  __device__ __forceinline__ void done(const AttnUnit&)const{}
};
template<class Sched,int THRL=8> __device__ __forceinline__ void attn_phase(char*lds,const AttnTensors&T,const Sched&S){
  AttnUnit u;
  for(int i=0;S.next(i,u);++i){ S.a_ready(u); attn_unit<THRL>(u.bh/NHEAD,u.bh%NHEAD,u.qb,T.Q,T.K,T.V,T.O,T.MK,lds); S.done(u); }
}
#undef SBAR
#undef WAIT_BAR
}

__global__ void __launch_bounds__(NT, 2) fwd_kernel(Args args) {
    extern __shared__ __attribute__((aligned(16))) unsigned char lds[];
    Frame F;
    F.lds = (LAS unsigned char*)lds;
    F.tid = threadIdx.x; F.lane = F.tid & 63; F.wave = __builtin_amdgcn_readfirstlane(F.tid >> 6);
    F.gw = blockIdx.x * NWAVES + F.wave; F.ngw = gridDim.x * NWAVES;
    F.x = args.in[0]; F.norm1_g = args.in[1]; F.w_in = args.in[2]; F.w_s = args.in[3]; F.b_s = args.in[4]; F.ln_g = args.in[5]; F.ln_b = args.in[6];
    F.w_out_a = args.in[7]; F.w_out_b = args.in[8]; F.w_o = args.in[9]; F.norm2_g = args.in[10]; F.w_ff_in = args.in[11]; F.w_ff_out = args.in[12]; F.norm_f_g = args.in[13];
    F.out = args.out; F.ws = args.ws;
    unsigned char* ws = args.ws;
    F.COS = (float*)(ws + WS_COS); F.SIN = (float*)(ws + WS_SIN); F.RS1 = (float*)(ws + WS_RS1); F.RS2 = (float*)(ws + WS_RS2); F.WI = (float*)(ws + WS_WI); F.SS2 = (float*)(ws + WS_SS2);
    F.WSB = (bf16_t*)(ws + WS_WSB); F.WIN = (bf16_t*)(ws + WS_WIN); F.WA = (bf16_t*)(ws + WS_WA); F.WB = (bf16_t*)(ws + WS_WB); F.WO = (bf16_t*)(ws + WS_WO);
    F.W1 = (bf16_t*)(ws + WS_W1); F.W2 = (bf16_t*)(ws + WS_W2); F.XB = (bf16_t*)(ws + WS_XB); F.U = (bf16_t*)(ws + WS_U); F.VG = (bf16_t*)(ws + WS_VG);
    F.Q = (bf16_t*)(ws + WS_Q); F.K = (bf16_t*)(ws + WS_K); F.V = (bf16_t*)(ws + WS_V); F.G = (bf16_t*)(ws + WS_G); F.X1B = (bf16_t*)(ws + WS_X1B); F.HID = (bf16_t*)(ws + WS_HID);
    F.QI = (unsigned short*)(ws + WS_QI); F.KI = (unsigned short*)(ws + WS_KI); F.MASK = (unsigned long long*)(ws + WS_MASK);
    const int lo = args.ph_lo, hi = args.ph_hi;
#define IN(k) (lo <= (k) && (k) < hi)
#define SEAM(k) do { if (IN(k) && IN((k) + 1)) { __threadfence(); cg::this_grid().sync(); } } while (0)
    if (IN(0)) p0_prologue(F);
    SEAM(0);
#define GEMM_FAST(EPI_T, EPI_INIT, AP, BP, NN, KK) do { pg8::Gemm g{AP, BP, M, NN, KK}; pg8::StaticOrder S; S.init(M, NN, (int)gridDim.x, (int)blockIdx.x); EPI_T E EPI_INIT; \
        pg8::gemm_phase<EPI_T, pg8::StaticOrder, PG8_ALIGN, PG8_SP2>(F.lds, g, S, E); } while (0)
    if (IN(1)) {
#if FAST_G1
        GEMM_FAST(pg8::EpiProjF, ({F.ws}), F.XB, F.WIN, NP, 1024);
#else
        EpiProj E{F.RS1, F.COS, F.SIN, F.U, F.VG, F.Q, F.K, F.V, F.G, F.QI, F.KI, F.WI}; sgemm(F.XB, F.WIN, M, NP, 1024, E, F.gw, F.ngw, F.lane);
#endif
    }
    SEAM(1);
    if (IN(2)) {
#if FAST_SGU
        sgu_fast(F);
#else
        sgu_simple(F);
#endif
        __syncthreads();
#if FAST_IDX
        indexer_fast(F);
#else
        indexer_simple(F);
#endif
    }
    SEAM(2);
    if (IN(3)) {
#if FAST_ATTN
        const attn_body::AttnTensors AT{(const attn_body::bf16*)F.Q, (const attn_body::bf16*)F.K, (const attn_body::bf16*)F.V, (attn_body::bf16*)F.Q, F.MASK};
        const attn_body::StaticOrder S((int)gridDim.x, (int)blockIdx.x);
        attn_body::attn_phase<attn_body::StaticOrder>((char*)lds, AT, S);
#else
        attn_simple(F);
#endif
    }
    SEAM(3);
#if FAST_MERGE
    if (IN(4)) { GEMM_FAST(pg8::EpiMergeF<0>, ({F.G, F.XB}), F.U, F.WA, 1024, 512); }
    if (IN(5)) { __syncthreads(); GEMM_FAST(pg8::EpiMergeF<1>, ({F.G, F.XB}), F.Q, F.WB, 1024, 512); }
#else
    if (IN(4)) { EpiMergeA E{F.G, F.XB}; sgemm(F.U, F.WA, M, 1024, 512, E, F.gw, F.ngw, F.lane); }
    SEAM(4);
    if (IN(5)) { EpiMergeB E{F.G, F.XB}; sgemm(F.Q, F.WB, M, 1024, 512, E, F.gw, F.ngw, F.lane); }
#endif
    SEAM(5);
    if (IN(6)) {
#if FAST_WO
        GEMM_FAST(pg8::EpiWoF, ({F.x, F.out, F.X1B, F.SS2}), F.XB, F.WO, 1024, 1024);
#else
        EpiWo E{F.x, F.out, F.X1B}; sgemm(F.XB, F.WO, M, 1024, 1024, E, F.gw, F.ngw, F.lane);
#endif
    }
    SEAM(6);
#if !(FAST_WO && FAST_FF1)
    if (IN(7)) rs2_rows(F);
    SEAM(7);
#endif
    if (IN(8)) {
#if FAST_FF1
        GEMM_FAST(pg8::EpiFF1F, ({F.SS2, F.HID}), F.X1B, F.W1, 4096, 1024);
#else
        EpiFF1 E{F.RS2, F.HID}; sgemm(F.X1B, F.W1, M, 4096, 1024, E, F.gw, F.ngw, F.lane);
#endif
    }
    SEAM(8);
    if (IN(9)) {
#if FAST_FF2
        GEMM_FAST(pg8::EpiFF2F, ({F.out}), F.HID, F.W2, 1024, 4096);
#else
        EpiFF2 E{F.out}; sgemm(F.HID, F.W2, M, 1024, 4096, E, F.gw, F.ngw, F.lane);
#endif
    }
    SEAM(9);
    if (IN(10)) final_norm(F);
#undef SEAM
#undef IN
}

extern "C" void kernel_launch(void* const* d_in, const int* in_sizes, int n_in, void* d_out, int out_size, void* d_ws, size_t ws_size, hipStream_t stream) {
    static int grid = 0;
    if (grid == 0) {
        if (n_in != 14 || out_size != M * D || ws_size < WS_END) { fprintf(stderr, "kernel_launch: unexpected shapes (n_in %d out %d ws %zu)\n", n_in, out_size, ws_size); grid = -1; return; }
        int dev = 0, cus = 0, per_cu = 0;
        hipGetDevice(&dev); hipDeviceGetAttribute(&cus, hipDeviceAttributeMultiprocessorCount, dev);
        hipFuncSetAttribute((const void*)fwd_kernel, hipFuncAttributeMaxDynamicSharedMemorySize, LDS_BYTES);
        hipOccupancyMaxActiveBlocksPerMultiprocessor(&per_cu, (const void*)fwd_kernel, NT, LDS_BYTES);
        if (per_cu < 1) { fprintf(stderr, "kernel_launch: occupancy query says %d blocks per CU\n", per_cu); per_cu = 1; }
        (void)hipGetLastError();
        grid = cus * (per_cu < 1 ? 1 : 1);
    }
    if (grid < 0) return;
    Args a{};
    for (int i = 0; i < 14; ++i) a.in[i] = (const float*)d_in[i];
    a.out = (float*)d_out; a.ws = (unsigned char*)d_ws;
#if ONE_LAUNCH
    a.ph_lo = 0; a.ph_hi = 11;
    void* kargs[] = {&a};
    hipError_t e = hipLaunchCooperativeKernel((const void*)fwd_kernel, dim3(grid), dim3(NT), kargs, LDS_BYTES, stream);
    if (e != hipSuccess) fprintf(stderr, "cooperative launch failed: %s (grid %d)\n", hipGetErrorString(e), grid);
#else
    for (int ph = 0; ph <= 10; ++ph) {
        a.ph_lo = ph; a.ph_hi = ph + 1;
        hipLaunchKernelGGL(fwd_kernel, dim3(grid), dim3(NT), LDS_BYTES, stream, a);
    }
#endif
}
```

```cpp
#include <hip/hip_runtime.h>
#include <hip/hip_cooperative_groups.h>
#include <cstdio>
#include <cstdint>

namespace cg = cooperative_groups;
#ifndef ONE_LAUNCH
#define ONE_LAUNCH 1
#endif
#ifndef FAST_G1
#define FAST_G1 1
#endif
#ifndef USE_CG_SYNC
#define USE_CG_SYNC 0
#endif
#ifndef FAST_ATTN
#define FAST_ATTN 1
#endif
#ifndef FAST_SGU
#define FAST_SGU 1
#endif
#ifndef FAST_IDX
#define FAST_IDX 1
#endif
#ifndef FAST_MERGE
#define FAST_MERGE 1
#endif
#ifndef FAST_WO
#define FAST_WO 1
#endif
#ifndef FAST_FF1
#define FAST_FF1 1
#endif
#ifndef FAST_FF2
#define FAST_FF2 1
#endif
#define LAS __attribute__((address_space(3)))
typedef unsigned short bf16_t;
typedef short bf16x8 __attribute__((ext_vector_type(8)));
typedef _Float16 f16x8 __attribute__((ext_vector_type(8)));
typedef float f32x4 __attribute__((ext_vector_type(4)));
typedef float f32x2 __attribute__((ext_vector_type(2)));
typedef unsigned u32x4 __attribute__((ext_vector_type(4)));
typedef unsigned u32x2 __attribute__((ext_vector_type(2)));

constexpr int BATCH = 8, SEQ = 4096, D = 1024, M = BATCH * SEQ;
constexpr int DIN = 5192, NP = 5376;
constexpr int FF = 4096;
constexpr float EPS = 1e-6f;
constexpr float IDX_SCALE = 0.04419417382415922f;
constexpr float C2 = 0.125f * 1.4426950408889634f;
constexpr int NWAVES = 8, NT = NWAVES * 64;
constexpr int LDS_BYTES = 147456;

constexpr size_t MiB = 1u << 20;
constexpr size_t WS_CTL = 0;
constexpr size_t WS_COS = 1 * MiB;
constexpr size_t WS_SIN = WS_COS + 512 * 1024;
constexpr size_t WS_RS1 = 2 * MiB;
constexpr size_t WS_RS2 = WS_RS1 + 128 * 1024;
constexpr size_t WS_WI = 3 * MiB;
constexpr size_t WS_WSB = 4 * MiB;
constexpr size_t WS_WIN = 5 * MiB;
constexpr size_t WS_WA = 16 * MiB;
constexpr size_t WS_WB = 17 * MiB;
constexpr size_t WS_WO = 18 * MiB;
constexpr size_t WS_W1 = 20 * MiB;
constexpr size_t WS_W2 = 28 * MiB;
constexpr size_t WS_SS2 = 36 * MiB;
constexpr size_t WS_XB = 40 * MiB;
constexpr size_t WS_U = 104 * MiB;
constexpr size_t WS_VG = 136 * MiB;
constexpr size_t WS_Q = 168 * MiB;
constexpr size_t WS_K = 200 * MiB;
constexpr size_t WS_V = 232 * MiB;
constexpr size_t WS_QI = 264 * MiB;
constexpr size_t WS_KI = 296 * MiB;
constexpr size_t WS_MASK = 300 * MiB;
constexpr size_t WS_G = 316 * MiB;
constexpr size_t WS_X1B = 444 * MiB;
constexpr size_t WS_HID = 104 * MiB;
constexpr size_t WS_END = 508 * MiB;

__device__ __forceinline__ unsigned f2bf(float f) { unsigned u = __float_as_uint(f); return (u + 0x7fffu + ((u >> 16) & 1u)) >> 16; }
__device__ __forceinline__ float bf2f(unsigned b) { return __uint_as_float(b << 16); }
__device__ __forceinline__ unsigned pk2(float lo, float hi) { return f2bf(lo) | (f2bf(hi) << 16); }
__device__ __forceinline__ unsigned short f2h(float f) { _Float16 h = (_Float16)f; return __builtin_bit_cast(unsigned short, h); }
__device__ __forceinline__ float h2f(unsigned b) { return (float)__builtin_bit_cast(_Float16, (unsigned short)b); }
__device__ __forceinline__ float wave_sum(float v) {
#pragma unroll
    for (int o = 1; o < 64; o <<= 1) v += __shfl_xor(v, o);
    return v;
}
__device__ __forceinline__ unsigned wave_sum_u(unsigned v) {
#pragma unroll
    for (int o = 1; o < 64; o <<= 1) v += (unsigned)__shfl_xor((int)v, o);
    return v;
}
__device__ __forceinline__ float gelu_tanh(float x) {
    const float z = 1.5957691216057308f * (x + 0.044715f * x * x * x);
    return x / (1.0f + __builtin_amdgcn_exp2f(-1.4426950408889634f * z));
}
__device__ __forceinline__ float sigmoidf(float x) { return 1.0f / (1.0f + __builtin_amdgcn_exp2f(-1.4426950408889634f * x)); }
__device__ __forceinline__ unsigned ukey(float f) { const unsigned u = __float_as_uint(f); return (u & 0x80000000u) ? ~u : (u | 0x80000000u); }

struct Args { const float* in[14]; float* out; unsigned char* ws; int ph_lo, ph_hi; };

struct Frame {
    LAS unsigned char* lds;
    int tid, lane, wave, gw, ngw;
    const float *x, *norm1_g, *w_in, *w_s, *b_s, *ln_g, *ln_b, *w_out_a, *w_out_b, *w_o, *norm2_g, *w_ff_in, *w_ff_out, *norm_f_g;
    float* out; unsigned char* ws;
    float *COS, *SIN, *RS1, *RS2, *WI, *SS2;
    bf16_t *WSB, *WIN, *WA, *WB, *WO, *W1, *W2, *XB, *U, *VG, *Q, *K, *V, *G, *X1B, *HID;
    unsigned short *QI, *KI;
    unsigned long long* MASK;
};

__device__ __forceinline__ void win_group(int n0, int& src, int& nv) {
    const int pn = n0 >> 8, p = n0 & 255;
    nv = 32;
    if (pn < 4) { src = n0; }
    else if (pn < 8 || (pn >= 10 && pn < 12)) {
        const int base = (pn < 6) ? 1024 + 256 * (pn - 4) : (pn < 8) ? 1536 + 256 * (pn - 6) : 2560 + 256 * (pn - 10);
        src = base + 64 * ((p & 127) >> 5) + 32 * (p >> 7);
    } else if (pn < 10) { src = n0; }
    else if (pn == 12) {
        if (p < 32) src = 3072; else if (p < 64) { src = 3136; nv = 8; } else if (p >= 128 && p < 160) src = 3104; else { src = 0; nv = 0; }
    } else { src = 3144 + (n0 - 3328); }
}
__device__ __forceinline__ void transpose_item(const float* W, int K, int N, int src0, int nv, const float* kscale, bf16_t* WT, int dstrow0, LAS float* scr, int k0, int lane) {
    const int c = lane & 31;
#pragma unroll 8
    for (int i = 0; i < 32; ++i) {
        const int kk = 2 * i + (lane >> 5);
        float v = (c < nv) ? W[(size_t)(k0 + kk) * N + src0 + c] : 0.f;
        if (kscale) v *= kscale[k0 + kk];
        scr[kk * 33 + c] = v;
    }
    asm volatile("s_waitcnt lgkmcnt(0)" ::: "memory");
    const int c8 = lane & 7;
#pragma unroll
    for (int j = 0; j < 4; ++j) {
        const int n = (lane >> 3) + 8 * j; const LAS float* s = scr + (8 * c8) * 33 + n;
        u32x4 o; o.x = pk2(s[0 * 33], s[1 * 33]); o.y = pk2(s[2 * 33], s[3 * 33]); o.z = pk2(s[4 * 33], s[5 * 33]); o.w = pk2(s[6 * 33], s[7 * 33]);
        *(u32x4*)(WT + (size_t)(dstrow0 + n) * K + k0 + 8 * c8) = o;
    }
    asm volatile("s_waitcnt lgkmcnt(0)" ::: "memory");
}
__device__ __forceinline__ void p0_prologue(Frame& F) {
    LAS float* scr = (LAS float*)(F.lds + F.wave * 8704);
    constexpr int I_WIN = 16 * (NP / 32), I_WA = 8 * 32, I_WB = 8 * 32, I_WO = 16 * 32, I_W1 = 16 * 128, I_W2 = 64 * 32;
    constexpr int NITEMS = I_WIN + I_WA + I_WB + I_WO + I_W1 + I_W2;
    for (int it = F.gw; it < NITEMS; it += F.ngw) {
        int r = it;
        if (r < I_WIN) { const int nb = r % (NP / 32), kb = r / (NP / 32); int src, nv; win_group(nb * 32, src, nv);
            transpose_item(F.w_in, 1024, DIN, src, nv, F.norm1_g, F.WIN, nb * 32, scr, kb * 64, F.lane); continue; } r -= I_WIN;
        if (r < I_WA) { const int nb = r % 32, kb = r / 32; transpose_item(F.w_out_a, 512, 1024, nb * 32, 32, nullptr, F.WA, nb * 32, scr, kb * 64, F.lane); continue; } r -= I_WA;
        if (r < I_WB) { const int nb = r % 32, kb = r / 32; transpose_item(F.w_out_b, 512, 1024, nb * 32, 32, nullptr, F.WB, nb * 32, scr, kb * 64, F.lane); continue; } r -= I_WB;
        if (r < I_WO) { const int nb = r % 32, kb = r / 32; transpose_item(F.w_o, 1024, 1024, nb * 32, 32, nullptr, F.WO, nb * 32, scr, kb * 64, F.lane); continue; } r -= I_WO;
        if (r < I_W1) { const int nb = r % 128, kb = r / 128; transpose_item(F.w_ff_in, 1024, 4096, nb * 32, 32, F.norm2_g, F.W1, nb * 32, scr, kb * 64, F.lane); continue; } r -= I_W1;
        { const int nb = r % 32, kb = r / 32; transpose_item(F.w_ff_out, 4096, 1024, nb * 32, 32, nullptr, F.W2, nb * 32, scr, kb * 64, F.lane); }
    }
    for (int m = F.gw; m < M; m += F.ngw) {
        const f32x4* xr = (const f32x4*)(F.x + (size_t)m * D) + F.lane;
        f32x4 v[4]; float s = 0.f;
#pragma unroll
        for (int j = 0; j < 4; ++j) { v[j] = xr[64 * j]; s += (v[j].x * v[j].x + v[j].y * v[j].y) + (v[j].z * v[j].z + v[j].w * v[j].w); }
        s = wave_sum(s);
        if (F.lane == 0) F.RS1[m] = 1.0f / sqrtf(s * (1.0f / D) + EPS);
        u32x2* o = (u32x2*)(F.XB + (size_t)m * D) + F.lane;
#pragma unroll
        for (int j = 0; j < 4; ++j) { u32x2 w; w.x = pk2(v[j].x, v[j].y); w.y = pk2(v[j].z, v[j].w); o[64 * j] = w; }
    }
    const int gt = F.gw * 64 + F.lane, ngt = F.ngw * 64;
    for (int i = gt; i < SEQ * 32; i += ngt) {
        const int pos = i >> 5, j = i & 31;
        const float inv = (float)pow(10000.0, -(double)j / 32.0);
        const float ang = (float)pos * inv;
        F.COS[i] = (float)cos((double)ang); F.SIN[i] = (float)sin((double)ang);
    }
    for (int i = gt; i < 4 * 128 * 128; i += ngt) { const int t = (i >> 7) & 127, s = i & 127; F.WSB[i] = (bf16_t)f2bf(s <= t ? F.w_s[i] : 0.f); }
}

template <class Epi>
__device__ __forceinline__ void sgemm(const bf16_t* A, const bf16_t* Bt, int Mr, int N, int K, const Epi& epi, int gw, int ngw, int lane) {
    const int c = lane & 15, q = lane >> 4;
    const int ntn = (N / 256) * 4, ntiles = (Mr / 64) * ntn;
    for (int t = gw; t < ntiles; t += ngw) {
        const int tm = t / ntn, r = t % ntn, pn = r >> 2, wc = r & 3;
        const int row0 = tm * 64, col0 = pn * 256 + wc * 32;
        f32x4 acc[4][2][2];
#pragma unroll
        for (int m = 0; m < 4; ++m)
#pragma unroll
            for (int bj = 0; bj < 2; ++bj)
#pragma unroll
                for (int n = 0; n < 2; ++n) acc[m][bj][n] = (f32x4){0.f, 0.f, 0.f, 0.f};
        const bf16_t* ap = A + (size_t)(row0 + c) * K + 8 * q;
        const bf16_t* bp = Bt + (size_t)(col0 + c) * K + 8 * q;
        for (int k0 = 0; k0 < K; k0 += 32) {
            bf16x8 a[4], b[2][2];
#pragma unroll
            for (int m = 0; m < 4; ++m) a[m] = *(const bf16x8*)(ap + (size_t)(16 * m) * K + k0);
#pragma unroll
            for (int bj = 0; bj < 2; ++bj)
#pragma unroll
                for (int n = 0; n < 2; ++n) b[bj][n] = *(const bf16x8*)(bp + (size_t)(128 * bj + 16 * n) * K + k0);
#pragma unroll
            for (int m = 0; m < 4; ++m)
#pragma unroll
                for (int bj = 0; bj < 2; ++bj)
#pragma unroll
                    for (int n = 0; n < 2; ++n) acc[m][bj][n] = __builtin_amdgcn_mfma_f32_16x16x32_bf16(a[m], b[bj][n], acc[m][bj][n], 0, 0, 0);
        }
#pragma unroll
        for (int m = 0; m < 4; ++m)
#pragma unroll
            for (int n = 0; n < 2; ++n)
#pragma unroll
                for (int i = 0; i < 4; ++i) epi(row0 + 16 * m + 4 * q + i, col0 + 16 * n + c, acc[m][0][n][i], acc[m][1][n][i]);
    }
}

struct EpiProj {
    const float *RS1, *COS, *SIN; bf16_t *U, *VG, *Q, *K, *V, *G; unsigned short *QI, *KI; float* WI;
    __device__ __forceinline__ void operator()(int row, int pcol, float a0, float a1) const {
        const float rs = RS1[row]; const float v0 = a0 * rs, v1 = a1 * rs;
        const int pn = pcol >> 8, p = pcol & 255;
        if (pn < 2) { bf16_t* o = U + (size_t)row * 512 + pn * 256 + p; o[0] = (bf16_t)f2bf(gelu_tanh(v0)); o[128] = (bf16_t)f2bf(gelu_tanh(v1)); }
        else if (pn < 4) { bf16_t* o = VG + (size_t)row * 512 + (pn - 2) * 256 + p; o[0] = (bf16_t)f2bf(gelu_tanh(v0)); o[128] = (bf16_t)f2bf(gelu_tanh(v1)); }
        else if (pn < 8 || pn == 10 || pn == 11) {
            const int pos = row & (SEQ - 1), d = p & 31, hit = p >> 5;
            const float cs = COS[pos * 32 + d], sn = SIN[pos * 32 + d];
            const float lo = v0 * cs - v1 * sn, hi = v1 * cs + v0 * sn;
            if (pn < 6) { bf16_t* o = Q + (size_t)row * 512 + (pn - 4) * 256 + hit * 64 + d; o[0] = (bf16_t)f2bf(lo * C2); o[32] = (bf16_t)f2bf(hi * C2); }
            else if (pn < 8) { bf16_t* o = K + (size_t)row * 512 + (pn - 6) * 256 + hit * 64 + d; o[0] = (bf16_t)f2bf(lo); o[32] = (bf16_t)f2bf(hi); }
            else { unsigned short* o = QI + (size_t)row * 512 + (pn - 10) * 256 + hit * 64 + d; o[0] = f2h(lo); o[32] = f2h(hi); }
        }
        else if (pn < 10) { bf16_t* o = V + (size_t)row * 512 + (pn - 8) * 256 + p; o[0] = (bf16_t)f2bf(v0); o[128] = (bf16_t)f2bf(v1); }
        else if (pn == 12) {
            if (p < 32) { const int pos = row & (SEQ - 1); const float cs = COS[pos * 32 + p], sn = SIN[pos * 32 + p];
                unsigned short* o = KI + (size_t)row * 64 + p; o[0] = f2h(v0 * cs - v1 * sn); o[32] = f2h(v1 * cs + v0 * sn); }
            else if (p < 40) { WI[(size_t)row * 8 + (p - 32)] = v0 * IDX_SCALE; }
        }
        else { bf16_t* o = G + (size_t)row * 2048 + (pn - 13) * 256 + p; o[0] = (bf16_t)f2bf(sigmoidf(v0)); o[128] = (bf16_t)f2bf(sigmoidf(v1)); }
    }
};
struct EpiMergeA { const bf16_t* G; bf16_t* MG;
    __device__ __forceinline__ void operator()(int row, int col, float a0, float a1) const {
        const bf16_t* g = G + (size_t)row * 2048 + col; bf16_t* o = MG + (size_t)row * 1024 + col;
        o[0] = (bf16_t)f2bf(bf2f(g[0]) * a0); o[128] = (bf16_t)f2bf(bf2f(g[128]) * a1); } };
struct EpiMergeB { const bf16_t* G; bf16_t* MG;
    __device__ __forceinline__ void operator()(int row, int col, float a0, float a1) const {
        const bf16_t* g = G + (size_t)row * 2048 + 1024 + col; bf16_t* o = MG + (size_t)row * 1024 + col;
        o[0] = (bf16_t)f2bf(bf2f(o[0]) + bf2f(g[0]) * a0); o[128] = (bf16_t)f2bf(bf2f(o[128]) + bf2f(g[128]) * a1); } };
struct EpiWo { const float* x; float* X1; bf16_t* X1B;
    __device__ __forceinline__ void operator()(int row, int col, float a0, float a1) const {
        const size_t o = (size_t)row * 1024 + col; const float r0 = x[o] + a0, r1 = x[o + 128] + a1;
        X1[o] = r0; X1[o + 128] = r1; X1B[o] = (bf16_t)f2bf(r0); X1B[o + 128] = (bf16_t)f2bf(r1); } };
struct EpiFF1 { const float* RS2; bf16_t* H;
    __device__ __forceinline__ void operator()(int row, int col, float a0, float a1) const {
        const float rs = RS2[row]; const float h0 = fmaxf(a0 * rs, 0.f), h1 = fmaxf(a1 * rs, 0.f);
        bf16_t* o = H + (size_t)row * 4096 + col; o[0] = (bf16_t)f2bf(h0 * h0); o[128] = (bf16_t)f2bf(h1 * h1); } };
struct EpiFF2 { float* X;
    __device__ __forceinline__ void operator()(int row, int col, float a0, float a1) const {
        const size_t o = (size_t)row * 1024 + col; X[o] += a0; X[o + 128] += a1; } };

__device__ __forceinline__ void sgu_simple(Frame& F) {
    LAS float* vs = (LAS float*)F.lds;
    LAS bf16_t* wsl = (LAS bf16_t*)(F.lds + 65536);
    LAS float* st = (LAS float*)(F.lds + 65536 + 32768);
    for (int bc = blockIdx.x; bc < M / 128; bc += gridDim.x) {
        const int row0 = bc * 128;
        for (int i = 0; i < 16; ++i) {
            const int r = F.wave * 16 + i;
            const u32x4 w = *(const u32x4*)(F.VG + (size_t)(row0 + r) * 512 + F.lane * 8);
            float v[8]; v[0] = bf2f(w.x & 0xffff); v[1] = bf2f(w.x >> 16); v[2] = bf2f(w.y & 0xffff); v[3] = bf2f(w.y >> 16);
            v[4] = bf2f(w.z & 0xffff); v[5] = bf2f(w.z >> 16); v[6] = bf2f(w.w & 0xffff); v[7] = bf2f(w.w >> 16);
            float s = 0.f;
#pragma unroll
            for (int j = 0; j < 8; ++j) s += v[j];
            const float mean = wave_sum(s) * (1.f / 512.f); float q = 0.f;
#pragma unroll
            for (int j = 0; j < 8; ++j) { const float d = v[j] - mean; q += d * d; }
            const float rstd = 1.0f / sqrtf(wave_sum(q) * (1.f / 512.f) + EPS);
            if (F.lane == 0) { st[2 * r] = mean; st[2 * r + 1] = rstd; }
        }
        __syncthreads();
        for (int g = 0; g < 4; ++g) {
            for (int idx = F.tid; idx < 16384; idx += NT) {
                const int s = idx >> 7, d = idx & 127;
                const float v = bf2f(F.VG[(size_t)(row0 + s) * 512 + g * 128 + d]);
                vs[idx] = (v - st[2 * s]) * st[2 * s + 1] * F.ln_g[g * 128 + d] + F.ln_b[g * 128 + d];
                wsl[idx] = F.WSB[g * 16384 + idx];
            }
            __syncthreads();
            for (int idx = F.tid; idx < 16384; idx += NT) {
                const int t = idx >> 7, d = idx & 127; float acc = 0.f;
                for (int s = 0; s <= t; ++s) acc += bf2f(wsl[t * 128 + s]) * vs[s * 128 + d];
                const float sf = acc + F.b_s[g * 128 + t];
                bf16_t* u = F.U + (size_t)(row0 + t) * 512 + g * 128 + d;
                *u = (bf16_t)f2bf(bf2f(*u) * sf);
            }
            __syncthreads();
        }
    }
}

__device__ __forceinline__ void indexer_simple(Frame& F) {
    LAS float* sc = (LAS float*)F.lds;
    LAS float* qf = (LAS float*)(F.lds + 16384);
    LAS float* wl = (LAS float*)(F.lds + 16384 + 2048);
    LAS unsigned* cnt = (LAS unsigned*)(F.lds + 16384 + 2048 + 64);
    LAS unsigned* eqc = (LAS unsigned*)(F.lds + 20480);
    for (int r = blockIdx.x; r < M; r += gridDim.x) {
        const int t = r & (SEQ - 1), b = r >> 12;
        unsigned char* mrow = (unsigned char*)(F.MASK + ((size_t)(b * 64 + (F.tid >> 3)) * SEQ + t)) + (F.tid & 7);
        if (t < 255) {
            unsigned m = 0;
#pragma unroll
            for (int i = 0; i < 8; ++i) m |= ((8 * F.tid + i) <= t) ? (1u << i) : 0u;
            *mrow = (unsigned char)m;
            continue;
        }
        qf[F.tid] = h2f(F.QI[(size_t)r * 512 + F.tid]);
        if (F.tid < 8) wl[F.tid] = F.WI[(size_t)r * 8 + F.tid];
        if (F.tid == 0) { cnt[0] = 0; cnt[1] = 0; }
        __syncthreads();
        for (int s = F.tid; s < SEQ; s += NT) {
            float score = 0.f;
            if (s <= t) {
                const unsigned short* kp = F.KI + (size_t)(b * SEQ + s) * 64;
                float kf[64];
#pragma unroll
                for (int j = 0; j < 8; ++j) { const u32x4 w = *(const u32x4*)(kp + 8 * j);
                    kf[8 * j + 0] = h2f(w.x & 0xffff); kf[8 * j + 1] = h2f(w.x >> 16); kf[8 * j + 2] = h2f(w.y & 0xffff); kf[8 * j + 3] = h2f(w.y >> 16);
                    kf[8 * j + 4] = h2f(w.z & 0xffff); kf[8 * j + 5] = h2f(w.z >> 16); kf[8 * j + 6] = h2f(w.w & 0xffff); kf[8 * j + 7] = h2f(w.w >> 16); }
#pragma unroll 1
                for (int h = 0; h < 8; ++h) {
                    float dot = 0.f;
#pragma unroll
                    for (int d = 0; d < 64; ++d) dot += qf[h * 64 + d] * kf[d];
                    score += wl[h] * fmaxf(dot, 0.f);
                }
            }
            sc[s] = score;
        }
        __syncthreads();
        unsigned key[8];
#pragma unroll
        for (int i = 0; i < 8; ++i) { const int s = 8 * F.tid + i; key[i] = (s <= t) ? ukey(sc[s]) : 0u; }
        unsigned lo = 1u, hi = 0xFFFFFFFFu; int it = 0;
        while (hi - lo > 1u) {
            const unsigned mid = lo + ((hi - lo) >> 1);
            unsigned c = 0;
#pragma unroll
            for (int i = 0; i < 8; ++i) c += (key[i] >= mid) ? 1u : 0u;
            c = wave_sum_u(c);
            __syncthreads();
            if (F.tid == 0) cnt[(it + 1) & 1] = 0;
            if (F.lane == 0) atomicAdd((unsigned*)&cnt[it & 1], c);
            __syncthreads();
            const unsigned tot = cnt[it & 1];
            if (tot >= 256u) lo = mid; else hi = mid;
            ++it;
        }
        const unsigned T = lo;
        unsigned cgt = 0, ceq = 0;
#pragma unroll
        for (int i = 0; i < 8; ++i) { cgt += (key[i] > T) ? 1u : 0u; ceq += (key[i] == T) ? 1u : 0u; }
        eqc[F.tid] = ceq;
        const unsigned cg = wave_sum_u(cgt);
        __syncthreads();
        if (F.tid == 0) cnt[(it + 1) & 1] = 0;
        if (F.lane == 0) atomicAdd((unsigned*)&cnt[it & 1], cg);
        __syncthreads();
        const unsigned need = 256u - cnt[it & 1];
        unsigned before = 0;
        for (int j = 0; j < F.tid; ++j) before += eqc[j];
        unsigned m = 0;
#pragma unroll
        for (int i = 0; i < 8; ++i) {
            bool sel = key[i] > T;
            if (key[i] == T) { sel = before < need; ++before; }
            m |= sel ? (1u << i) : 0u;
        }
        *mrow = (unsigned char)m;
        __syncthreads();
    }
}

__device__ __forceinline__ void attn_simple(Frame& F) {
    for (int task = F.gw; task < M * 8; task += F.ngw) {
        const int row = task >> 3, h = task & 7, t = row & (SEQ - 1), b = row >> 12;
        const float q = bf2f(F.Q[(size_t)row * 512 + h * 64 + F.lane]);
        float m = -INFINITY, l = 0.f, acc = 0.f;
        for (int tile = 0; tile <= (t >> 6); ++tile) {
            unsigned long long w = F.MASK[(size_t)(b * 64 + tile) * SEQ + t];
            w = (unsigned long long)(unsigned)__builtin_amdgcn_readfirstlane((unsigned)w) | ((unsigned long long)(unsigned)__builtin_amdgcn_readfirstlane((unsigned)(w >> 32)) << 32);
            while (w) {
                const int i = __builtin_ctzll(w); w &= w - 1;
                const size_t kr = (size_t)(b * SEQ + tile * 64 + i) * 512 + h * 64 + F.lane;
                const float logit = wave_sum(q * bf2f(F.K[kr]));
                const float mn = fmaxf(m, logit), scl = __builtin_amdgcn_exp2f(m - mn), pe = __builtin_amdgcn_exp2f(logit - mn);
                l = l * scl + pe; acc = acc * scl + pe * bf2f(F.V[kr]); m = mn;
            }
        }
        F.Q[(size_t)row * 512 + h * 64 + F.lane] = (bf16_t)f2bf(acc / l);
    }
}

__device__ __forceinline__ void rs2_rows(Frame& F) {
    for (int m = F.gw; m < M; m += F.ngw) {
        const f32x4* xr = (const f32x4*)(F.out + (size_t)m * D) + F.lane; float s = 0.f;
#pragma unroll
        for (int j = 0; j < 4; ++j) { const f32x4 v = xr[64 * j]; s += (v.x * v.x + v.y * v.y) + (v.z * v.z + v.w * v.w); }
        s = wave_sum(s);
        if (F.lane == 0) F.RS2[m] = 1.0f / sqrtf(s * (1.0f / D) + EPS);
        if (F.lane < 16) F.SS2[(size_t)m * 16 + F.lane] = F.lane == 0 ? s : 0.f;
    }
}
__device__ __forceinline__ void final_norm(Frame& F) {
    for (int m = F.gw; m < M; m += F.ngw) {
        f32x4* xr = (f32x4*)(F.out + (size_t)m * D) + F.lane; f32x4 v[4]; float s = 0.f;
#pragma unroll
        for (int j = 0; j < 4; ++j) { v[j] = xr[64 * j]; s += (v[j].x * v[j].x + v[j].y * v[j].y) + (v[j].z * v[j].z + v[j].w * v[j].w); }
        const float rs = 1.0f / sqrtf(wave_sum(s) * (1.0f / D) + EPS);
#pragma unroll
        for (int j = 0; j < 4; ++j) { const f32x4 g = *((const f32x4*)F.norm_f_g + F.lane + 64 * j); xr[64 * j] = v[j] * rs * g; }
    }
}


typedef float f32x16 __attribute__((ext_vector_type(16)));
__device__ __forceinline__ void indexer_fast(Frame& F) {
    LAS float* sc = (LAS float*)F.lds;
    const int lane = F.lane, w = F.wave, c = lane & 31, hf = lane >> 5;
    const int qr = ((c >> 2) & 1) * 2 + (c >> 4), hr = (c & 3) + 4 * ((c >> 3) & 1);
    for (int g = blockIdx.x; g < BATCH * (SEQ / 8); g += gridDim.x) {
        const int b = g & 7, t0 = (g >> 3) * 8, t = t0 + w;
        const size_t rowbase = (size_t)b * SEQ;
        unsigned long long myword = 0ull;
        if (t0 + 7 <= 255) {
            const int jm = t >> 6;
            myword = lane < jm ? ~0ull : (lane == jm ? ((2ull << (t & 63)) - 1ull) : 0ull);
        } else {
            float wq[2][2][8];
#pragma unroll
            for (int s = 0; s < 2; ++s)
#pragma unroll
                for (int g2 = 0; g2 < 2; ++g2) { const f32x4* wp = (const f32x4*)(F.WI + (rowbase + t0 + 4 * s + 2 * hf + g2) * 8); const f32x4 a = wp[0], bb = wp[1];
                    wq[s][g2][0] = a[0]; wq[s][g2][1] = a[1]; wq[s][g2][2] = a[2]; wq[s][g2][3] = a[3]; wq[s][g2][4] = bb[0]; wq[s][g2][5] = bb[1]; wq[s][g2][6] = bb[2]; wq[s][g2][7] = bb[3]; }
            f16x8 af[2][4];
#pragma unroll
            for (int s = 0; s < 2; ++s)
#pragma unroll
                for (int ks = 0; ks < 4; ++ks) af[s][ks] = *(const f16x8*)(F.QI + (rowbase + t0 + 4 * s + qr) * 512 + hr * 64 + 16 * ks + 8 * hf);
            const int ntile = (t0 + 8 + 31) >> 5;
            for (int tile = w; tile < ntile; tile += 8) {
                const unsigned short* kp = F.KI + (rowbase + tile * 32 + c) * 64 + 8 * hf;
                f16x8 bfr[4];
#pragma unroll
                for (int ks = 0; ks < 4; ++ks) bfr[ks] = *(const f16x8*)(kp + 16 * ks);
#pragma unroll
                for (int s = 0; s < 2; ++s) {
                    f32x16 d = {0.f, 0.f, 0.f, 0.f, 0.f, 0.f, 0.f, 0.f, 0.f, 0.f, 0.f, 0.f, 0.f, 0.f, 0.f, 0.f};
#pragma unroll
                    for (int ks = 0; ks < 4; ++ks) d = __builtin_amdgcn_mfma_f32_32x32x16_f16(af[s][ks], bfr[ks], d, 0, 0, 0);
#pragma unroll
                    for (int g2 = 0; g2 < 2; ++g2) { float sco = 0.f;
#pragma unroll
                        for (int h = 0; h < 8; ++h) sco += wq[s][g2][h] * fmaxf(d[8 * g2 + h], 0.f);
                        sc[(4 * s + 2 * hf + g2) * 4096 + tile * 32 + c] = sco; }
                }
            }
            __syncthreads();
            unsigned key[64];
            const int jm = t >> 6;
#pragma unroll
            for (int blk = 0; blk < 4; ++blk) {
                if (jm >= 16 * blk) {
#pragma unroll
                    for (int jj = 0; jj < 16; ++jj) { const int j = 16 * blk + jj, idx = j * 64 + lane; const float v = sc[w * 4096 + idx]; key[j] = (idx <= t) ? ukey(v) : 0u; }
                } else {
#pragma unroll
                    for (int jj = 0; jj < 16; ++jj) key[16 * blk + jj] = 0u;
                }
            }
            unsigned lo = 1u, hi = 0xFFFFFFFFu; bool exact = false;
            while (hi - lo > 1u) {
                const unsigned mid = lo + ((hi - lo) >> 1);
                unsigned cnt = 0;
#pragma unroll
                for (int blk = 0; blk < 4; ++blk) if (jm >= 16 * blk) {
#pragma unroll
                    for (int jj = 0; jj < 16; ++jj) cnt += (unsigned)__builtin_popcountll(__ballot(key[16 * blk + jj] >= mid)); }
                if (cnt == 256u) { lo = mid; exact = true; break; }
                if (cnt > 256u) lo = mid; else hi = mid;
            }
            const unsigned T = lo;
            if (exact) {
#pragma unroll
                for (int j = 0; j < 64; ++j) { const unsigned long long m = __ballot(key[j] >= T); if (lane == j) myword = m; }
            } else {
                unsigned cgt = 0;
#pragma unroll
                for (int j = 0; j < 64; ++j) cgt += (unsigned)__builtin_popcountll(__ballot(key[j] > T));
                unsigned need = 256u - cgt;
#pragma unroll
                for (int j = 0; j < 64; ++j) { const unsigned long long gt = __ballot(key[j] > T); unsigned long long eq = __ballot(key[j] == T), take = 0ull;
                    while (need != 0u && eq != 0ull) { const unsigned long long low = eq & (0ull - eq); take |= low; eq ^= low; --need; }
                    if (lane == j) myword = gt | take; }
            }
            __syncthreads();
        }
        F.MASK[((size_t)(b * 64 + lane)) * SEQ + t] = myword;
    }
}

__device__ __forceinline__ void sgu_fast(Frame& F) {
    constexpr int PITCH = 136;
    LAS bf16_t* vT = (LAS bf16_t*)F.lds;
    LAS float* st = (LAS float*)(F.lds + 128 * PITCH * 2);
    const int lane = F.lane, w = F.wave, fr = lane & 15, fq = lane >> 4;
    for (int bc = blockIdx.x; bc < M / 128; bc += gridDim.x) {
        const int row0 = bc * 128;
        for (int i = 0; i < 16; ++i) {
            const int r = w * 16 + i;
            const u32x4 ww = *(const u32x4*)(F.VG + (size_t)(row0 + r) * 512 + lane * 8);
            float v[8]; v[0] = bf2f(ww.x & 0xffff); v[1] = bf2f(ww.x >> 16); v[2] = bf2f(ww.y & 0xffff); v[3] = bf2f(ww.y >> 16);
            v[4] = bf2f(ww.z & 0xffff); v[5] = bf2f(ww.z >> 16); v[6] = bf2f(ww.w & 0xffff); v[7] = bf2f(ww.w >> 16);
            float s = 0.f;
#pragma unroll
            for (int j = 0; j < 8; ++j) s += v[j];
            const float mean = wave_sum(s) * (1.f / 512.f); float q = 0.f;
#pragma unroll
            for (int j = 0; j < 8; ++j) { const float d = v[j] - mean; q += d * d; }
            const float rstd = 1.0f / sqrtf(wave_sum(q) * (1.f / 512.f) + EPS);
            if (lane == 0) { st[2 * r] = mean; st[2 * r + 1] = rstd; }
        }
        __syncthreads();
        const int tb = w >> 1, dh = w & 1;
        for (int g = 0; g < 4; ++g) {
#pragma unroll
            for (int i = 0; i < 4; ++i) { const int idx = F.tid + NT * i, s = idx & 127, d8 = (idx >> 7) * 8;
                const u32x4 ww = *(const u32x4*)(F.VG + (size_t)(row0 + s) * 512 + g * 128 + d8);
                const f32x4 g0 = *(const f32x4*)(F.ln_g + g * 128 + d8), g1 = *(const f32x4*)(F.ln_g + g * 128 + d8 + 4), b0 = *(const f32x4*)(F.ln_b + g * 128 + d8), b1 = *(const f32x4*)(F.ln_b + g * 128 + d8 + 4);
                const float mean = st[2 * s], rstd = st[2 * s + 1];
                float v[8]; v[0] = bf2f(ww.x & 0xffff); v[1] = bf2f(ww.x >> 16); v[2] = bf2f(ww.y & 0xffff); v[3] = bf2f(ww.y >> 16);
                v[4] = bf2f(ww.z & 0xffff); v[5] = bf2f(ww.z >> 16); v[6] = bf2f(ww.w & 0xffff); v[7] = bf2f(ww.w >> 16);
#pragma unroll
                for (int e = 0; e < 8; ++e) { const float gg = e < 4 ? g0[e & 3] : g1[e & 3], bb = e < 4 ? b0[e & 3] : b1[e & 3];
                    vT[(d8 + e) * PITCH + s] = (bf16_t)f2bf((v[e] - mean) * rstd * gg + bb); } }
            __syncthreads();
            f32x4 acc[4][2];
#pragma unroll
            for (int nd = 0; nd < 4; ++nd)
#pragma unroll
                for (int mt = 0; mt < 2; ++mt) acc[nd][mt] = (f32x4){0.f, 0.f, 0.f, 0.f};
            for (int ks = 0; ks <= tb; ++ks) {
                bf16x8 vf[4], wf[2];
#pragma unroll
                for (int nd = 0; nd < 4; ++nd) vf[nd] = *(const LAS bf16x8*)(vT + (dh * 64 + nd * 16 + fr) * PITCH + ks * 32 + 8 * fq);
#pragma unroll
                for (int mt = 0; mt < 2; ++mt) wf[mt] = *(const bf16x8*)(F.WSB + g * 16384 + (tb * 32 + mt * 16 + fr) * 128 + ks * 32 + 8 * fq);
#pragma unroll
                for (int nd = 0; nd < 4; ++nd)
#pragma unroll
                    for (int mt = 0; mt < 2; ++mt) acc[nd][mt] = __builtin_amdgcn_mfma_f32_16x16x32_bf16(vf[nd], wf[mt], acc[nd][mt], 0, 0, 0);
            }
#pragma unroll
            for (int mt = 0; mt < 2; ++mt) { const int tl = tb * 32 + mt * 16 + fr; const float bs = F.b_s[g * 128 + tl];
#pragma unroll
                for (int nd = 0; nd < 4; ++nd) { bf16_t* up = F.U + (size_t)(row0 + tl) * 512 + g * 128 + dh * 64 + nd * 16 + 4 * fq;
                    const u32x2 uu = *(const u32x2*)up; u32x2 o;
                    o.x = pk2(bf2f(uu.x & 0xffff) * (acc[nd][mt][0] + bs), bf2f(uu.x >> 16) * (acc[nd][mt][1] + bs));
                    o.y = pk2(bf2f(uu.y & 0xffff) * (acc[nd][mt][2] + bs), bf2f(uu.y >> 16) * (acc[nd][mt][3] + bs));
                    *(u32x2*)up = o; } }
            __syncthreads();
        }
    }
}

namespace pg8 {
#define PG8_LAS __attribute__((address_space(3)))
typedef unsigned short bf16_t;
typedef short bf16x8 __attribute__((ext_vector_type(8)));
typedef float f32x4 __attribute__((ext_vector_type(4)));
typedef unsigned u32x4 __attribute__((ext_vector_type(4)));
constexpr int BM = 256, BK = 64, HALF = 128, HTB = HALF * BK * 2  , STAGE_BYTES = 8 * HTB, NXCD = 8, WGM = 8;

__host__ __device__ __forceinline__ int lds_byte(int r, int c) { const int st = (r >> 4) * 2 + (c >> 5), rr = r & 15, cc = c & 31, ob = rr * 64 + cc * 2; return st * 1024 + (ob ^ (((ob >> 9) & 1) << 5)); }
__host__ __device__ __forceinline__ void stage_rc(int b, int& R, int& C) { const int st = b / 1024, sb = b % 1024, swz = sb ^ (((sb >> 9) & 1) << 5); R = (st >> 1) * 16 + swz / 64; C = (st & 1) * 32 + (swz % 64) / 2; }
__host__ __device__ __forceinline__ int perm32(int rho) { const int n = rho >> 4, i = rho & 15; return 8 * (i >> 2) + 4 * n + (i & 3); }

struct Unit { int pm, pn; };
struct Gemm { const bf16_t* A; const bf16_t* Bt; int M, N, K; };

struct StaticOrder {
    int nM, nN, nwg, G, c;
    __host__ __device__ void init(int M, int N, int G_, int c_) { nM = M / BM; nN = N / BM; nwg = nM * nN; G = G_; c = c_; }
    __host__ __device__ bool next(int i, Unit& u) const {
        const long L = (long)i * G + c; if (L >= nwg) return false;
        int wgid = (int)L; { const int q = nwg / NXCD, r = nwg % NXCD, xcd = wgid % NXCD, off = wgid / NXCD; wgid = (xcd < r ? xcd * (q + 1) : r * (q + 1) + (xcd - r) * q) + off; }
        const int nig = WGM * nN, gid = wgid / nig, fm = gid * WGM, gsz = (nM - fm) < WGM ? (nM - fm) : WGM;
        u.pm = fm + ((wgid % nig) % gsz); u.pn = (wgid % nig) / gsz; return true;
    }
    __device__ __forceinline__ void a_ready(const Unit&) const {}
    __device__ __forceinline__ void done(const Unit&) const {}
};
template <class Epi, class Sched, bool ALIGN_EPI = false, bool SP2 = false>
__device__ __forceinline__ void gemm_phase(PG8_LAS unsigned char* lds, const Gemm g, const Sched& S, const Epi& E) {
    const int tid = threadIdx.x, wid = __builtin_amdgcn_readfirstlane(tid >> 6), lane = tid & 63, wr = wid >> 2, wc = wid & 3, fr = lane & 15, fq = lane >> 4;
    const int K = g.K, nt = K / BK;
    unsigned voffA[2], voffB[2];
#pragma unroll
    for (int i = 0; i < 2; ++i) { int R, C; stage_rc(tid * 16 + i * 8192, R, C); const int Rb = Epi::PERM ? ((R & ~31) + perm32(R & 31)) : R;
        voffA[i] = (unsigned)(R * K + C) * 2u; voffB[i] = (unsigned)(Rb * K + C) * 2u; }
    const size_t kstep = (size_t)(BK * 2);
    const size_t hstep = (size_t)HALF * K * 2;
    const size_t tstep = 2 * hstep;
    const unsigned ldsw = (unsigned)wid * 1024u;
    const int aoff = lds_byte(wr * 64 + fr, fq * 8), boff = lds_byte(wc * 32 + fr, fq * 8);
#define PG8_SA(b, h) (((b) * 2 + (h)) * HTB)
#define PG8_SB(b, h) ((4 + (b) * 2 + (h)) * HTB)
#define PG8_STAGE(bufoff, gbase, voff) do { _Pragma("unroll") for (int _i = 0; _i < 2; ++_i) \
        __builtin_amdgcn_global_load_lds((const unsigned*)((const char*)(gbase) + (voff)[_i]), (PG8_LAS unsigned*)(lds + (bufoff) + ldsw + _i * 8192), 16, 0, 0); } while (0)
#define PG8_LDA(dst, b, h) do { _Pragma("unroll") for (int m = 0; m < 4; ++m) _Pragma("unroll") for (int k = 0; k < 2; ++k) dst[m][k] = *(const PG8_LAS bf16x8*)(lds + PG8_SA(b, h) + aoff + m * 2048 + k * 1024); } while (0)
#define PG8_LDB(dst, b, h) do { _Pragma("unroll") for (int n = 0; n < 2; ++n) _Pragma("unroll") for (int k = 0; k < 2; ++k) dst[n][k] = *(const PG8_LAS bf16x8*)(lds + PG8_SB(b, h) + boff + n * 2048 + k * 1024); } while (0)
#define PG8_MMA(ai, bj, At, Bt) do { __builtin_amdgcn_s_setprio(1); _Pragma("unroll") for (int m = 0; m < 4; ++m) _Pragma("unroll") for (int n = 0; n < 2; ++n) _Pragma("unroll") for (int k = 0; k < 2; ++k) \
        acc[ai][bj][m][n] = __builtin_amdgcn_mfma_f32_16x16x32_bf16(Bt[n][k], At[m][k], acc[ai][bj][m][n], 0, 0, 0); __builtin_amdgcn_s_setprio(0); } while (0)
#define PG8_WAIT_V(n) asm volatile("s_waitcnt vmcnt(" #n ")" ::: "memory")
#define PG8_WAIT_L(n) asm volatile("s_waitcnt lgkmcnt(" #n ")" ::: "memory")
#define PG8_BAR __builtin_amdgcn_s_barrier()
#define PG8_SCHED __builtin_amdgcn_sched_barrier(0)
    Unit cur, nxt; int ui = 0;
    if (!S.next(0, cur)) return;
    f32x4 acc[2][2][4][2];
#pragma unroll
    for (int a = 0; a < 2; ++a)
#pragma unroll
        for (int b = 0; b < 2; ++b)
#pragma unroll
            for (int m = 0; m < 4; ++m)
#pragma unroll
                for (int n = 0; n < 2; ++n) acc[a][b][m][n] = (f32x4){0.f, 0.f, 0.f, 0.f};
    bf16x8 At[4][2], B0[2][2], B1[2][2];
    const char* cA = (const char*)g.A + (size_t)cur.pm * tstep; const char* cB = (const char*)g.Bt + (size_t)cur.pn * tstep;
    S.a_ready(cur);
    if constexpr (SP2) {
        PG8_STAGE(PG8_SB(0, 0), cB, voffB); PG8_STAGE(PG8_SB(0, 1), cB + hstep, voffB); PG8_STAGE(PG8_SA(0, 0), cA, voffA); PG8_STAGE(PG8_SA(0, 1), cA + hstep, voffA);
        if (wr == 1) PG8_BAR;
        PG8_WAIT_V(2); PG8_BAR;
        PG8_STAGE(PG8_SB(1, 0), cB + kstep, voffB); PG8_STAGE(PG8_SA(1, 0), cA + kstep, voffA); PG8_STAGE(PG8_SB(1, 1), cB + hstep + kstep, voffB);
        PG8_WAIT_V(6); PG8_BAR;
    } else {
        PG8_STAGE(PG8_SB(0, 0), cB, voffB); PG8_STAGE(PG8_SA(0, 0), cA, voffA); PG8_STAGE(PG8_SB(0, 1), cB + hstep, voffB); PG8_STAGE(PG8_SA(0, 1), cA + hstep, voffA);
        if (wr == 1) PG8_BAR;
        PG8_WAIT_V(4); PG8_BAR;
        PG8_STAGE(PG8_SB(1, 0), cB + kstep, voffB); PG8_STAGE(PG8_SA(1, 0), cA + kstep, voffA); PG8_STAGE(PG8_SB(1, 1), cB + hstep + kstep, voffB);
        PG8_WAIT_V(6); PG8_BAR;
    }
    for (;;) {
        const bool has_next = S.next(ui + 1, nxt);
        const char* nA = has_next ? (const char*)g.A + (size_t)nxt.pm * tstep : cA; const char* nB = has_next ? (const char*)g.Bt + (size_t)nxt.pn * tstep : cB;
        for (int t = 0; t < nt; t += 2) {
            const bool last = (t == nt - 2);
            const char* a1 = cA + (size_t)(t + 1) * kstep;
            const char* a2 = last ? nA : cA + (size_t)(t + 2) * kstep; const char* b2 = last ? nB : cB + (size_t)(t + 2) * kstep;
            const char* a3 = a2 + kstep; const char* b3 = b2 + kstep;
            if (last && has_next) S.a_ready(nxt);
            if constexpr (SP2) {
            PG8_LDB(B0, 0, 0); PG8_LDB(B1, 0, 1); PG8_SCHED; PG8_LDA(At, 0, 0); PG8_STAGE(PG8_SA(1, 1), a1 + hstep, voffA);
            PG8_WAIT_V(8); PG8_WAIT_L(0); PG8_BAR; PG8_MMA(0, 0, At, B0); PG8_MMA(0, 1, At, B1); PG8_BAR; PG8_SCHED;
            PG8_LDA(At, 0, 1); PG8_STAGE(PG8_SB(0, 0), b2, voffB); PG8_STAGE(PG8_SB(0, 1), b2 + hstep, voffB); PG8_STAGE(PG8_SA(0, 0), a2, voffA);
            PG8_WAIT_V(8); PG8_WAIT_L(0); PG8_BAR; PG8_MMA(1, 0, At, B0); PG8_MMA(1, 1, At, B1); PG8_BAR; PG8_SCHED;
            PG8_LDB(B0, 1, 0); PG8_LDB(B1, 1, 1); PG8_SCHED; PG8_LDA(At, 1, 0); PG8_STAGE(PG8_SA(0, 1), a2 + hstep, voffA);
            PG8_WAIT_V(8); PG8_WAIT_L(0); PG8_BAR; PG8_MMA(0, 0, At, B0); PG8_MMA(0, 1, At, B1); PG8_BAR; PG8_SCHED;
            PG8_LDA(At, 1, 1); PG8_STAGE(PG8_SB(1, 0), b3, voffB); PG8_STAGE(PG8_SB(1, 1), b3 + hstep, voffB); PG8_STAGE(PG8_SA(1, 0), a3, voffA);
            PG8_WAIT_V(8); PG8_WAIT_L(0); PG8_BAR; PG8_MMA(1, 0, At, B0); PG8_MMA(1, 1, At, B1); PG8_BAR; PG8_SCHED;
            } else {
            PG8_LDB(B0, 0, 0); PG8_SCHED; PG8_LDA(At, 0, 0); PG8_STAGE(PG8_SA(1, 1), a1 + hstep, voffA);
            PG8_WAIT_L(8); PG8_BAR; PG8_WAIT_L(0); PG8_MMA(0, 0, At, B0); PG8_BAR; PG8_SCHED;
            PG8_LDB(B1, 0, 1); PG8_STAGE(PG8_SB(0, 0), b2, voffB);
            PG8_BAR; PG8_WAIT_L(0); PG8_MMA(0, 1, At, B1); PG8_BAR;
            PG8_LDA(At, 0, 1); PG8_STAGE(PG8_SA(0, 0), a2, voffA);
            PG8_BAR; PG8_WAIT_L(0); PG8_MMA(1, 0, At, B0); PG8_BAR; PG8_SCHED;
            PG8_STAGE(PG8_SB(0, 1), b2 + hstep, voffB);
            PG8_WAIT_V(6); PG8_BAR; PG8_MMA(1, 1, At, B1); PG8_BAR;
            PG8_LDB(B0, 1, 0); PG8_SCHED; PG8_LDA(At, 1, 0); PG8_STAGE(PG8_SA(0, 1), a2 + hstep, voffA);
            PG8_WAIT_L(8); PG8_BAR; PG8_WAIT_L(0); PG8_MMA(0, 0, At, B0); PG8_BAR; PG8_SCHED;
            PG8_LDB(B1, 1, 1); PG8_STAGE(PG8_SB(1, 0), b3, voffB);
            PG8_BAR; PG8_WAIT_L(0); PG8_MMA(0, 1, At, B1); PG8_BAR;
            PG8_LDA(At, 1, 1); PG8_STAGE(PG8_SA(1, 0), a3, voffA);
            PG8_BAR; PG8_WAIT_L(0); PG8_MMA(1, 0, At, B0); PG8_BAR; PG8_SCHED;
            PG8_STAGE(PG8_SB(1, 1), b3 + hstep, voffB);
            PG8_WAIT_V(6); PG8_BAR; PG8_MMA(1, 1, At, B1); PG8_BAR;
            }
        }
        if constexpr (ALIGN_EPI) { if (wr == 0) PG8_BAR; }
        if constexpr (!Epi::AFTER_DRAIN) { E(acc, cur, wr, wc, fr, fq); S.done(cur); }
        if (!has_next) break;
#pragma unroll
        for (int a = 0; a < 2; ++a)
#pragma unroll
            for (int b = 0; b < 2; ++b)
#pragma unroll
                for (int m = 0; m < 4; ++m)
#pragma unroll
                    for (int n = 0; n < 2; ++n) acc[a][b][m][n] = (f32x4){0.f, 0.f, 0.f, 0.f};
        cur = nxt; cA = nA; cB = nB; ++ui;
        if constexpr (ALIGN_EPI) { if (wr == 1) PG8_BAR; }
    }
    PG8_WAIT_V(0);
    if constexpr (!ALIGN_EPI) { if (wr == 0) PG8_BAR; }
    PG8_BAR;
    if constexpr (Epi::AFTER_DRAIN) { E.fused(acc, cur, wr, wc, fr, fq, lds, wid, lane); S.done(cur); }
#undef PG8_SA
#undef PG8_SB
#undef PG8_STAGE
#undef PG8_LDA
#undef PG8_LDB
#undef PG8_MMA
#undef PG8_WAIT_V
#undef PG8_WAIT_L
#undef PG8_BAR
#undef PG8_SCHED
}
}

#define PG8_SP2 true
#define PG8_ALIGN true
namespace pg8 {
__device__ __forceinline__ unsigned cvt_pk_bf16(float lo, float hi) { unsigned r; asm volatile("v_cvt_pk_bf16_f32 %0, %1, %2" : "=v"(r) : "v"(lo), "v"(hi)); return r; }
__device__ __forceinline__ unsigned cvt_pk_f16(float lo, float hi) { const _Float16 a = (_Float16)lo, b = (_Float16)hi; return (unsigned)__builtin_bit_cast(unsigned short, a) | ((unsigned)__builtin_bit_cast(unsigned short, b) << 16); }
__device__ __forceinline__ u32x4 pack8_bf16(const f32x4& a, const f32x4& b) { u32x4 w; w.x = cvt_pk_bf16(a[0], a[1]); w.y = cvt_pk_bf16(a[2], a[3]); w.z = cvt_pk_bf16(b[0], b[1]); w.w = cvt_pk_bf16(b[2], b[3]); return w; }
__device__ __forceinline__ u32x4 pack8_f16(const f32x4& a, const f32x4& b) { u32x4 w; w.x = cvt_pk_f16(a[0], a[1]); w.y = cvt_pk_f16(a[2], a[3]); w.z = cvt_pk_f16(b[0], b[1]); w.w = cvt_pk_f16(b[2], b[3]); return w; }
__device__ __forceinline__ f32x4 bf_lo4(const u32x4& w) { return (f32x4){__uint_as_float(w.x << 16), __uint_as_float(w.x & 0xffff0000u), __uint_as_float(w.y << 16), __uint_as_float(w.y & 0xffff0000u)}; }
__device__ __forceinline__ f32x4 bf_hi4(const u32x4& w) { return (f32x4){__uint_as_float(w.z << 16), __uint_as_float(w.z & 0xffff0000u), __uint_as_float(w.w << 16), __uint_as_float(w.w & 0xffff0000u)}; }
__device__ __forceinline__ f32x4 gelu4(const f32x4& x) { f32x4 r;
#pragma unroll
    for (int i = 0; i < 4; ++i) { const float z = 1.5957691216057308f * (x[i] + 0.044715f * x[i] * x[i] * x[i]); r[i] = x[i] * __builtin_amdgcn_rcpf(1.0f + __builtin_amdgcn_exp2f(-1.4426950408889634f * z)); }
    return r; }
__device__ __forceinline__ f32x4 sigm4(const f32x4& x) { f32x4 r;
#pragma unroll
    for (int i = 0; i < 4; ++i) r[i] = __builtin_amdgcn_rcpf(1.0f + __builtin_amdgcn_exp2f(-1.4426950408889634f * x[i]));
    return r; }

struct EpiProjF {
    static constexpr bool PERM = true, AFTER_DRAIN = false;
    unsigned char* ws;
    __device__ __forceinline__ void operator()(const f32x4 (&acc)[2][2][4][2], const Unit& u, int wr, int wc, int fr, int fq) const {
        const int pn = u.pn, row0 = u.pm * BM + wr * 64 + fr, cb = 32 * wc + 8 * fq;
        const float* RS1 = (const float*)(ws + WS_RS1); const float* COS = (const float*)(ws + WS_COS); const float* SIN = (const float*)(ws + WS_SIN);
        unsigned short* KI = (unsigned short*)(ws + WS_KI); float* WI = (float*)(ws + WS_WI);
        if (pn < 4 || pn == 8 || pn == 9 || pn >= 13) {
            size_t boff; int ld, colt;
            if (pn < 2) { boff = WS_U; ld = 512; colt = pn * 256; } else if (pn < 4) { boff = WS_VG; ld = 512; colt = (pn - 2) * 256; }
            else if (pn < 10) { boff = WS_V; ld = 512; colt = (pn - 8) * 256; } else { boff = WS_G; ld = 2048; colt = (pn - 13) * 256; }
            bf16_t* base = (bf16_t*)(ws + boff);
            const int act = pn < 4 ? 1 : (pn >= 13 ? 2 : 0);
#pragma unroll
            for (int ai = 0; ai < 2; ++ai)
#pragma unroll
                for (int m = 0; m < 4; ++m) { const int r = row0 + ai * HALF + m * 16; const float rs = RS1[r]; bf16_t* rowp = base + (size_t)r * ld + colt + cb;
#pragma unroll
                    for (int bj = 0; bj < 2; ++bj) { f32x4 v0 = acc[ai][bj][m][0] * rs, v1 = acc[ai][bj][m][1] * rs;
                        if (act == 1) { v0 = gelu4(v0); v1 = gelu4(v1); } else if (act == 2) { v0 = sigm4(v0); v1 = sigm4(v1); }
                        *(u32x4*)(rowp + bj * HALF) = pack8_bf16(v0, v1); } }
        } else if (pn == 12) {
            if (wc == 0) {
                const int pos0 = row0 & (SEQ - 1);
                f32x4 c0 = *(const f32x4*)(COS + pos0 * 32 + 8 * fq), c1 = *(const f32x4*)(COS + pos0 * 32 + 8 * fq + 4), s0 = *(const f32x4*)(SIN + pos0 * 32 + 8 * fq), s1 = *(const f32x4*)(SIN + pos0 * 32 + 8 * fq + 4);
                const f32x4 dc0 = *(const f32x4*)(COS + 16 * 32 + 8 * fq), dc1 = *(const f32x4*)(COS + 16 * 32 + 8 * fq + 4), ds0 = *(const f32x4*)(SIN + 16 * 32 + 8 * fq), ds1 = *(const f32x4*)(SIN + 16 * 32 + 8 * fq + 4);
#pragma unroll
                for (int ai = 0; ai < 2; ++ai) {
#pragma unroll
                    for (int m = 0; m < 4; ++m) { const int r = row0 + ai * HALF + m * 16; const float rs = RS1[r];
                        const f32x4 a0 = acc[ai][0][m][0] * rs, a1 = acc[ai][0][m][1] * rs, b0 = acc[ai][1][m][0] * rs, b1 = acc[ai][1][m][1] * rs;
                        unsigned short* rowp = KI + (size_t)r * 64 + 8 * fq;
                        *(u32x4*)rowp = pack8_f16(a0 * c0 - b0 * s0, a1 * c1 - b1 * s1);
                        *(u32x4*)(rowp + 32) = pack8_f16(b0 * c0 + a0 * s0, b1 * c1 + a1 * s1);
                        { const f32x4 t0 = c0 * dc0 - s0 * ds0, t1 = c1 * dc1 - s1 * ds1; s0 = s0 * dc0 + c0 * ds0; s1 = s1 * dc1 + c1 * ds1; c0 = t0; c1 = t1; } }
                    if (ai == 0) {
#pragma unroll
                        for (int k = 0; k < 4; ++k) { const f32x4 t0 = c0 * dc0 - s0 * ds0, t1 = c1 * dc1 - s1 * ds1; s0 = s0 * dc0 + c0 * ds0; s1 = s1 * dc1 + c1 * ds1; c0 = t0; c1 = t1; } }
                }
            } else if (wc == 1) {
                if (fq == 0) {
#pragma unroll
                    for (int ai = 0; ai < 2; ++ai)
#pragma unroll
                        for (int m = 0; m < 4; ++m) { const int r = row0 + ai * HALF + m * 16; const float rs = RS1[r] * IDX_SCALE;
                            *(f32x4*)(WI + (size_t)r * 8) = acc[ai][0][m][0] * rs; *(f32x4*)(WI + (size_t)r * 8 + 4) = acc[ai][0][m][1] * rs; }
                }
            }
        } else {
            const int kind = pn < 6 ? 0 : (pn < 8 ? 1 : 2);
            const int colt = (kind == 0 ? (pn - 4) : kind == 1 ? (pn - 6) : (pn - 10)) * 256 + 64 * wc + 8 * fq;
            unsigned short* base = (unsigned short*)(ws + (kind == 0 ? WS_Q : kind == 1 ? WS_K : WS_QI));
            const float sc = kind == 0 ? C2 : 1.0f;
            const int pos0 = row0 & (SEQ - 1);
            f32x4 c0 = *(const f32x4*)(COS + pos0 * 32 + 8 * fq), c1 = *(const f32x4*)(COS + pos0 * 32 + 8 * fq + 4), s0 = *(const f32x4*)(SIN + pos0 * 32 + 8 * fq), s1 = *(const f32x4*)(SIN + pos0 * 32 + 8 * fq + 4);
            const f32x4 dc0 = *(const f32x4*)(COS + 16 * 32 + 8 * fq), dc1 = *(const f32x4*)(COS + 16 * 32 + 8 * fq + 4), ds0 = *(const f32x4*)(SIN + 16 * 32 + 8 * fq), ds1 = *(const f32x4*)(SIN + 16 * 32 + 8 * fq + 4);
#pragma unroll
            for (int ai = 0; ai < 2; ++ai) {
#pragma unroll
                for (int m = 0; m < 4; ++m) { const int r = row0 + ai * HALF + m * 16; const float rs = RS1[r] * sc;
                    const f32x4 a0 = acc[ai][0][m][0] * rs, a1 = acc[ai][0][m][1] * rs, b0 = acc[ai][1][m][0] * rs, b1 = acc[ai][1][m][1] * rs;
                    unsigned short* rowp = base + (size_t)r * 512 + colt;
                    if (kind == 2) { *(u32x4*)rowp = pack8_f16(a0 * c0 - b0 * s0, a1 * c1 - b1 * s1); *(u32x4*)(rowp + 32) = pack8_f16(b0 * c0 + a0 * s0, b1 * c1 + a1 * s1); }
                    else { *(u32x4*)rowp = pack8_bf16(a0 * c0 - b0 * s0, a1 * c1 - b1 * s1); *(u32x4*)(rowp + 32) = pack8_bf16(b0 * c0 + a0 * s0, b1 * c1 + a1 * s1); }
                    { const f32x4 t0 = c0 * dc0 - s0 * ds0, t1 = c1 * dc1 - s1 * ds1; s0 = s0 * dc0 + c0 * ds0; s1 = s1 * dc1 + c1 * ds1; c0 = t0; c1 = t1; } }
                if (ai == 0) {
#pragma unroll
                    for (int k = 0; k < 4; ++k) { const f32x4 t0 = c0 * dc0 - s0 * ds0, t1 = c1 * dc1 - s1 * ds1; s0 = s0 * dc0 + c0 * ds0; s1 = s1 * dc1 + c1 * ds1; c0 = t0; c1 = t1; } }
            }
        }
    }
};
template <int BR> struct EpiMergeF {
    static constexpr bool PERM = true, AFTER_DRAIN = false;
    const bf16_t* G; bf16_t* MG;
    __device__ __forceinline__ void operator()(const f32x4 (&acc)[2][2][4][2], const Unit& u, int wr, int wc, int fr, int fq) const {
        const int row0 = u.pm * BM + wr * 64 + fr, col0 = u.pn * BM + 32 * wc + 8 * fq;
#pragma unroll
        for (int ai = 0; ai < 2; ++ai)
#pragma unroll
            for (int m = 0; m < 4; ++m) { const int r = row0 + ai * HALF + m * 16; const bf16_t* gp = G + (size_t)r * 2048 + BR * 1024 + col0; bf16_t* op = MG + (size_t)r * 1024 + col0;
#pragma unroll
                for (int bj = 0; bj < 2; ++bj) { const u32x4 g = *(const u32x4*)(gp + bj * HALF);
                    f32x4 v0 = bf_lo4(g) * acc[ai][bj][m][0], v1 = bf_hi4(g) * acc[ai][bj][m][1];
                    if (BR == 1) { const u32x4 o = *(const u32x4*)(op + bj * HALF); v0 = v0 + bf_lo4(o); v1 = v1 + bf_hi4(o); }
                    *(u32x4*)(op + bj * HALF) = pack8_bf16(v0, v1); } }
    }
};
struct EpiWoF {
    static constexpr bool PERM = true, AFTER_DRAIN = false;
    const float* x; float* X1; bf16_t* X1B; float* SS2;
    __device__ __forceinline__ void operator()(const f32x4 (&acc)[2][2][4][2], const Unit& u, int wr, int wc, int fr, int fq) const {
        const int row0 = u.pm * BM + wr * 64 + fr, col0 = u.pn * BM + 32 * wc + 8 * fq;
#pragma unroll
        for (int ai = 0; ai < 2; ++ai)
#pragma unroll
            for (int m = 0; m < 4; ++m) { const int r = row0 + ai * HALF + m * 16; const size_t o = (size_t)r * 1024 + col0; float ss = 0.f;
#pragma unroll
                for (int bj = 0; bj < 2; ++bj) { const f32x4 r0 = *(const f32x4*)(x + o + bj * HALF) + acc[ai][bj][m][0], r1 = *(const f32x4*)(x + o + bj * HALF + 4) + acc[ai][bj][m][1];
                    *(f32x4*)(X1 + o + bj * HALF) = r0; *(f32x4*)(X1 + o + bj * HALF + 4) = r1; *(u32x4*)(X1B + o + bj * HALF) = pack8_bf16(r0, r1);
                    ss += (r0[0] * r0[0] + r0[1] * r0[1]) + (r0[2] * r0[2] + r0[3] * r0[3]) + (r1[0] * r1[0] + r1[1] * r1[1]) + (r1[2] * r1[2] + r1[3] * r1[3]); }
                ss += __shfl_xor(ss, 16); ss += __shfl_xor(ss, 32);
                if (fq == 0) SS2[(size_t)r * 16 + u.pn * 4 + wc] = ss; }
    }
};
struct EpiFF1F {
    static constexpr bool PERM = true, AFTER_DRAIN = false;
    const float* SS2; bf16_t* H;
    __device__ __forceinline__ void operator()(const f32x4 (&acc)[2][2][4][2], const Unit& u, int wr, int wc, int fr, int fq) const {
        const int row0 = u.pm * BM + wr * 64 + fr, col0 = u.pn * BM + 32 * wc + 8 * fq;
#pragma unroll
        for (int ai = 0; ai < 2; ++ai)
#pragma unroll
            for (int m = 0; m < 4; ++m) { const int r = row0 + ai * HALF + m * 16; const f32x4* sp = (const f32x4*)(SS2 + (size_t)r * 16);
                const f32x4 t = (sp[0] + sp[1]) + (sp[2] + sp[3]); const float rq = 1.0f / (((t[0] + t[1]) + (t[2] + t[3])) * (1.0f / 1024.f) + EPS);
                bf16_t* hp = H + (size_t)r * 4096 + col0;
#pragma unroll
                for (int bj = 0; bj < 2; ++bj) { f32x4 v0 = __builtin_elementwise_max(acc[ai][bj][m][0], (f32x4){0.f, 0.f, 0.f, 0.f}), v1 = __builtin_elementwise_max(acc[ai][bj][m][1], (f32x4){0.f, 0.f, 0.f, 0.f});
                    v0 = v0 * v0 * rq; v1 = v1 * v1 * rq; *(u32x4*)(hp + bj * HALF) = pack8_bf16(v0, v1); } }
    }
};
struct EpiFF2F {
    static constexpr bool PERM = true, AFTER_DRAIN = false;
    float* X;
    __device__ __forceinline__ void operator()(const f32x4 (&acc)[2][2][4][2], const Unit& u, int wr, int wc, int fr, int fq) const {
        const int row0 = u.pm * BM + wr * 64 + fr, col0 = u.pn * BM + 32 * wc + 8 * fq;
#pragma unroll
        for (int ai = 0; ai < 2; ++ai)
#pragma unroll
            for (int m = 0; m < 4; ++m) { float* p = X + (size_t)(row0 + ai * HALF + m * 16) * 1024 + col0;
#pragma unroll
                for (int bj = 0; bj < 2; ++bj) { const f32x4 r0 = *(const f32x4*)(p + bj * HALF) + acc[ai][bj][m][0], r1 = *(const f32x4*)(p + bj * HALF + 4) + acc[ai][bj][m][1];
                    *(f32x4*)(p + bj * HALF) = r0; *(f32x4*)(p + bj * HALF + 4) = r1; } }
    }
};
}

#include <hip/hip_bf16.h>
#include <cmath>
namespace attn_body {
using bf16=__hip_bfloat16;
using bf16x8=__attribute__((ext_vector_type(8)))short;
using s16x4=__attribute__((ext_vector_type(4)))short;
using f32x16=__attribute__((ext_vector_type(16)))float;
using u32x4=__attribute__((ext_vector_type(4)))unsigned;
constexpr int BATCH=8,NHEAD=8,SEQ=4096,D=64,DM=NHEAD*D;
constexpr int NW=8,QBLK=32,QB=QBLK*NW,KVBLK=64,NQB=SEQ/QB;
constexpr int ATTN_PITCH=DM, ATTN_UNIT_ROWS=QB;
__device__ __forceinline__ int crow(int r,int hi){return (r&3)+8*(r>>2)+4*hi;}
#define SBAR() __builtin_amdgcn_sched_barrier(0)
constexpr int NSLOT=3, SLOTB=8192;
constexpr int LDS_K=0, LDS_V=NSLOT*SLOTB, LDS_WS=2*NSLOT*SLOTB, LDS_OST=LDS_WS+NW*64*4, LDS_MASK=LDS_OST+NW*4096, LDS_BYTES=LDS_MASK+NW*768;
constexpr float C2=0.125f*1.4426950408889634f;
__device__ __forceinline__ void glds16(const void*gsrc,unsigned lds_dst){unsigned keep;
  asm volatile("s_mov_b32 %0, m0\n\ts_mov_b32 m0, %2\n\ts_nop 0\n\tglobal_load_lds_dwordx4 %1, off\n\ts_mov_b32 m0, %0":"=&s"(keep):"v"(gsrc),"s"(lds_dst):"memory");}
__device__ __forceinline__ void glds4(const void*gsrc,unsigned lds_dst){unsigned keep;
  asm volatile("s_mov_b32 %0, m0\n\ts_mov_b32 m0, %2\n\ts_nop 0\n\tglobal_load_lds_dword %1, off\n\ts_mov_b32 m0, %0":"=&s"(keep):"v"(gsrc),"s"(lds_dst):"memory");}
__device__ __forceinline__ float mk1(float x,unsigned m,int pos){return __uint_as_float(__float_as_uint(x)&(unsigned)__builtin_amdgcn_sbfe((int)m,pos,1));}
__device__ __forceinline__ float max3f(float a,float b,float c){float r;asm("v_max3_f32 %0, %1, %2, %3":"=v"(r):"v"(a),"v"(b),"v"(c));return r;}
__device__ __forceinline__ float max2f(float a,float b){float r;asm("v_max_f32_e32 %0, %1, %2":"=v"(r):"v"(a),"v"(b));return r;}
__device__ __forceinline__ float fadd_s(float a,float b){float r;asm("v_add_f32_e32 %0, %1, %2":"=v"(r):"v"(a),"v"(b));return r;}
__device__ __forceinline__ float fsub_s(float a,float b){float r;asm("v_sub_f32_e32 %0, %1, %2":"=v"(r):"v"(a),"v"(b));return r;}
typedef float f32x2_t __attribute__((ext_vector_type(2))); typedef __bf16 bf16x2_t __attribute__((ext_vector_type(2)));
__device__ __forceinline__ unsigned cvtpk_s(float lo,float hi){f32x2_t v={lo,hi};bf16x2_t b=__builtin_convertvector(v,bf16x2_t);return __builtin_bit_cast(unsigned,b);}
#define WAIT_BAR(N) asm volatile("s_waitcnt vmcnt(" #N ") lgkmcnt(0)\n\ts_barrier":::"memory")

__device__ __forceinline__ void qkt(f32x16&p0,f32x16&p1,const char*Kslot,const bf16x8*qr,const f32x16&negm,int r32,int hi){
  const char*kb=Kslot+hi*1024+r32*16;
  #pragma unroll
  for(int d0=0;d0<4;++d0){
    const bf16x8 b0=*reinterpret_cast<const bf16x8*>(kb+d0*2048);
    const bf16x8 b1=*reinterpret_cast<const bf16x8*>(kb+d0*2048+512);
    if(d0==0){p0=__builtin_amdgcn_mfma_f32_32x32x16_bf16(b0,qr[0],negm,0,0,0);p1=__builtin_amdgcn_mfma_f32_32x32x16_bf16(b1,qr[0],negm,0,0,0);}
    else{p0=__builtin_amdgcn_mfma_f32_32x32x16_bf16(b0,qr[d0],p0,0,0,0);p1=__builtin_amdgcn_mfma_f32_32x32x16_bf16(b1,qr[d0],p1,0,0,0);}}
}
typedef __attribute__((address_space(3))) const char* lds_cptr;
typedef short v4i16_t __attribute__((ext_vector_type(4)));
__device__ __forceinline__ void kload8(bf16x8*kf,lds_cptr kp){
  kf[0]=*(const __attribute__((address_space(3))) bf16x8*)(kp);      kf[1]=*(const __attribute__((address_space(3))) bf16x8*)(kp+512);
  kf[2]=*(const __attribute__((address_space(3))) bf16x8*)(kp+2048); kf[3]=*(const __attribute__((address_space(3))) bf16x8*)(kp+2560);
  kf[4]=*(const __attribute__((address_space(3))) bf16x8*)(kp+4096); kf[5]=*(const __attribute__((address_space(3))) bf16x8*)(kp+4608);
  kf[6]=*(const __attribute__((address_space(3))) bf16x8*)(kp+6144); kf[7]=*(const __attribute__((address_space(3))) bf16x8*)(kp+6656);
}
__device__ __forceinline__ void kload2(bf16x8*kf,lds_cptr kp,int j){ kf[2*j]=*(const __attribute__((address_space(3))) bf16x8*)(kp+j*2048); kf[2*j+1]=*(const __attribute__((address_space(3))) bf16x8*)(kp+j*2048+512); }
__device__ __forceinline__ s16x4 vtr(lds_cptr p){ return __builtin_bit_cast(s16x4,__builtin_amdgcn_ds_read_tr16_b64_v4i16((__attribute__((address_space(3))) v4i16_t*)p)); }
__device__ __forceinline__ float rowmax(const f32x16&p0,const f32x16&p1){
  float a=max3f(p0[0],p0[1],p1[0]),b=max3f(p0[2],p0[3],p1[1]);a=max3f(a,p1[2],p1[3]);
  #pragma unroll
  for(int r=4;r<16;r+=4){a=max3f(a,p0[r],p0[r+1]);b=max3f(b,p0[r+2],p0[r+3]);a=max3f(a,p1[r],p1[r+1]);b=max3f(b,p1[r+2],p1[r+3]);}
  const float m=max2f(a,b);
  auto rr=__builtin_amdgcn_permlane32_swap(__float_as_uint(m),__float_as_uint(m),false,false);
  return max2f(__uint_as_float(rr[0]),__uint_as_float(rr[1]));
}
__device__ __forceinline__ void pv(f32x16*o,int vb,bf16x8 pa0,bf16x8 pa1,bf16x8 pa2,bf16x8 pa3){
  #pragma unroll
  for(int d0=0;d0<2;++d0){s16x4 lo[4],hi[4];
    #pragma unroll
    for(int ks=0;ks<4;++ks){
      asm volatile("ds_read_b64_tr_b16 %0,%1 offset:%c2":"=&v"(lo[ks]):"v"(vb),"i"(d0*4096+ks*1024):"memory");
      asm volatile("ds_read_b64_tr_b16 %0,%1 offset:%c2":"=&v"(hi[ks]):"v"(vb),"i"(d0*4096+ks*1024+512):"memory");}
    asm volatile("s_waitcnt lgkmcnt(0)":::"memory");SBAR();
    #define PK(k) (bf16x8){lo[k][0],lo[k][1],lo[k][2],lo[k][3],hi[k][0],hi[k][1],hi[k][2],hi[k][3]}
    o[d0]=__builtin_amdgcn_mfma_f32_32x32x16_bf16(pa0,PK(0),o[d0],0,0,0);
    o[d0]=__builtin_amdgcn_mfma_f32_32x32x16_bf16(pa1,PK(1),o[d0],0,0,0);
    o[d0]=__builtin_amdgcn_mfma_f32_32x32x16_bf16(pa2,PK(2),o[d0],0,0,0);
    o[d0]=__builtin_amdgcn_mfma_f32_32x32x16_bf16(pa3,PK(3),o[d0],0,0,0);
    #undef PK
  }
}

#ifndef ATTN_STORE16
#define ATTN_STORE16(p,v) (*(u32x4*)(p)=(v))
#endif
template<int THRL> __device__ __forceinline__ void attn_unit(int b,int h,int qb,const bf16*Q,const bf16*__restrict__ K,const bf16*__restrict__ V,bf16*O,const unsigned long long*MK,char*shm){
  const int tid=threadIdx.x,lane=tid&63,r32=lane&31,hi=lane>>5; const int wid=__builtin_amdgcn_readfirstlane(tid>>6);
  const long rowbase=(long)b*SEQ; const int q0=qb*QB;
  const bf16*Qw=Q+(rowbase+q0+wid*QBLK)*DM+h*D;
  const bf16*Kh=K+rowbase*DM+h*D,*Vh=V+rowbase*DM+h*D;
  const unsigned lds0=(unsigned)(uintptr_t)shm;
  float*wsf=(float*)(shm+LDS_WS)+wid*64;
  const bf16*ksrc=Kh+(long)lane*DM+wid*8;
  const bf16*vsrc=Vh+(long)(16*(wid&3)+(lane>>2))*DM+(wid>>2)*32+(lane&3)*8;
  const unsigned kdst=lds0+LDS_K+wid*1024, vdst=lds0+LDS_V+wid*1024;
  #define DMA_K(t,slot) glds16(ksrc+(long)(t)*KVBLK*DM,(unsigned)__builtin_amdgcn_readfirstlane(kdst+(slot)))
  #define DMA_V(t,slot) glds16(vsrc+(long)(t)*KVBLK*DM,(unsigned)__builtin_amdgcn_readfirstlane(vdst+(slot)))
  const char*msrc=(const char*)MK+((size_t)b*64*SEQ+q0+wid*QBLK)*8+lane*4;
  const unsigned mdst=lds0+LDS_MASK+wid*768;
  #define DMA_M(t,slot) glds4(msrc+(size_t)(t)*SEQ*8,(unsigned)__builtin_amdgcn_readfirstlane(mdst+((slot)>>5)))
  typedef __attribute__((address_space(3))) const unsigned long long* lds_u64p;
  const lds_cptr mp0=(lds_cptr)shm+LDS_MASK+wid*768+8*r32;
  unsigned mlo,mhi;
  #define MRD(slot) do{ const unsigned long long mw_=*(lds_u64p)(mp0+((slot)>>5)); mlo=((unsigned)mw_)>>(4*hi); mhi=((unsigned)(mw_>>32))>>(4*hi); }while(0)
  const int vb0=(int)(lds0+LDS_V)+((lane>>4)&1)*32+(lane&3)*8+(4*hi+((lane&15)>>2))*64;
  const char*Kbase=shm+LDS_K; bf16x8 kf[8];
  const lds_cptr shm3=(lds_cptr)shm; const lds_cptr kp0=shm3+LDS_K+hi*1024+r32*16; const lds_cptr vp0=shm3+LDS_V+((lane>>4)&1)*32+(lane&3)*8+(4*hi+((lane&15)>>2))*64;
  const int NT=(q0+QB)/KVBLK;
  DMA_M(0,0);DMA_K(0,0);DMA_V(0,0);DMA_K(1,SLOTB);
  bf16x8 qr[4];
  #pragma unroll
  for(int d0=0;d0<4;++d0)qr[d0]=*reinterpret_cast<const bf16x8*>(&Qw[(long)r32*DM+d0*16+hi*8]);
  float mhat=0.f,l_reg=0.f;f32x16 o[2];o[0]=f32x16{};o[1]=f32x16{};f32x16 negm=f32x16{};asm volatile("":"+v"(negm));
  const int qrel=wid*QBLK+r32;
  bool resc=false;
  #define START(P0,P1) do{ const float rm=rowmax(P0,P1); resc=false; \
    { const float dl=rm; mhat=fadd_s(mhat,dl); \
      _Pragma("unroll") for(int r=0;r<16;++r){P0[r]=fsub_s(P0[r],dl);P1[r]=fsub_s(P1[r],dl);} \
      _Pragma("unroll") for(int r=0;r<16;++r)negm[r]=-mhat; asm volatile("":"+v"(negm)); } \
    _Pragma("unroll") for(int r=0;r<16;++r)P0[r]=__builtin_amdgcn_exp2f(P0[r]); }while(0)
  #define RESC() do{ if(resc){ asm volatile("s_waitcnt lgkmcnt(0)":::"memory"); \
      _Pragma("unroll") for(int d_=0;d_<2;++d_) _Pragma("unroll") for(int r=0;r<16;++r)o[d_][r]*=wsf[crow(r,hi)]; } }while(0)
  f32x16 pA0,pA1,pB0,pB1;
  int sl_prev=0,sl_cur=0,sl_next=SLOTB;
  #define ROT() do{sl_prev=sl_cur;sl_cur=sl_next;sl_next=(sl_next==(NSLOT-1)*SLOTB)?0:sl_next+SLOTB;}while(0)
  DMA_K(2,2*SLOTB);
  WAIT_BAR(3);
  qkt(pA0,pA1,Kbase,qr,negm,r32,hi);asm volatile("s_nop 15\n\ts_nop 7":"+v"(pA0),"+v"(pA1));
  START(pA0,pA1);
  _Pragma("unroll") for(int r=0;r<16;++r)pA1[r]=__builtin_amdgcn_exp2f(pA1[r]);
  MRD(0);
  _Pragma("unroll") for(int r=0;r<16;++r){pA0[r]=mk1(pA0[r],mlo,(r&3)+8*(r>>2));pA1[r]=mk1(pA1[r],mhi,(r&3)+8*(r>>2));}
  WAIT_BAR(0);
  DMA_M(1,SLOTB);DMA_M(2,2*SLOTB);DMA_K(3,0);DMA_V(1,SLOTB);
  ROT();
  kload8(kf,kp0+sl_cur);
  WAIT_BAR(2);
  s16x4 vlo[8],vhi[8]; u32x4 pw0,pw1,pw2,pw3;
  #define PKW(P,B) cvtpk_s(P[B],P[B+1])
  #define PAF(k) __builtin_bit_cast(bf16x8,pw##k)
  #define VFR(i) (bf16x8){vlo[i][0],vlo[i][1],vlo[i][2],vlo[i][3],vhi[i][0],vhi[i][1],vhi[i][2],vhi[i][3]}
  #define PIN(x) asm volatile("":"+v"(x))
  #define MX3(a,b,c) __builtin_fmaxf(__builtin_fmaxf((a),(b)),(c))
  #define GAPA(MF,A0,A1,A2,A3,W0,W1,PW) do{ MF; sacc+=A0; sacc+=A1; sacc+=A2; sacc+=A3; PIN(sacc); W0; W1; PIN(PW); SBAR(); }while(0)
  #define EX(v) __builtin_amdgcn_exp2f(v)
  #define GAPB(MF,X,B,MW) do{ MF; X[B]=mk1(EX(X[B]),MW,2*(B)); X[B+1]=mk1(EX(X[B+1]),MW,2*(B)+1); X[B+2]=mk1(EX(X[B+2]),MW,2*(B)+2); X[B+3]=mk1(EX(X[B+3]),MW,2*(B)+3); PIN(X); SBAR(); }while(0)
  #define VRD(i) do{ vlo[i]=vtr(vp_+(((i)>>2)*4096+((i)&3)*1024)); vhi[i]=vtr(vp_+(((i)>>2)*4096+((i)&3)*1024+512)); }while(0)
  #define KRD(G,j) do{ if(G){ kload2(kf,kp0+sl_next,j); SBAR(); } }while(0)
  #define STEP(C0,C1,P0,P1,t,GK,GV,GL,GM) do{ SBAR(); \
    const lds_cptr vp_=vp0+sl_prev; MRD(sl_cur); \
    VRD(0); SBAR(); float sacc=(P0[0]+P0[1]); \
    GAPA(C0=__builtin_amdgcn_mfma_f32_32x32x16_bf16(kf[0],qr[0],negm,0,0,0), P0[2],P0[3],P0[4],P0[5],     pw0[0]=PKW(P0,0), pw0[1]=PKW(P0,2), pw0); \
    VRD(4); SBAR(); GAPA(C1=__builtin_amdgcn_mfma_f32_32x32x16_bf16(kf[1],qr[0],negm,0,0,0), P0[6],P0[7],P0[8],P0[9],     pw0[2]=PKW(P0,4), pw0[3]=PKW(P0,6), pw0); \
    VRD(1); SBAR(); GAPA(C0=__builtin_amdgcn_mfma_f32_32x32x16_bf16(kf[2],qr[1],C0,0,0,0),   P0[10],P0[11],P0[12],P0[13], pw1[0]=PKW(P0,8), pw1[1]=PKW(P0,10), pw1); \
    VRD(5); SBAR(); GAPA(C1=__builtin_amdgcn_mfma_f32_32x32x16_bf16(kf[3],qr[1],C1,0,0,0),   P0[14],P0[15],P1[0],P1[1],   pw1[2]=PKW(P0,12),pw1[3]=PKW(P0,14), pw1); \
    VRD(2); SBAR(); GAPA(C0=__builtin_amdgcn_mfma_f32_32x32x16_bf16(kf[4],qr[2],C0,0,0,0),   P1[2],P1[3],P1[4],P1[5],     pw2[0]=PKW(P1,0), pw2[1]=PKW(P1,2), pw2); \
    VRD(6); SBAR(); GAPA(C1=__builtin_amdgcn_mfma_f32_32x32x16_bf16(kf[5],qr[2],C1,0,0,0),   P1[6],P1[7],P1[8],P1[9],     pw2[2]=PKW(P1,4), pw2[3]=PKW(P1,6), pw2); \
    VRD(3); SBAR(); GAPA(C0=__builtin_amdgcn_mfma_f32_32x32x16_bf16(kf[6],qr[3],C0,0,0,0),   P1[10],P1[11],P1[12],P1[13], pw3[0]=PKW(P1,8), pw3[1]=PKW(P1,10), pw3); \
    VRD(7); SBAR(); GAPA(C1=__builtin_amdgcn_mfma_f32_32x32x16_bf16(kf[7],qr[3],C1,0,0,0),   P1[14],P1[15],0.f,0.f,       pw3[2]=PKW(P1,12),pw3[3]=PKW(P1,14), pw3); \
    l_reg+=sacc; \
    if(GK){DMA_K((t)+3,sl_cur);} if(GV){DMA_V((t)+1,sl_next);} if(GM){DMA_M((t)+2,sl_prev);} \
    { float a=MX3(C0[0],C0[1],C1[0]),b=MX3(C0[2],C0[3],C1[1]); a=MX3(a,C1[2],C1[3]); \
      _Pragma("unroll") for(int r=4;r<16;r+=4){a=MX3(a,C0[r],C0[r+1]);b=MX3(b,C0[r+2],C0[r+3]);a=MX3(a,C1[r],C1[r+1]);b=MX3(b,C1[r+2],C1[r+3]);} \
      float rm=__builtin_fmaxf(a,b); { auto rr=__builtin_amdgcn_permlane32_swap(__float_as_uint(rm),__float_as_uint(rm),false,false); rm=__builtin_fmaxf(__uint_as_float(rr[0]),__uint_as_float(rr[1])); } \
      resc=false; \
      if(__builtin_expect(__any(rm>(float)THRL),0)){ const float dl=__builtin_fmaxf(rm,0.f); mhat+=dl; \
        _Pragma("unroll") for(int r=0;r<16;++r){C0[r]-=dl;C1[r]-=dl;} \
        _Pragma("unroll") for(int r=0;r<16;++r)negm[r]=-mhat; asm volatile("":"+v"(negm)); \
        const float f=__builtin_amdgcn_exp2f(-dl); l_reg*=f; if(hi==0)wsf[r32]=f; resc=true; } } \
    SBAR(); \
    GAPB(o[0]=__builtin_amdgcn_mfma_f32_32x32x16_bf16(PAF(0),VFR(0),o[0],0,0,0), C0,0,mlo); \
    GAPB(o[1]=__builtin_amdgcn_mfma_f32_32x32x16_bf16(PAF(0),VFR(4),o[1],0,0,0), C0,4,mlo); \
    KRD(GL,0); GAPB(o[0]=__builtin_amdgcn_mfma_f32_32x32x16_bf16(PAF(1),VFR(1),o[0],0,0,0), C0,8,mlo); \
    KRD(GL,1); GAPB(o[1]=__builtin_amdgcn_mfma_f32_32x32x16_bf16(PAF(1),VFR(5),o[1],0,0,0), C0,12,mlo); \
    KRD(GL,2); GAPB(o[0]=__builtin_amdgcn_mfma_f32_32x32x16_bf16(PAF(2),VFR(2),o[0],0,0,0), C1,0,mhi); \
    KRD(GL,3); GAPB(o[1]=__builtin_amdgcn_mfma_f32_32x32x16_bf16(PAF(2),VFR(6),o[1],0,0,0), C1,4,mhi); \
    GAPB(o[0]=__builtin_amdgcn_mfma_f32_32x32x16_bf16(PAF(3),VFR(3),o[0],0,0,0), C1,8,mhi); \
    GAPB(o[1]=__builtin_amdgcn_mfma_f32_32x32x16_bf16(PAF(3),VFR(7),o[1],0,0,0), C1,12,mhi); \
    }while(0)
  int t=1;
  for(;t+5<NT;t+=2){
    STEP(pB0,pB1,pA0,pA1,t,true,true,true,true);     WAIT_BAR(3); RESC(); ROT();
    STEP(pA0,pA1,pB0,pB1,t+1,true,true,true,true);   WAIT_BAR(3); RESC(); ROT();
  }
  #define ENDW(tt) do{ if((tt)+3<NT){WAIT_BAR(3);} else if((tt)+2<NT){WAIT_BAR(2);} else {WAIT_BAR(0);} }while(0)
  for(;t+1<NT;t+=2){
    STEP(pB0,pB1,pA0,pA1,t,(t+3<NT),(t+1<NT),(t+1<NT),(t+2<NT));       ENDW(t);   RESC(); ROT();
    STEP(pA0,pA1,pB0,pB1,t+1,(t+4<NT),(t+2<NT),(t+2<NT),(t+3<NT));     ENDW(t+1); RESC(); ROT();
  }
  STEP(pB0,pB1,pA0,pA1,NT-1,false,false,false,false); RESC();
  { float sacc=pB0[0]+pB0[1]; _Pragma("unroll") for(int r=2;r<16;++r)sacc+=pB0[r]; _Pragma("unroll") for(int r=0;r<16;++r)sacc+=pB1[r]; l_reg+=sacc;
    pw0=(u32x4){PKW(pB0,0),PKW(pB0,2),PKW(pB0,4),PKW(pB0,6)};pw1=(u32x4){PKW(pB0,8),PKW(pB0,10),PKW(pB0,12),PKW(pB0,14)};pw2=(u32x4){PKW(pB1,0),PKW(pB1,2),PKW(pB1,4),PKW(pB1,6)};pw3=(u32x4){PKW(pB1,8),PKW(pB1,10),PKW(pB1,12),PKW(pB1,14)};
    SBAR(); pv(o,vb0+sl_cur,PAF(0),PAF(1),PAF(2),PAF(3)); }
  #undef PKW
  #undef PAF
  #undef VFR
  #undef PIN
  #undef MX3
  #undef GAPA
  #undef GAPB
  #undef EX
  #undef VRD
  #undef KRD
  #undef STEP
  #undef ENDW
  {auto rr=__builtin_amdgcn_permlane32_swap(__float_as_uint(l_reg),__float_as_uint(l_reg),false,false);l_reg=__uint_as_float(rr[0])+__uint_as_float(rr[1]);}
  if(hi==0)wsf[32+r32]=l_reg;asm volatile("s_waitcnt lgkmcnt(0)":::"memory");
  float rli[16];
  #pragma unroll
  for(int r=0;r<16;++r)rli[r]=__builtin_amdgcn_rcpf(wsf[32+crow(r,hi)]);
  bf16*Ow=O+(rowbase+q0+wid*QBLK)*DM+h*D;
  { bf16*stg=(bf16*)(shm+LDS_OST)+wid*2048;
    #pragma unroll
    for(int r=0;r<16;++r){const int orow=crow(r,hi);
      #pragma unroll
      for(int d0=0;d0<2;++d0)stg[orow*64+d0*32+r32]=__float2bfloat16(o[d0][r]*rli[r]);}
    asm volatile("s_waitcnt lgkmcnt(0)":::"memory");
    #pragma unroll
    for(int i=0;i<4;++i){const int row=i*8+(lane>>3),ch=lane&7; const u32x4 v=*(const u32x4*)(stg+row*64+ch*8); ATTN_STORE16(Ow+(long)row*DM+ch*8,v);} }
  asm volatile("s_waitcnt lgkmcnt(0)\n\ts_barrier":::"memory");
  #undef DMA_K
  #undef DMA_V
  #undef DMA_M
  #undef MRD
  #undef START
  #undef RESC
  #undef ROT
}
constexpr int ATTN_LDS_BYTES=LDS_BYTES;
struct AttnTensors { const bf16* Q; const bf16* K; const bf16* V; bf16* O; const unsigned long long* MK; };
struct AttnUnit { int bh; int qb; };
struct StaticOrder {
  int vcu, G;
  __device__ __forceinline__ explicit StaticOrder(int grid,int block):vcu((grid%8==0)?(block%8)*(grid/8)+block/8:block),G(grid){}
  __device__ __forceinline__ bool next(int i,AttnUnit&u)const{
    if(G==256){ if(i>=4)return false; const int s=vcu&3; u.bh=vcu>>2; u.qb=(i==0)?s:(i==1)?15-s:(i==2)?4+s:11-s; return true; }
    const int id=i*G+vcu; if(id>=BATCH*NHEAD*NQB)return false; u.bh=id/NQB; u.qb=NQB-1-(id%NQB); return true; }
  __device__ __forceinline__ void a_ready(const AttnUnit&)const{}
  __device__ __forceinline__ void done(const AttnUnit&)const{}
};
template<class Sched,int THRL=8> __device__ __forceinline__ void attn_phase(char*lds,const AttnTensors&T,const Sched&S){
  AttnUnit u;
  for(int i=0;S.next(i,u);++i){ S.a_ready(u); attn_unit<THRL>(u.bh/NHEAD,u.bh%NHEAD,u.qb,T.Q,T.K,T.V,T.O,T.MK,lds); S.done(u); }
}
#undef SBAR
#undef WAIT_BAR
}

#define GAS __attribute__((address_space(1)))
#define XB_TMO      128
#define XB_XCNT(j)  (256  + 64 * (j))
#define XB_XSUB(j)  (1280 + 64 * (j))
#define XB_XGEN(j)  (2304 + 64 * (j))
#define XB_TOP      3328
#define XB_TOPGEN   3392
#define XCD_BAR_WORDS 3456
#define XB_SPIN_CAP (1u << 18)

__device__ __forceinline__ unsigned xb_ld(unsigned* p)              { return __hip_atomic_load(p, __ATOMIC_RELAXED, __HIP_MEMORY_SCOPE_AGENT); }
__device__ __forceinline__ unsigned xb_add(unsigned* p, unsigned v) { return __hip_atomic_fetch_add(p, v, __ATOMIC_RELAXED, __HIP_MEMORY_SCOPE_AGENT); }
__device__ __forceinline__ unsigned xb_xcc_id() { return (unsigned)__builtin_amdgcn_s_getreg((3 << 11) | 20) & 0xFu; }
#define XB_SPIN(cond, bar) do { unsigned _sp = 0; while (cond) { __builtin_amdgcn_s_sleep(1); \
    if ((++_sp & 255u) == 0u) { if (xb_ld(&(bar)[XB_TMO])) break; if (_sp > XB_SPIN_CAP) { atomicAdd(&(bar)[XB_TMO], 1u); break; } } } } while (0)

struct XcdBarrier {
    unsigned* bar; unsigned x;
    volatile LAS unsigned* st;
};

__device__ __forceinline__ XcdBarrier xcd_barrier_post(unsigned* bar, volatile LAS unsigned* st) {
    XcdBarrier b; b.bar = bar; b.x = xb_xcc_id(); b.st = st;
    if (threadIdx.x == 0) (void)xb_add(&bar[XB_XCNT(b.x)], 1u);
    return b;
}
__device__ __forceinline__ void xcd_barrier_complete(unsigned* bar, unsigned x, unsigned& nloc, unsigned& nx) {
    const unsigned G = gridDim.x * gridDim.y * gridDim.z;
    unsigned sum, cnt, mine, sp = 0u;
    for (;;) {
        sum = 0u; cnt = 0u; mine = 0u;
#pragma unroll
        for (unsigned j = 0; j < 16; ++j) { const unsigned c = xb_ld(&bar[XB_XCNT(j)]); sum += c; cnt += (c > 0u) ? 1u : 0u; mine = (j == x) ? c : mine; }
        if (sum == G) break;
        __builtin_amdgcn_s_sleep(1);
        if ((++sp & 255u) == 0u) { if (xb_ld(&bar[XB_TMO])) break; if (sp > XB_SPIN_CAP) { atomicAdd(&bar[XB_TMO], 1u); break; } }
    }
    nloc = mine > 0u ? mine : 1u; nx = cnt > 0u ? cnt : 1u;
}

__device__ __forceinline__ void xcd_barrier(const XcdBarrier& b) {
    asm volatile("s_waitcnt vmcnt(0)" ::: "memory");
    __syncthreads();
    if (threadIdx.x == 0) {
        unsigned* bar = b.bar;
        __builtin_amdgcn_s_waitcnt(0);
        unsigned nloc = b.st[0], nx = b.st[1];
        if (nloc == 0u) { xcd_barrier_complete(bar, b.x, nloc, nx); b.st[0] = nloc; b.st[1] = nx; }
        const unsigned old = xb_add(&bar[XB_XSUB(b.x)], 1u);
        const unsigned gen = old / nloc;
        if (old + 1u == (gen + 1u) * nloc) {
            __builtin_amdgcn_fence(__ATOMIC_RELEASE, "agent");
            asm volatile("s_waitcnt vmcnt(0)" ::: "memory");
            const unsigned og = xb_add(&bar[XB_TOP], 1u);
            const unsigned tg = og / nx;
            if (og + 1u == (tg + 1u) * nx) xb_add(&bar[XB_TOPGEN], 1u);
            else XB_SPIN(xb_ld(&bar[XB_TOPGEN]) == tg, bar);
            __builtin_amdgcn_fence(__ATOMIC_ACQUIRE, "agent");
            xb_add(&bar[XB_XGEN(b.x)], 1u);
            asm volatile("s_waitcnt vmcnt(0)" ::: "memory");
        } else {
            XB_SPIN(xb_ld(&bar[XB_XGEN(b.x)]) == gen, bar);
            __builtin_amdgcn_fence(__ATOMIC_ACQUIRE, "agent");
            asm volatile("s_waitcnt vmcnt(0)" ::: "memory");
        }
    }
    __syncthreads();
}

constexpr int LDSCTL_OFF = 131072, MISC_OFF = LDSCTL_OFF + 320;
constexpr size_t WS_BAR = 4096 * 4;
__global__ void __launch_bounds__(NT, 2) fwd_kernel(Args args) {
    extern __shared__ __attribute__((aligned(16))) unsigned char lds[];
    Frame F;
    F.lds = (LAS unsigned char*)lds;
    F.tid = threadIdx.x; F.lane = F.tid & 63; F.wave = __builtin_amdgcn_readfirstlane(F.tid >> 6);
    F.gw = blockIdx.x * NWAVES + F.wave; F.ngw = gridDim.x * NWAVES;
    F.x = args.in[0]; F.norm1_g = args.in[1]; F.w_in = args.in[2]; F.w_s = args.in[3]; F.b_s = args.in[4]; F.ln_g = args.in[5]; F.ln_b = args.in[6];
    F.w_out_a = args.in[7]; F.w_out_b = args.in[8]; F.w_o = args.in[9]; F.norm2_g = args.in[10]; F.w_ff_in = args.in[11]; F.w_ff_out = args.in[12]; F.norm_f_g = args.in[13];
    F.out = args.out; F.ws = args.ws;
    unsigned char* ws = args.ws;
    F.COS = (float*)(ws + WS_COS); F.SIN = (float*)(ws + WS_SIN); F.RS1 = (float*)(ws + WS_RS1); F.RS2 = (float*)(ws + WS_RS2); F.WI = (float*)(ws + WS_WI); F.SS2 = (float*)(ws + WS_SS2);
    F.WSB = (bf16_t*)(ws + WS_WSB); F.WIN = (bf16_t*)(ws + WS_WIN); F.WA = (bf16_t*)(ws + WS_WA); F.WB = (bf16_t*)(ws + WS_WB); F.WO = (bf16_t*)(ws + WS_WO);
    F.W1 = (bf16_t*)(ws + WS_W1); F.W2 = (bf16_t*)(ws + WS_W2); F.XB = (bf16_t*)(ws + WS_XB); F.U = (bf16_t*)(ws + WS_U); F.VG = (bf16_t*)(ws + WS_VG);
    F.Q = (bf16_t*)(ws + WS_Q); F.K = (bf16_t*)(ws + WS_K); F.V = (bf16_t*)(ws + WS_V); F.G = (bf16_t*)(ws + WS_G); F.X1B = (bf16_t*)(ws + WS_X1B); F.HID = (bf16_t*)(ws + WS_HID);
    F.QI = (unsigned short*)(ws + WS_QI); F.KI = (unsigned short*)(ws + WS_KI); F.MASK = (unsigned long long*)(ws + WS_MASK);
    for (int u = F.tid; u < (LDS_BYTES - LDSCTL_OFF) / 4; u += NT) ((LAS unsigned*)(F.lds + LDSCTL_OFF))[u] = 0u;
    __syncthreads();
    XcdBarrier bar = xcd_barrier_post((unsigned*)(args.ws + WS_BAR), (volatile LAS unsigned*)(F.lds + MISC_OFF) + 8);
    const int lo = args.ph_lo, hi = args.ph_hi;
#define IN(k) (lo <= (k) && (k) < hi)
#if USE_CG_SYNC
#define SEAM(k) do { if (IN(k) && IN((k) + 1)) { __threadfence(); cg::this_grid().sync(); } } while (0)
#else
#define SEAM(k) do { if (IN(k) && IN((k) + 1)) { xcd_barrier(bar); } } while (0)
#endif
    if (IN(0)) p0_prologue(F);
    SEAM(0);
#define GEMM_FAST(EPI_T, EPI_INIT, AP, BP, NN, KK) do { pg8::Gemm g{AP, BP, M, NN, KK}; pg8::StaticOrder S; S.init(M, NN, (int)gridDim.x, (int)blockIdx.x); EPI_T E EPI_INIT; \
        pg8::gemm_phase<EPI_T, pg8::StaticOrder, PG8_ALIGN, PG8_SP2>(F.lds, g, S, E); } while (0)
    if (IN(1)) {
#if FAST_G1
        GEMM_FAST(pg8::EpiProjF, ({F.ws}), F.XB, F.WIN, NP, 1024);
#else
        EpiProj E{F.RS1, F.COS, F.SIN, F.U, F.VG, F.Q, F.K, F.V, F.G, F.QI, F.KI, F.WI}; sgemm(F.XB, F.WIN, M, NP, 1024, E, F.gw, F.ngw, F.lane);
#endif
    }
    SEAM(1);
    if (IN(2)) {
#if FAST_SGU
        sgu_fast(F);
#else
        sgu_simple(F);
#endif
        __syncthreads();
#if FAST_IDX
        indexer_fast(F);
#else
        indexer_simple(F);
#endif
    }
    SEAM(2);
    if (IN(3)) {
#if FAST_ATTN
        const attn_body::AttnTensors AT{(const attn_body::bf16*)F.Q, (const attn_body::bf16*)F.K, (const attn_body::bf16*)F.V, (attn_body::bf16*)F.Q, F.MASK};
        const attn_body::StaticOrder S((int)gridDim.x, (int)blockIdx.x);
        attn_body::attn_phase<attn_body::StaticOrder>((char*)lds, AT, S);
#else
        attn_simple(F);
#endif
    }
    SEAM(3);
#if FAST_MERGE
    if (IN(4)) { GEMM_FAST(pg8::EpiMergeF<0>, ({F.G, F.XB}), F.U, F.WA, 1024, 512); }
    if (IN(5)) { __syncthreads(); GEMM_FAST(pg8::EpiMergeF<1>, ({F.G, F.XB}), F.Q, F.WB, 1024, 512); }
#else
    if (IN(4)) { EpiMergeA E{F.G, F.XB}; sgemm(F.U, F.WA, M, 1024, 512, E, F.gw, F.ngw, F.lane); }
    SEAM(4);
    if (IN(5)) { EpiMergeB E{F.G, F.XB}; sgemm(F.Q, F.WB, M, 1024, 512, E, F.gw, F.ngw, F.lane); }
#endif
    SEAM(5);
    if (IN(6)) {
#if FAST_WO
        GEMM_FAST(pg8::EpiWoF, ({F.x, F.out, F.X1B, F.SS2}), F.XB, F.WO, 1024, 1024);
#else
        EpiWo E{F.x, F.out, F.X1B}; sgemm(F.XB, F.WO, M, 1024, 1024, E, F.gw, F.ngw, F.lane);
#endif
    }
    SEAM(6);
#if !(FAST_WO && FAST_FF1)
    if (IN(7)) rs2_rows(F);
    SEAM(7);
#endif
    if (IN(8)) {
#if FAST_FF1
        GEMM_FAST(pg8::EpiFF1F, ({F.SS2, F.HID}), F.X1B, F.W1, 4096, 1024);
#else
        EpiFF1 E{F.RS2, F.HID}; sgemm(F.X1B, F.W1, M, 4096, 1024, E, F.gw, F.ngw, F.lane);
#endif
    }
    SEAM(8);
    if (IN(9)) {
#if FAST_FF2
        GEMM_FAST(pg8::EpiFF2F, ({F.out}), F.HID, F.W2, 1024, 4096);
#else
        EpiFF2 E{F.out}; sgemm(F.HID, F.W2, M, 1024, 4096, E, F.gw, F.ngw, F.lane);
#endif
    }
    SEAM(9);
    if (IN(10)) final_norm(F);
#undef SEAM
#undef IN
}

extern "C" void kernel_launch(void* const* d_in, const int* in_sizes, int n_in, void* d_out, int out_size, void* d_ws, size_t ws_size, hipStream_t stream) {
    static int grid = 0;
    if (grid == 0) {
        if (n_in != 14 || out_size != M * D || ws_size < WS_END) { fprintf(stderr, "kernel_launch: unexpected shapes (n_in %d out %d ws %zu)\n", n_in, out_size, ws_size); grid = -1; return; }
        int dev = 0, cus = 0, per_cu = 0;
        hipGetDevice(&dev); hipDeviceGetAttribute(&cus, hipDeviceAttributeMultiprocessorCount, dev);
        hipFuncSetAttribute((const void*)fwd_kernel, hipFuncAttributeMaxDynamicSharedMemorySize, LDS_BYTES);
        hipOccupancyMaxActiveBlocksPerMultiprocessor(&per_cu, (const void*)fwd_kernel, NT, LDS_BYTES);
        if (per_cu < 1) { fprintf(stderr, "kernel_launch: occupancy query says %d blocks per CU\n", per_cu); per_cu = 1; }
        (void)hipGetLastError();
        grid = cus * (per_cu < 1 ? 1 : 1);
    }
    if (grid < 0) return;
    Args a{};
    for (int i = 0; i < 14; ++i) a.in[i] = (const float*)d_in[i];
    a.out = (float*)d_out; a.ws = (unsigned char*)d_ws;
#if ONE_LAUNCH
    hipMemsetAsync((char*)d_ws + WS_CTL, 0, 64 * 1024, stream);
    a.ph_lo = 0; a.ph_hi = 11;
    void* kargs[] = {&a};
    hipError_t e = hipLaunchCooperativeKernel((const void*)fwd_kernel, dim3(grid), dim3(NT), kargs, LDS_BYTES, stream);
    if (e != hipSuccess) fprintf(stderr, "cooperative launch failed: %s (grid %d)\n", hipGetErrorString(e), grid);
#else
    for (int ph = 0; ph <= 10; ++ph) {
        a.ph_lo = ph; a.ph_hi = ph + 1;
        hipLaunchKernelGGL(fwd_kernel, dim3(grid), dim3(NT), LDS_BYTES, stream, a);
    }
#endif
}
```

```cpp
#include <hip/hip_runtime.h>
#include <hip/hip_cooperative_groups.h>
#include <cstdio>
#include <cstdint>

namespace cg = cooperative_groups;
#ifndef ONE_LAUNCH
#define ONE_LAUNCH 1
#endif
#ifndef FAST_G1
#define FAST_G1 1
#endif
#ifndef USE_CG_SYNC
#define USE_CG_SYNC 0
#endif
#ifndef FAST_ATTN
#define FAST_ATTN 1
#endif
#ifndef FAST_SGU
#define FAST_SGU 1
#endif
#ifndef FAST_IDX
#define FAST_IDX 1
#endif
#ifndef FAST_MERGE
#define FAST_MERGE 1
#endif
#ifndef FAST_WO
#define FAST_WO 1
#endif
#ifndef FAST_FF1
#define FAST_FF1 1
#endif
#ifndef FAST_FF2
#define FAST_FF2 1
#endif
#define LAS __attribute__((address_space(3)))
typedef unsigned short bf16_t;
typedef short bf16x8 __attribute__((ext_vector_type(8)));
typedef _Float16 f16x8 __attribute__((ext_vector_type(8)));
typedef float f32x4 __attribute__((ext_vector_type(4)));
typedef float f32x2 __attribute__((ext_vector_type(2)));
typedef unsigned u32x4 __attribute__((ext_vector_type(4)));
typedef unsigned u32x2 __attribute__((ext_vector_type(2)));

constexpr int BATCH = 8, SEQ = 4096, D = 1024, M = BATCH * SEQ;
constexpr int DIN = 5192, NP = 5376;
constexpr int FF = 4096;
constexpr float EPS = 1e-6f;
constexpr float IDX_SCALE = 0.04419417382415922f;
constexpr float C2 = 0.125f * 1.4426950408889634f;
constexpr int NWAVES = 8, NT = NWAVES * 64;
constexpr int LDS_BYTES = 147456;

constexpr size_t MiB = 1u << 20;
constexpr size_t WS_CTL = 0;
constexpr size_t WS_COS = 1 * MiB;
constexpr size_t WS_SIN = WS_COS + 512 * 1024;
constexpr size_t WS_RS1 = 2 * MiB;
constexpr size_t WS_RS2 = WS_RS1 + 128 * 1024;
constexpr size_t WS_WI = 3 * MiB;
constexpr size_t WS_WSB = 4 * MiB;
constexpr size_t WS_WIN = 5 * MiB;
constexpr size_t WS_WA = 16 * MiB;
constexpr size_t WS_WB = 17 * MiB;
constexpr size_t WS_WO = 18 * MiB;
constexpr size_t WS_W1 = 20 * MiB;
constexpr size_t WS_W2 = 28 * MiB;
constexpr size_t WS_SS2 = 36 * MiB;
constexpr size_t WS_MG = 200 * MiB;
constexpr size_t WS_XB = 40 * MiB;
constexpr size_t WS_U = 104 * MiB;
constexpr int UP = 1024;
constexpr size_t WS_VG = 444 * MiB;
constexpr size_t WS_Q = 168 * MiB;
constexpr size_t WS_K = 200 * MiB;
constexpr size_t WS_V = 232 * MiB;
constexpr size_t WS_QI = 264 * MiB;
constexpr size_t WS_KI = 296 * MiB;
constexpr size_t WS_MASK = 300 * MiB;
constexpr size_t WS_G = 316 * MiB;
constexpr size_t WS_X1B = 444 * MiB;
constexpr size_t WS_HID = 104 * MiB;
constexpr size_t WS_END = 508 * MiB;

__device__ __forceinline__ unsigned f2bf(float f) { unsigned u = __float_as_uint(f); return (u + 0x7fffu + ((u >> 16) & 1u)) >> 16; }
__device__ __forceinline__ float bf2f(unsigned b) { return __uint_as_float(b << 16); }
__device__ __forceinline__ unsigned pk2(float lo, float hi) { return f2bf(lo) | (f2bf(hi) << 16); }
__device__ __forceinline__ unsigned short f2h(float f) { _Float16 h = (_Float16)f; return __builtin_bit_cast(unsigned short, h); }
__device__ __forceinline__ float h2f(unsigned b) { return (float)__builtin_bit_cast(_Float16, (unsigned short)b); }
__device__ __forceinline__ float wave_sum(float v) {
#pragma unroll
    for (int o = 1; o < 64; o <<= 1) v += __shfl_xor(v, o);
    return v;
}
__device__ __forceinline__ unsigned wave_sum_u(unsigned v) {
#pragma unroll
    for (int o = 1; o < 64; o <<= 1) v += (unsigned)__shfl_xor((int)v, o);
    return v;
}
__device__ __forceinline__ float gelu_tanh(float x) {
    const float z = 1.5957691216057308f * (x + 0.044715f * x * x * x);
    return x / (1.0f + __builtin_amdgcn_exp2f(-1.4426950408889634f * z));
}
__device__ __forceinline__ float sigmoidf(float x) { return 1.0f / (1.0f + __builtin_amdgcn_exp2f(-1.4426950408889634f * x)); }
__device__ __forceinline__ unsigned ukey(float f) { const unsigned u = __float_as_uint(f); return (u & 0x80000000u) ? ~u : (u | 0x80000000u); }

__device__ __forceinline__ size_t ki_off(int t, int d) { return (size_t)((((t >> 5) * 4 + (d >> 4)) * 64 + ((d >> 3) & 1) * 32 + (t & 31)) * 8 + (d & 7)); }
struct Args { const float* in[14]; float* out; unsigned char* ws; int ph_lo, ph_hi; };

struct Frame {
    LAS unsigned char* lds;
    int tid, lane, wave, gw, ngw;
    const Args* a;
    __device__ __forceinline__ const float* x() const { return a->in[0]; }
    __device__ __forceinline__ const float* norm1_g() const { return a->in[1]; }
    __device__ __forceinline__ const float* w_in() const { return a->in[2]; }
    __device__ __forceinline__ const float* w_s() const { return a->in[3]; }
    __device__ __forceinline__ const float* b_s() const { return a->in[4]; }
    __device__ __forceinline__ const float* ln_g() const { return a->in[5]; }
    __device__ __forceinline__ const float* ln_b() const { return a->in[6]; }
    __device__ __forceinline__ const float* w_out_a() const { return a->in[7]; }
    __device__ __forceinline__ const float* w_out_b() const { return a->in[8]; }
    __device__ __forceinline__ const float* w_o() const { return a->in[9]; }
    __device__ __forceinline__ const float* norm2_g() const { return a->in[10]; }
    __device__ __forceinline__ const float* w_ff_in() const { return a->in[11]; }
    __device__ __forceinline__ const float* w_ff_out() const { return a->in[12]; }
    __device__ __forceinline__ const float* norm_f_g() const { return a->in[13]; }
    float* out; unsigned char* ws;
    __device__ __forceinline__ float* COS() const { return (float*)(ws + WS_COS); }
    __device__ __forceinline__ float* SIN() const { return (float*)(ws + WS_SIN); }
    __device__ __forceinline__ float* RS1() const { return (float*)(ws + WS_RS1); }
    __device__ __forceinline__ float* RS2() const { return (float*)(ws + WS_RS2); }
    __device__ __forceinline__ float* WI() const { return (float*)(ws + WS_WI); }
    __device__ __forceinline__ float* SS2() const { return (float*)(ws + WS_SS2); }
    __device__ __forceinline__ bf16_t* WSB() const { return (bf16_t*)(ws + WS_WSB); }
    __device__ __forceinline__ bf16_t* WIN() const { return (bf16_t*)(ws + WS_WIN); }
    __device__ __forceinline__ bf16_t* WA() const { return (bf16_t*)(ws + WS_WA); }
    __device__ __forceinline__ bf16_t* WB() const { return (bf16_t*)(ws + WS_WB); }
    __device__ __forceinline__ bf16_t* WO() const { return (bf16_t*)(ws + WS_WO); }
    __device__ __forceinline__ bf16_t* W1() const { return (bf16_t*)(ws + WS_W1); }
    __device__ __forceinline__ bf16_t* W2() const { return (bf16_t*)(ws + WS_W2); }
    __device__ __forceinline__ bf16_t* XB() const { return (bf16_t*)(ws + WS_XB); }
    __device__ __forceinline__ bf16_t* MG() const { return (bf16_t*)(ws + WS_MG); }
    __device__ __forceinline__ bf16_t* U() const { return (bf16_t*)(ws + WS_U); }
    __device__ __forceinline__ bf16_t* VG() const { return (bf16_t*)(ws + WS_VG); }
    __device__ __forceinline__ bf16_t* Q() const { return (bf16_t*)(ws + WS_Q); }
    __device__ __forceinline__ bf16_t* K() const { return (bf16_t*)(ws + WS_K); }
    __device__ __forceinline__ bf16_t* V() const { return (bf16_t*)(ws + WS_V); }
    __device__ __forceinline__ bf16_t* G() const { return (bf16_t*)(ws + WS_G); }
    __device__ __forceinline__ bf16_t* X1B() const { return (bf16_t*)(ws + WS_X1B); }
    __device__ __forceinline__ bf16_t* HID() const { return (bf16_t*)(ws + WS_HID); }
    __device__ __forceinline__ unsigned short* QI() const { return (unsigned short*)(ws + WS_QI); }
    __device__ __forceinline__ unsigned short* KI() const { return (unsigned short*)(ws + WS_KI); }
    __device__ __forceinline__ unsigned long long* MASK() const { return (unsigned long long*)(ws + WS_MASK); }
};

__device__ __forceinline__ void win_group(int n0, int& src, int& nv) {
    const int pn = n0 >> 8, p = n0 & 255;
    nv = 32;
    if (pn < 4) { src = n0; }
    else if (pn < 8 || (pn >= 10 && pn < 12)) {
        const int base = (pn < 6) ? 1024 + 256 * (pn - 4) : (pn < 8) ? 1536 + 256 * (pn - 6) : 2560 + 256 * (pn - 10);
        src = base + 64 * ((p & 127) >> 5) + 32 * (p >> 7);
    } else if (pn < 10) { src = n0; }
    else if (pn == 12) {
        if (p < 32) src = 3072; else if (p < 64) { src = 3136; nv = 8; } else if (p >= 128 && p < 160) src = 3104; else { src = 0; nv = 0; }
    } else { src = 3144 + (n0 - 3328); }
}
__device__ __forceinline__ void transpose_item(const float* W, int K, int N, int src0, int nv, const float* kscale, bf16_t* WT, int dstrow0, LAS float* scr, int k0, int lane, int pitch = 0, int kdst = 0) {
    if (pitch == 0) pitch = K;
    const int c4 = (lane & 7) * 4, rr = lane >> 3;
    f32x4 v[8];
#pragma unroll
    for (int i = 0; i < 8; ++i) v[i] = (c4 < nv) ? *(const f32x4*)(W + (size_t)(k0 + 8 * i + rr) * N + src0 + c4) : (f32x4){0.f, 0.f, 0.f, 0.f};
#pragma unroll
    for (int i = 0; i < 8; ++i) { const int kk = 8 * i + rr; const float ks = kscale ? kscale[k0 + kk] : 1.0f;
        scr[kk * 33 + c4] = v[i][0] * ks; scr[kk * 33 + c4 + 1] = v[i][1] * ks; scr[kk * 33 + c4 + 2] = v[i][2] * ks; scr[kk * 33 + c4 + 3] = v[i][3] * ks; }
    asm volatile("s_waitcnt lgkmcnt(0)" ::: "memory");
    const int c8 = lane & 7;
#pragma unroll
    for (int j = 0; j < 4; ++j) {
        const int n = (lane >> 3) + 8 * j; const LAS float* s = scr + (8 * c8) * 33 + n;
        u32x4 o; o.x = pk2(s[0 * 33], s[1 * 33]); o.y = pk2(s[2 * 33], s[3 * 33]); o.z = pk2(s[4 * 33], s[5 * 33]); o.w = pk2(s[6 * 33], s[7 * 33]);
        *(u32x4*)(WT + (size_t)(dstrow0 + n) * pitch + kdst + k0 + 8 * c8) = o;
    }
    asm volatile("s_waitcnt lgkmcnt(0)" ::: "memory");
}
__device__ __forceinline__ void p0_prologue(Frame& F) {
    LAS float* scr = (LAS float*)(F.lds + F.wave * 8704);
    constexpr int I_WIN = 16 * (NP / 32), I_WA = 8 * 32, I_WB = 8 * 32, I_WO = 16 * 32, I_W1 = 16 * 128, I_W2 = 64 * 32;
    constexpr int NITEMS = I_WIN + I_WA + I_WB + I_WO + I_W1 + I_W2;
    for (int it = F.gw; it < NITEMS; it += F.ngw) {
        int r = it;
        if (r < I_WIN) { const int nb = r % (NP / 32), kb = r / (NP / 32); int src, nv; win_group(nb * 32, src, nv);
            transpose_item(F.w_in(), 1024, DIN, src, nv, F.norm1_g(), F.WIN(), nb * 32, scr, kb * 64, F.lane); continue; } r -= I_WIN;
        if (r < I_WA) { const int nb = r % 32, kb = r / 32; transpose_item(F.w_out_a(), 512, 1024, nb * 32, 32, nullptr, F.WA(), nb * 32, scr, kb * 64, F.lane, 1024, 0); continue; } r -= I_WA;
        if (r < I_WB) { const int nb = r % 32, kb = r / 32; transpose_item(F.w_out_b(), 512, 1024, nb * 32, 32, nullptr, F.WA(), nb * 32, scr, kb * 64, F.lane, 1024, 512); continue; } r -= I_WB;
        if (r < I_WO) { const int nb = r % 32, kb = r / 32; transpose_item(F.w_o(), 1024, 1024, nb * 32, 32, nullptr, F.WO(), nb * 32, scr, kb * 64, F.lane); continue; } r -= I_WO;
        if (r < I_W1) { const int nb = r % 128, kb = r / 128; transpose_item(F.w_ff_in(), 1024, 4096, nb * 32, 32, F.norm2_g(), F.W1(), nb * 32, scr, kb * 64, F.lane); continue; } r -= I_W1;
        { const int nb = r % 32, kb = r / 32; transpose_item(F.w_ff_out(), 4096, 1024, nb * 32, 32, nullptr, F.W2(), nb * 32, scr, kb * 64, F.lane); }
    }
    for (int m = F.gw; m < M; m += 4 * F.ngw) {
        f32x4 v[4][4]; float ss[4];
#pragma unroll
        for (int r = 0; r < 4; ++r) { const int mr = (m + r * F.ngw < M) ? m + r * F.ngw : m; const f32x4* xr = (const f32x4*)(F.x() + (size_t)mr * D) + F.lane;
#pragma unroll
            for (int j = 0; j < 4; ++j) v[r][j] = xr[64 * j]; }
#pragma unroll
        for (int r = 0; r < 4; ++r) { const int mr = m + r * F.ngw; if (mr < M) {
            float s2 = 0.f;
#pragma unroll
            for (int j = 0; j < 4; ++j) s2 += (v[r][j].x * v[r][j].x + v[r][j].y * v[r][j].y) + (v[r][j].z * v[r][j].z + v[r][j].w * v[r][j].w);
            ss[r] = s2;
            u32x2* o = (u32x2*)(F.XB() + (size_t)mr * D) + F.lane;
#pragma unroll
            for (int j = 0; j < 4; ++j) { u32x2 w; w.x = pk2(v[r][j].x, v[r][j].y); w.y = pk2(v[r][j].z, v[r][j].w); o[64 * j] = w; } } else ss[r] = 0.f; }
#pragma unroll
        for (int o = 1; o < 64; o <<= 1) {
#pragma unroll
            for (int r = 0; r < 4; ++r) ss[r] += __shfl_xor(ss[r], o); }
        if (F.lane == 0) {
#pragma unroll
            for (int r = 0; r < 4; ++r) { const int mr = m + r * F.ngw; if (mr < M) F.RS1()[mr] = 1.0f / sqrtf(ss[r] * (1.0f / D) + EPS); } }
    }
    const int gt = F.gw * 64 + F.lane, ngt = F.ngw * 64;
    for (int i = gt; i < SEQ * 32; i += ngt) {
        const int pos = i >> 5, j = i & 31;
        const float inv = (float)pow(10000.0, -(double)j / 32.0);
        const float ang = (float)pos * inv;
        F.COS()[i] = (float)cos((double)ang); F.SIN()[i] = (float)sin((double)ang);
    }
    for (int i = gt; i < 4 * 128 * 128; i += ngt) { const int t = (i >> 7) & 127, s = i & 127; F.WSB()[i] = (bf16_t)f2bf(s <= t ? F.w_s()[i] : 0.f); }
}

template <class Epi>
__device__ __forceinline__ void sgemm(const bf16_t* A, const bf16_t* Bt, int Mr, int N, int K, const Epi& epi, int gw, int ngw, int lane) {
    const int c = lane & 15, q = lane >> 4;
    const int ntn = (N / 256) * 4, ntiles = (Mr / 64) * ntn;
    for (int t = gw; t < ntiles; t += ngw) {
        const int tm = t / ntn, r = t % ntn, pn = r >> 2, wc = r & 3;
        const int row0 = tm * 64, col0 = pn * 256 + wc * 32;
        f32x4 acc[4][2][2];
#pragma unroll
        for (int m = 0; m < 4; ++m)
#pragma unroll
            for (int bj = 0; bj < 2; ++bj)
#pragma unroll
                for (int n = 0; n < 2; ++n) acc[m][bj][n] = (f32x4){0.f, 0.f, 0.f, 0.f};
        const bf16_t* ap = A + (size_t)(row0 + c) * K + 8 * q;
        const bf16_t* bp = Bt + (size_t)(col0 + c) * K + 8 * q;
        for (int k0 = 0; k0 < K; k0 += 32) {
            bf16x8 a[4], b[2][2];
#pragma unroll
            for (int m = 0; m < 4; ++m) a[m] = *(const bf16x8*)(ap + (size_t)(16 * m) * K + k0);
#pragma unroll
            for (int bj = 0; bj < 2; ++bj)
#pragma unroll
                for (int n = 0; n < 2; ++n) b[bj][n] = *(const bf16x8*)(bp + (size_t)(128 * bj + 16 * n) * K + k0);
#pragma unroll
            for (int m = 0; m < 4; ++m)
#pragma unroll
                for (int bj = 0; bj < 2; ++bj)
#pragma unroll
                    for (int n = 0; n < 2; ++n) acc[m][bj][n] = __builtin_amdgcn_mfma_f32_16x16x32_bf16(a[m], b[bj][n], acc[m][bj][n], 0, 0, 0);
        }
#pragma unroll
        for (int m = 0; m < 4; ++m)
#pragma unroll
            for (int n = 0; n < 2; ++n)
#pragma unroll
                for (int i = 0; i < 4; ++i) epi(row0 + 16 * m + 4 * q + i, col0 + 16 * n + c, acc[m][0][n][i], acc[m][1][n][i]);
    }
}

struct EpiProj {
    const float *RS1, *COS, *SIN; bf16_t *U, *VG, *Q, *K, *V, *G; unsigned short *QI, *KI; float* WI;
    __device__ __forceinline__ void operator()(int row, int pcol, float a0, float a1) const {
        const float rs = RS1[row]; const float v0 = a0 * rs, v1 = a1 * rs;
        const int pn = pcol >> 8, p = pcol & 255;
        if (pn < 2) { bf16_t* o = U + (size_t)row * UP + pn * 256 + p; o[0] = (bf16_t)f2bf(gelu_tanh(v0)); o[128] = (bf16_t)f2bf(gelu_tanh(v1)); }
        else if (pn < 4) { bf16_t* o = VG + (size_t)row * 512 + (pn - 2) * 256 + p; o[0] = (bf16_t)f2bf(gelu_tanh(v0)); o[128] = (bf16_t)f2bf(gelu_tanh(v1)); }
        else if (pn < 8 || pn == 10 || pn == 11) {
            const int pos = row & (SEQ - 1), d = p & 31, hit = p >> 5;
            const float cs = COS[pos * 32 + d], sn = SIN[pos * 32 + d];
            const float lo = v0 * cs - v1 * sn, hi = v1 * cs + v0 * sn;
            if (pn < 6) { bf16_t* o = Q + (size_t)row * 512 + (pn - 4) * 256 + hit * 64 + d; o[0] = (bf16_t)f2bf(lo * C2); o[32] = (bf16_t)f2bf(hi * C2); }
            else if (pn < 8) { bf16_t* o = K + (size_t)row * 512 + (pn - 6) * 256 + hit * 64 + d; o[0] = (bf16_t)f2bf(lo); o[32] = (bf16_t)f2bf(hi); }
            else { unsigned short* o = QI + (size_t)row * 512 + (pn - 10) * 256 + hit * 64 + d; o[0] = f2h(lo); o[32] = f2h(hi); }
        }
        else if (pn < 10) { bf16_t* o = V + (size_t)row * 512 + (pn - 8) * 256 + p; o[0] = (bf16_t)f2bf(v0); o[128] = (bf16_t)f2bf(v1); }
        else if (pn == 12) {
            if (p < 32) { const int pos = row & (SEQ - 1); const float cs = COS[pos * 32 + p], sn = SIN[pos * 32 + p];
                unsigned short* o = KI + (size_t)(row >> 12) * SEQ * 64; o[ki_off(pos, p)] = f2h(v0 * cs - v1 * sn); o[ki_off(pos, p + 32)] = f2h(v1 * cs + v0 * sn); }
            else if (p < 40) { WI[(size_t)row * 8 + (p - 32)] = v0 * IDX_SCALE; }
        }
        else { bf16_t* o = G + (size_t)row * 2048 + (pn - 13) * 256 + p; o[0] = (bf16_t)f2bf(sigmoidf(v0)); o[128] = (bf16_t)f2bf(sigmoidf(v1)); }
    }
};
struct EpiMergeA { const bf16_t* G; bf16_t* MG;
    __device__ __forceinline__ void operator()(int row, int col, float a0, float a1) const {
        const bf16_t* g = G + (size_t)row * 2048 + col; bf16_t* o = MG + (size_t)row * 1024 + col;
        o[0] = (bf16_t)f2bf(bf2f(g[0]) * a0); o[128] = (bf16_t)f2bf(bf2f(g[128]) * a1); } };
struct EpiMergeB { const bf16_t* G; bf16_t* MG;
    __device__ __forceinline__ void operator()(int row, int col, float a0, float a1) const {
        const bf16_t* g = G + (size_t)row * 2048 + 1024 + col; bf16_t* o = MG + (size_t)row * 1024 + col;
        o[0] = (bf16_t)f2bf(bf2f(o[0]) + bf2f(g[0]) * a0); o[128] = (bf16_t)f2bf(bf2f(o[128]) + bf2f(g[128]) * a1); } };
struct EpiWo { const float* x; float* X1; bf16_t* X1B;
    __device__ __forceinline__ void operator()(int row, int col, float a0, float a1) const {
        const size_t o = (size_t)row * 1024 + col; const float r0 = x[o] + a0, r1 = x[o + 128] + a1;
        X1[o] = r0; X1[o + 128] = r1; X1B[o] = (bf16_t)f2bf(r0); X1B[o + 128] = (bf16_t)f2bf(r1); } };
struct EpiFF1 { const float* RS2; bf16_t* H;
    __device__ __forceinline__ void operator()(int row, int col, float a0, float a1) const {
        const float rs = RS2[row]; const float h0 = fmaxf(a0 * rs, 0.f), h1 = fmaxf(a1 * rs, 0.f);
        bf16_t* o = H + (size_t)row * 4096 + col; o[0] = (bf16_t)f2bf(h0 * h0); o[128] = (bf16_t)f2bf(h1 * h1); } };
struct EpiFF2 { float* X;
    __device__ __forceinline__ void operator()(int row, int col, float a0, float a1) const {
        const size_t o = (size_t)row * 1024 + col; X[o] += a0; X[o + 128] += a1; } };

__device__ __forceinline__ void sgu_simple(Frame& F) {
    LAS float* vs = (LAS float*)F.lds;
    LAS bf16_t* wsl = (LAS bf16_t*)(F.lds + 65536);
    LAS float* st = (LAS float*)(F.lds + 65536 + 32768);
    for (int bc = blockIdx.x; bc < M / 128; bc += gridDim.x) {
        const int row0 = bc * 128;
        for (int i = 0; i < 16; ++i) {
            const int r = F.wave * 16 + i;
            const u32x4 w = *(const u32x4*)(F.VG() + (size_t)(row0 + r) * 512 + F.lane * 8);
            float v[8]; v[0] = bf2f(w.x & 0xffff); v[1] = bf2f(w.x >> 16); v[2] = bf2f(w.y & 0xffff); v[3] = bf2f(w.y >> 16);
            v[4] = bf2f(w.z & 0xffff); v[5] = bf2f(w.z >> 16); v[6] = bf2f(w.w & 0xffff); v[7] = bf2f(w.w >> 16);
            float s = 0.f;
#pragma unroll
            for (int j = 0; j < 8; ++j) s += v[j];
            const float mean = wave_sum(s) * (1.f / 512.f); float q = 0.f;
#pragma unroll
            for (int j = 0; j < 8; ++j) { const float d = v[j] - mean; q += d * d; }
            const float rstd = 1.0f / sqrtf(wave_sum(q) * (1.f / 512.f) + EPS);
            if (F.lane == 0) { st[2 * r] = mean; st[2 * r + 1] = rstd; }
        }
        __syncthreads();
        for (int g = 0; g < 4; ++g) {
            for (int idx = F.tid; idx < 16384; idx += NT) {
                const int s = idx >> 7, d = idx & 127;
                const float v = bf2f(F.VG()[(size_t)(row0 + s) * 512 + g * 128 + d]);
                vs[idx] = (v - st[2 * s]) * st[2 * s + 1] * F.ln_g()[g * 128 + d] + F.ln_b()[g * 128 + d];
                wsl[idx] = F.WSB()[g * 16384 + idx];
            }
            __syncthreads();
            for (int idx = F.tid; idx < 16384; idx += NT) {
                const int t = idx >> 7, d = idx & 127; float acc = 0.f;
                for (int s = 0; s <= t; ++s) acc += bf2f(wsl[t * 128 + s]) * vs[s * 128 + d];
                const float sf = acc + F.b_s()[g * 128 + t];
                bf16_t* u = F.U() + (size_t)(row0 + t) * UP + g * 128 + d;
                *u = (bf16_t)f2bf(bf2f(*u) * sf);
            }
            __syncthreads();
        }
    }
}

__device__ __forceinline__ void indexer_simple(Frame& F) {
    LAS float* sc = (LAS float*)F.lds;
    LAS float* qf = (LAS float*)(F.lds + 16384);
    LAS float* wl = (LAS float*)(F.lds + 16384 + 2048);
    LAS unsigned* cnt = (LAS unsigned*)(F.lds + 16384 + 2048 + 64);
    LAS unsigned* eqc = (LAS unsigned*)(F.lds + 20480);
    for (int r = blockIdx.x; r < M; r += gridDim.x) {
        const int t = r & (SEQ - 1), b = r >> 12;
        unsigned char* mrow = (unsigned char*)(F.MASK() + ((size_t)(b * 64 + (F.tid >> 3)) * SEQ + t)) + (F.tid & 7);
        if (t < 255) {
            unsigned m = 0;
#pragma unroll
            for (int i = 0; i < 8; ++i) m |= ((8 * F.tid + i) <= t) ? (1u << i) : 0u;
            *mrow = (unsigned char)m;
            continue;
        }
        qf[F.tid] = h2f(F.QI()[(size_t)r * 512 + F.tid]);
        if (F.tid < 8) wl[F.tid] = F.WI()[(size_t)r * 8 + F.tid];
        if (F.tid == 0) { cnt[0] = 0; cnt[1] = 0; }
        __syncthreads();
        for (int s = F.tid; s < SEQ; s += NT) {
            float score = 0.f;
            if (s <= t) {
                const unsigned short* kb_ = F.KI() + (size_t)b * SEQ * 64;
                float kf[64];
#pragma unroll
                for (int j = 0; j < 8; ++j) { const u32x4 w = *(const u32x4*)(kb_ + ki_off(s, 8 * j));
                    kf[8 * j + 0] = h2f(w.x & 0xffff); kf[8 * j + 1] = h2f(w.x >> 16); kf[8 * j + 2] = h2f(w.y & 0xffff); kf[8 * j + 3] = h2f(w.y >> 16);
                    kf[8 * j + 4] = h2f(w.z & 0xffff); kf[8 * j + 5] = h2f(w.z >> 16); kf[8 * j + 6] = h2f(w.w & 0xffff); kf[8 * j + 7] = h2f(w.w >> 16); }
#pragma unroll 1
                for (int h = 0; h < 8; ++h) {
                    float dot = 0.f;
#pragma unroll
                    for (int d = 0; d < 64; ++d) dot += qf[h * 64 + d] * kf[d];
                    score += wl[h] * fmaxf(dot, 0.f);
                }
            }
            sc[s] = score;
        }
        __syncthreads();
        unsigned key[8];
#pragma unroll
        for (int i = 0; i < 8; ++i) { const int s = 8 * F.tid + i; key[i] = (s <= t) ? ukey(sc[s]) : 0u; }
        unsigned lo = 1u, hi = 0xFFFFFFFFu; int it = 0;
        while (hi - lo > 1u) {
            const unsigned mid = lo + ((hi - lo) >> 1);
            unsigned c = 0;
#pragma unroll
            for (int i = 0; i < 8; ++i) c += (key[i] >= mid) ? 1u : 0u;
            c = wave_sum_u(c);
            __syncthreads();
            if (F.tid == 0) cnt[(it + 1) & 1] = 0;
            if (F.lane == 0) atomicAdd((unsigned*)&cnt[it & 1], c);
            __syncthreads();
            const unsigned tot = cnt[it & 1];
            if (tot >= 256u) lo = mid; else hi = mid;
            ++it;
        }
        const unsigned T = lo;
        unsigned cgt = 0, ceq = 0;
#pragma unroll
        for (int i = 0; i < 8; ++i) { cgt += (key[i] > T) ? 1u : 0u; ceq += (key[i] == T) ? 1u : 0u; }
        eqc[F.tid] = ceq;
        const unsigned cg = wave_sum_u(cgt);
        __syncthreads();
        if (F.tid == 0) cnt[(it + 1) & 1] = 0;
        if (F.lane == 0) atomicAdd((unsigned*)&cnt[it & 1], cg);
        __syncthreads();
        const unsigned need = 256u - cnt[it & 1];
        unsigned before = 0;
        for (int j = 0; j < F.tid; ++j) before += eqc[j];
        unsigned m = 0;
#pragma unroll
        for (int i = 0; i < 8; ++i) {
            bool sel = key[i] > T;
            if (key[i] == T) { sel = before < need; ++before; }
            m |= sel ? (1u << i) : 0u;
        }
        *mrow = (unsigned char)m;
        __syncthreads();
    }
}

__device__ __forceinline__ void attn_simple(Frame& F) {
    for (int task = F.gw; task < M * 8; task += F.ngw) {
        const int row = task >> 3, h = task & 7, t = row & (SEQ - 1), b = row >> 12;
        const float q = bf2f(F.Q()[(size_t)row * 512 + h * 64 + F.lane]);
        float m = -INFINITY, l = 0.f, acc = 0.f;
        for (int tile = 0; tile <= (t >> 6); ++tile) {
            unsigned long long w = F.MASK()[(size_t)(b * 64 + tile) * SEQ + t];
            w = (unsigned long long)(unsigned)__builtin_amdgcn_readfirstlane((unsigned)w) | ((unsigned long long)(unsigned)__builtin_amdgcn_readfirstlane((unsigned)(w >> 32)) << 32);
            while (w) {
                const int i = __builtin_ctzll(w); w &= w - 1;
                const size_t kr = (size_t)(b * SEQ + tile * 64 + i) * 512 + h * 64 + F.lane;
                const float logit = wave_sum(q * bf2f(F.K()[kr]));
                const float mn = fmaxf(m, logit), scl = __builtin_amdgcn_exp2f(m - mn), pe = __builtin_amdgcn_exp2f(logit - mn);
                l = l * scl + pe; acc = acc * scl + pe * bf2f(F.V()[kr]); m = mn;
            }
        }
        F.Q()[(size_t)row * 512 + h * 64 + F.lane] = (bf16_t)f2bf(acc / l);
    }
}

__device__ __forceinline__ void rs2_rows(Frame& F) {
    for (int m = F.gw; m < M; m += F.ngw) {
        const f32x4* xr = (const f32x4*)(F.out + (size_t)m * D) + F.lane; float s = 0.f;
#pragma unroll
        for (int j = 0; j < 4; ++j) { const f32x4 v = xr[64 * j]; s += (v.x * v.x + v.y * v.y) + (v.z * v.z + v.w * v.w); }
        s = wave_sum(s);
        if (F.lane == 0) F.RS2()[m] = 1.0f / sqrtf(s * (1.0f / D) + EPS);
        if (F.lane < 16) F.SS2()[(size_t)m * 16 + F.lane] = F.lane == 0 ? s : 0.f;
    }
}
__device__ __forceinline__ f32x4 bfx_lo4(const u32x4& w) { return (f32x4){__uint_as_float(w.x << 16), __uint_as_float(w.x & 0xffff0000u), __uint_as_float(w.y << 16), __uint_as_float(w.y & 0xffff0000u)}; }
__device__ __forceinline__ f32x4 bfx_hi4(const u32x4& w) { return (f32x4){__uint_as_float(w.z << 16), __uint_as_float(w.z & 0xffff0000u), __uint_as_float(w.w << 16), __uint_as_float(w.w & 0xffff0000u)}; }
__device__ __forceinline__ void final_norm(Frame& F) {
    for (int m = F.gw; m < M; m += 2 * F.ngw) {
        const int mb = (m + F.ngw < M) ? m + F.ngw : m;
        u32x4 wa[2], wb[2];
#pragma unroll
        for (int j = 0; j < 2; ++j) { wa[j] = *((const u32x4*)(F.X1B() + (size_t)m * D) + F.lane + 64 * j); wb[j] = *((const u32x4*)(F.X1B() + (size_t)mb * D) + F.lane + 64 * j); }
        f32x4 va[2][2], vb[2][2]; float sa = 0.f, sb = 0.f;
#pragma unroll
        for (int j = 0; j < 2; ++j) { va[j][0] = bfx_lo4(wa[j]); va[j][1] = bfx_hi4(wa[j]); vb[j][0] = bfx_lo4(wb[j]); vb[j][1] = bfx_hi4(wb[j]);
#pragma unroll
            for (int h = 0; h < 2; ++h) { sa += (va[j][h].x * va[j][h].x + va[j][h].y * va[j][h].y) + (va[j][h].z * va[j][h].z + va[j][h].w * va[j][h].w);
                sb += (vb[j][h].x * vb[j][h].x + vb[j][h].y * vb[j][h].y) + (vb[j][h].z * vb[j][h].z + vb[j][h].w * vb[j][h].w); } }
#pragma unroll
        for (int o = 1; o < 64; o <<= 1) { sa += __shfl_xor(sa, o); sb += __shfl_xor(sb, o); }
        const float ra = 1.0f / sqrtf(sa * (1.0f / D) + EPS), rb = 1.0f / sqrtf(sb * (1.0f / D) + EPS);
#pragma unroll
        for (int j = 0; j < 2; ++j)
#pragma unroll
            for (int h = 0; h < 2; ++h) { const f32x4 g = *((const f32x4*)F.norm_f_g() + 2 * (F.lane + 64 * j) + h);
                *((f32x4*)(F.out + (size_t)m * D) + 2 * (F.lane + 64 * j) + h) = va[j][h] * ra * g;
                if (mb != m) *((f32x4*)(F.out + (size_t)mb * D) + 2 * (F.lane + 64 * j) + h) = vb[j][h] * rb * g; }
    }
}

typedef float f32x16 __attribute__((ext_vector_type(16)));
#ifndef DUP_MFMA
#define DUP_MFMA 0
#endif
#ifndef DUP_VALU
#define DUP_VALU 0
#endif
#ifndef DUP_LOAD
#define DUP_LOAD 0
#endif
__device__ __forceinline__ float relu1(float x) { const int b = __float_as_int(x); return __int_as_float(b > 0 ? b : 0); }
__device__ __forceinline__ float fkey(unsigned k) { return __uint_as_float((k & 0x80000000u) ? (k ^ 0x80000000u) : ~k); }
__device__ __forceinline__ void indexer_fast(Frame& F) {
    LAS float* sc = (LAS float*)F.lds;
    const int lane = F.lane, w = F.wave, c = lane & 31, hf = lane >> 5;
    const int qr = ((c >> 2) & 1) * 2 + (c >> 4), hr = (c & 3) + 4 * ((c >> 3) & 1);
#ifdef PROBE_SUB
    unsigned long long tacc_[5] = {0ull, 0ull, 0ull, 0ull, 0ull}; unsigned long long ts_ = 0;
#define TS0() do { ts_ = __builtin_amdgcn_s_memrealtime(); } while (0)
#define TS1(k) do { const unsigned long long e_ = __builtin_amdgcn_s_memrealtime(); tacc_[k] += e_ - ts_; ts_ = e_; } while (0)
#else
#define TS0() do {} while (0)
#define TS1(k) do {} while (0)
#endif
    constexpr int QIS_OFF = 131072 + 2048, WIS_OFF = QIS_OFF + 8192, TCNT_OFF = WIS_OFF + 256, HIST_OFF = TCNT_OFF + 64, HIST_WB = 608;
    LAS unsigned* tcnt = (LAS unsigned*)(F.lds + TCNT_OFF);
    if (F.tid == 0) *tcnt = 0u;
    u32x4 sa = {0u, 0u, 0u, 0u}, sw = {0u, 0u, 0u, 0u};
#define IDX_REAL(gg) ((((gg) >> 3) * 8 + 7) > 255)
#define STAGE_LOAD(gg) do { const size_t r_ = (size_t)((gg) & 7) * SEQ + (size_t)((gg) >> 3) * 8; int tq_ = F.tid; asm volatile("" : "+v"(tq_));      \
        sa = *(const u32x4*)(F.QI() + r_ * 512 + tq_ * 8); if (tq_ < 16) sw = *(const u32x4*)(F.WI() + r_ * 8 + tq_ * 4); } while (0)
#define STAGE_WRITE() do { *(LAS u32x4*)(F.lds + QIS_OFF + F.tid * 16) = sa; if (F.tid < 16) *(LAS u32x4*)(F.lds + WIS_OFF + F.tid * 16) = sw; } while (0)
#define G_OF(i) ((i) * (int)gridDim.x + (((i) & 1) ? (int)gridDim.x - 1 - (int)blockIdx.x : (int)blockIdx.x))
    { int i_f = 0; while (G_OF(i_f) < BATCH * (SEQ / 8) && !IDX_REAL(G_OF(i_f))) ++i_f;
      const int gf = G_OF(i_f); if (gf < BATCH * (SEQ / 8)) { STAGE_LOAD(gf); STAGE_WRITE(); } }
    __syncthreads();
    for (int it = 0;; ++it) {
        const int g = G_OF(it); if (g >= BATCH * (SEQ / 8)) break;
        const int b = g & 7, t0 = (g >> 3) * 8, t = t0 + w;
        const size_t rowbase = (size_t)b * SEQ;
        unsigned long long myword = 0ull;
        if (t0 + 7 <= 255) {
            const int jm = t >> 6;
            myword = lane < jm ? ~0ull : (lane == jm ? ((2ull << (t & 63)) - 1ull) : 0ull);
        } else {
            TS0();
#define LOAD_WQ() float wq[2][2][8]; do { int wo_ = WIS_OFF + 64 * hf; asm volatile("" : "+v"(wo_)); \
                _Pragma("unroll") for (int s = 0; s < 2; ++s) _Pragma("unroll") for (int g2 = 0; g2 < 2; ++g2) { const LAS f32x4* wp = (const LAS f32x4*)(F.lds + wo_ + (4 * s + g2) * 32); const f32x4 a = wp[0], bb = wp[1]; \
                    wq[s][g2][0] = a[0]; wq[s][g2][1] = a[1]; wq[s][g2][2] = a[2]; wq[s][g2][3] = a[3]; wq[s][g2][4] = bb[0]; wq[s][g2][5] = bb[1]; wq[s][g2][6] = bb[2]; wq[s][g2][7] = bb[3]; } } while (0)
            f16x8 af[2][4];
#pragma unroll
            for (int s = 0; s < 2; ++s)
#pragma unroll
                for (int ks = 0; ks < 4; ++ks) af[s][ks] = *(const LAS f16x8*)(F.lds + QIS_OFF + ((4 * s + qr) * 512 + hr * 64 + 16 * ks + 8 * hf) * 2);
            const int gn = G_OF(it + 1); const bool stage_next = gn < BATCH * (SEQ / 8) && IDX_REAL(gn);
            if (stage_next) STAGE_LOAD(gn);
            const int ntile = (t0 + 8 + 31) >> 5;
            const unsigned short* kp0 = F.KI() + rowbase * 64 + lane * 8;
#define LOAD_PAIR(BUF, TB) do { _Pragma("unroll") for (int u2 = 0; u2 < 2; ++u2) { const int tl_ = (TB) + u2; const int tc_ = tl_ < ntile ? tl_ : 0; \
                _Pragma("unroll") for (int ks = 0; ks < 4; ++ks) BUF[u2][ks] = *(const f16x8*)(kp0 + (size_t)tc_ * 2048 + 512 * ks); } } while (0)
#define SCORE_PAIR(BUF, TB) do { const int tl0 = (TB), tl1 = (TB) + 1; \
                f32x16 d00 = {0.f, 0.f, 0.f, 0.f, 0.f, 0.f, 0.f, 0.f, 0.f, 0.f, 0.f, 0.f, 0.f, 0.f, 0.f, 0.f}, d01 = d00, d10 = d00, d11 = d00; \
                _Pragma("unroll") for (int ks = 0; ks < 4; ++ks) { d00 = __builtin_amdgcn_mfma_f32_32x32x16_f16(af[0][ks], BUF[0][ks], d00, 0, 0, 0); d01 = __builtin_amdgcn_mfma_f32_32x32x16_f16(af[1][ks], BUF[0][ks], d01, 0, 0, 0); \
                    d10 = __builtin_amdgcn_mfma_f32_32x32x16_f16(af[0][ks], BUF[1][ks], d10, 0, 0, 0); d11 = __builtin_amdgcn_mfma_f32_32x32x16_f16(af[1][ks], BUF[1][ks], d11, 0, 0, 0); } \
                LOAD_WQ(); float sA[2][2], sB[2][2]; \
                _Pragma("unroll") for (int g2 = 0; g2 < 2; ++g2) { sA[0][g2] = wq[0][g2][0] * relu1(d00[8 * g2]); sA[1][g2] = wq[1][g2][0] * relu1(d01[8 * g2]); sB[0][g2] = wq[0][g2][0] * relu1(d10[8 * g2]); sB[1][g2] = wq[1][g2][0] * relu1(d11[8 * g2]); } \
                _Pragma("unroll") for (int h = 1; h < 8; ++h) _Pragma("unroll") for (int g2 = 0; g2 < 2; ++g2) { sA[0][g2] += wq[0][g2][h] * relu1(d00[8 * g2 + h]); sA[1][g2] += wq[1][g2][h] * relu1(d01[8 * g2 + h]); \
                    sB[0][g2] += wq[0][g2][h] * relu1(d10[8 * g2 + h]); sB[1][g2] += wq[1][g2][h] * relu1(d11[8 * g2 + h]); } \
                _Pragma("unroll") for (int s2 = 0; s2 < 2; ++s2) _Pragma("unroll") for (int g2 = 0; g2 < 2; ++g2) { sc[(4 * s2 + 2 * hf + g2) * 4096 + tl0 * 32 + c] = sA[s2][g2]; if (tl1 < ntile) sc[(4 * s2 + 2 * hf + g2) * 4096 + tl1 * 32 + c] = sB[s2][g2]; } } while (0)
            f16x8 kb0[2][4], kb1[2][4], kb2[2][4];
#define GRAB() ((int)__builtin_amdgcn_readfirstlane((int)(lane == 0 ? __hip_atomic_fetch_add(tcnt, 2u, __ATOMIC_RELAXED, __HIP_MEMORY_SCOPE_WORKGROUP) : 0u)))
            int p0 = GRAB(), p1, p2;
            LOAD_PAIR(kb0, p0); p1 = GRAB(); LOAD_PAIR(kb1, p1);
            for (;;) {
                p2 = GRAB(); LOAD_PAIR(kb2, p2); if (p0 >= ntile) break; SCORE_PAIR(kb0, p0);
                p0 = GRAB(); LOAD_PAIR(kb0, p0); if (p1 >= ntile) break; SCORE_PAIR(kb1, p1);
                p1 = GRAB(); LOAD_PAIR(kb1, p1); if (p2 >= ntile) break; SCORE_PAIR(kb2, p2);
            }
#undef GRAB
#undef LOAD_PAIR
#undef SCORE_PAIR
#undef LOAD_WQ
            TS1(0);
            __syncthreads();
            TS1(1);
            typedef float f32x2v __attribute__((ext_vector_type(2)));
            f32x2v sf[32];
            const int jm = t >> 6;
#pragma unroll
            for (int blk = 0; blk < 4; ++blk) {
                if (jm >= 16 * blk) {
                    float v[16];
#pragma unroll
                    for (int jj = 0; jj < 16; ++jj) v[jj] = sc[w * 4096 + (16 * blk + jj) * 64 + lane];
#pragma unroll
                    for (int jj = 0; jj < 16; ++jj) asm volatile("" : "+v"(v[jj]));
#pragma unroll
                    for (int jj = 0; jj < 16; ++jj) { const int j = 16 * blk + jj, idx = j * 64 + lane; sf[j >> 1][j & 1] = (idx <= t) ? v[jj] : -1048576.0f; }
                } else {
#pragma unroll
                    for (int jj = 0; jj < 16; ++jj) sf[(16 * blk + jj) >> 1][jj & 1] = -1048576.0f;
                }
            }
            if (F.tid == 0) *tcnt = 0u;
            if (stage_next) STAGE_WRITE();
            asm volatile("s_waitcnt lgkmcnt(0)" ::: "memory");
            __syncthreads();
#define COUNT_GE(MID, OUT) do { const unsigned pm_ = (MID) - 1u; const float pf_ = (pm_ - 0x7FFFFFFEu <= 1u) ? -7.8886091e-31f : fkey(pm_);     \
                const float cc_ = -pf_ * 1.2676506e30f; const f32x2v big_ = {1.2676506e30f, 1.2676506e30f}; \
                float q0_ = 0.f, q1_ = 0.f, q2_ = 0.f, q3_ = 0.f; \
                _Pragma("unroll") for (int blk = 0; blk < 4; ++blk) if (jm >= 16 * blk) { \
                    _Pragma("unroll") for (int pp = 0; pp < 8; pp += 2) { float t0_, t1_, t2_, t3_; \
                        asm("v_fma_f32 %0, %1, %2, %3 clamp" : "=v"(t0_) : "v"(sf[8 * blk + pp][0]), "v"(big_[0]), "v"(cc_)); asm("v_fma_f32 %0, %1, %2, %3 clamp" : "=v"(t1_) : "v"(sf[8 * blk + pp][1]), "v"(big_[0]), "v"(cc_)); \
                        asm("v_fma_f32 %0, %1, %2, %3 clamp" : "=v"(t2_) : "v"(sf[8 * blk + pp + 1][0]), "v"(big_[0]), "v"(cc_)); asm("v_fma_f32 %0, %1, %2, %3 clamp" : "=v"(t3_) : "v"(sf[8 * blk + pp + 1][1]), "v"(big_[0]), "v"(cc_)); \
                        asm("v_add_f32 %0, %0, %1" : "+v"(q0_) : "v"(t0_)); asm("v_add_f32 %0, %0, %1" : "+v"(q1_) : "v"(t1_)); asm("v_add_f32 %0, %0, %1" : "+v"(q2_) : "v"(t2_)); asm("v_add_f32 %0, %0, %1" : "+v"(q3_) : "v"(t3_)); } } \
                int cl_ = (int)((q0_ + q1_) + (q2_ + q3_)); \
                cl_ += __builtin_amdgcn_update_dpp(0, cl_, 0xB1, 0xF, 0xF, true); cl_ += __builtin_amdgcn_update_dpp(0, cl_, 0x4E, 0xF, 0xF, true);        \
                cl_ += __builtin_amdgcn_update_dpp(0, cl_, 0x141, 0xF, 0xF, true); cl_ += __builtin_amdgcn_update_dpp(0, cl_, 0x140, 0xF, 0xF, true);      \
                OUT = (unsigned)((__builtin_amdgcn_readlane(cl_, 0) + __builtin_amdgcn_readlane(cl_, 16)) + (__builtin_amdgcn_readlane(cl_, 32) + __builtin_amdgcn_readlane(cl_, 48))); } while (0)
            float mxf = -1048576.0f;
#pragma unroll
            for (int blk = 0; blk < 4; ++blk) if (jm >= 16 * blk) {
#pragma unroll
                for (int pp = 0; pp < 8; ++pp) mxf = fmaxf(mxf, fmaxf(sf[8 * blk + pp][0], sf[8 * blk + pp][1])); }
#pragma unroll
            for (int o = 1; o < 64; o <<= 1) mxf = fmaxf(mxf, __shfl_xor(mxf, o));
            const unsigned mx = (unsigned)__builtin_amdgcn_readfirstlane((int)ukey(mxf));
            unsigned lo = 1u, hi = mx + 1u; bool exact = false;
            if (mx > (0x80000000u | (100u << 18))) {
                LAS unsigned* hw = (LAS unsigned*)(F.lds + HIST_OFF + w * HIST_WB);
                const int l15 = lane & 15;
#define HIST_PASS(SH, LOBIN, HICLAMP, ROUT, COUT) do { \
                    hw[lane] = 0u; hw[lane + 64] = 0u; if (lane < 24) hw[lane + 128] = 0u; \
                    const int lc_ = (LOBIN) - 1 - l15, hc_ = (HICLAMP); const int cb_ = HIST_OFF + w * HIST_WB + 4 * (16 - (LOBIN)); \
                    _Pragma("unroll") for (int blk = 0; blk < 4; ++blk) if (jm >= 16 * blk) { \
                        _Pragma("unroll") for (int pp = 0; pp < 8; ++pp) _Pragma("unroll") for (int e = 0; e < 2; ++e) { int b_ = __float_as_int(sf[8 * blk + pp][e]) >> (SH); \
                            asm("v_med3_i32 %0, %1, %2, %3" : "=v"(b_) : "v"(b_), "v"(lc_), "v"(hc_)); \
                            __hip_atomic_fetch_add((LAS unsigned*)(F.lds + ((b_ << 2) + cb_)), 1u, __ATOMIC_RELAXED, __HIP_MEMORY_SCOPE_WORKGROUP); } } \
                    asm volatile("s_waitcnt lgkmcnt(0)" ::: "memory"); \
                    const u32x2 hp_ = *(const LAS u32x2*)(hw + 16 + 2 * lane), ha_ = *(const LAS u32x2*)(hw + 144); \
                    int v_ = (int)(hp_.x + hp_.y); \
                    v_ += __builtin_amdgcn_update_dpp(0, v_, 0x101, 0xF, 0xF, true); v_ += __builtin_amdgcn_update_dpp(0, v_, 0x102, 0xF, 0xF, true);        \
                    v_ += __builtin_amdgcn_update_dpp(0, v_, 0x104, 0xF, 0xF, true); v_ += __builtin_amdgcn_update_dpp(0, v_, 0x108, 0xF, 0xF, true);        \
                    const int r1_ = __builtin_amdgcn_readlane(v_, 16), r2_ = __builtin_amdgcn_readlane(v_, 32), r3_ = __builtin_amdgcn_readlane(v_, 48); \
                    v_ += (lane < 16 ? r1_ : 0) + (lane < 32 ? r2_ : 0) + (lane < 48 ? r3_ : 0); \
                    const int se_ = v_ + (int)(ha_.x + ha_.y), so_ = se_ - (int)hp_.x;                  \
                    const unsigned long long bm_ = __ballot(se_ >= 256); \
                    if (bm_ == 0ull) { ROUT = -1; COUT = 0; } \
                    else { const int il_ = 63 - __builtin_clzll(bm_); const int e_ = __builtin_amdgcn_readlane(se_, il_), o_ = __builtin_amdgcn_readlane(so_, il_); \
                        if (o_ >= 256) { ROUT = 2 * il_ + 1; COUT = o_; } else { ROUT = 2 * il_; COUT = e_; } } } while (0)
                const int bhi = (int)(mx & 0x7FFFFFFFu) >> 18, blo = bhi - 96;
                int r1, c1; HIST_PASS(18, blo, bhi, r1, c1);
                if (r1 < 0) hi = 0x80000000u | ((unsigned)blo << 18);
                else if (c1 == 256) { lo = 0x80000000u | ((unsigned)(blo + r1) << 18); exact = true; }
                else { lo = 0x80000000u | ((unsigned)(blo + r1) << 18); hi = lo + (1u << 18); }
#undef HIST_PASS
            }
            while (!exact && hi - lo > 1u) {
                const unsigned mid = lo + ((hi - lo) >> 1);
                unsigned cnt; COUNT_GE(mid, cnt);
                if (cnt == 256u) { lo = mid; exact = true; break; }
                if (cnt > 256u) lo = mid; else hi = mid;
            }
#undef COUNT_GE
            TS1(2);
            const float Tf = fkey(lo);
            int lq = lane; asm volatile("" : "+v"(lq));
            if (exact) {
                unsigned mw_lo = 0u, mw_hi = 0u;
#pragma unroll
                for (int j = 0; j < 64; ++j) { const unsigned long long m = __ballot(sf[j >> 1][j & 1] >= Tf);
                    asm("s_nop 3\n\tv_writelane_b32 %0, %2, %4\n\tv_writelane_b32 %1, %3, %4" : "+v"(mw_lo), "+v"(mw_hi) : "s"((unsigned)m), "s"((unsigned)(m >> 32)), "n"(j)); }
                myword = ((unsigned long long)mw_hi << 32) | mw_lo;
            } else {
                unsigned cgt = 0;
#pragma unroll
                for (int j = 0; j < 64; ++j) cgt += (unsigned)__builtin_popcountll(__ballot(sf[j >> 1][j & 1] > Tf));
                unsigned need = 256u - cgt;
#pragma unroll
                for (int j = 0; j < 64; ++j) { const unsigned long long gt = __ballot(sf[j >> 1][j & 1] > Tf); unsigned long long eq = __ballot(sf[j >> 1][j & 1] == Tf), take = 0ull;
                    while (need != 0u && eq != 0ull) { const unsigned long long low = eq & (0ull - eq); take |= low; eq ^= low; --need; }
                    if (lq == j) myword = gt | take; }
            }
            TS1(4);
        }
        F.MASK()[((size_t)(b * 64 + lane)) * SEQ + t] = myword;
    }
#ifdef PROBE_SUB
    { const unsigned long long d_ = tacc_[PROBE_SUB]; const unsigned long long t1_ = __builtin_amdgcn_s_memrealtime(); while (__builtin_amdgcn_s_memrealtime() - t1_ < d_) __builtin_amdgcn_s_sleep(8); }
#endif
}

__device__ __forceinline__ void sgu_fast(Frame& F) {
    constexpr int PITCH = 136, VTB = 128 * PITCH * 2;
    LAS float* part = (LAS float*)(F.lds + 2 * VTB);
    LAS float* gl = (LAS float*)(F.lds + 2 * VTB + 4096);
    const int w = F.wave, tb = w >> 1, dh = w & 1;
    if (F.tid < 128) *(LAS f32x4*)(gl + F.tid * 4) = *(const f32x4*)(F.ln_g() + F.tid * 4);
    else if (F.tid < 256) *(LAS f32x4*)(gl + 512 + (F.tid - 128) * 4) = *(const f32x4*)(F.ln_b() + (F.tid - 128) * 4);
    for (int bc = blockIdx.x; bc < M / 128; bc += gridDim.x) {
        const int row0 = bc * 128;
        int tq = F.tid; asm volatile("" : "+v"(tq));
        const int lane = tq & 63, fr = lane & 15, fq = lane >> 4;
        const int s = tq & 127, j4 = tq >> 7;
        u32x4 raw[4][4];
#pragma unroll
        for (int g = 0; g < 4; ++g)
#pragma unroll
            for (int i = 0; i < 4; ++i) raw[g][i] = *(const u32x4*)(F.VG() + (size_t)(row0 + s) * 512 + g * 128 + (j4 + 4 * i) * 8);
        u32x2 uu[2][2][4]; float bsv[4][2];
#define SGU_LOAD_U(gg) do { _Pragma("unroll") for (int mt = 0; mt < 2; ++mt) _Pragma("unroll") for (int nd = 0; nd < 4; ++nd) \
            uu[(gg) & 1][mt][nd] = *(const u32x2*)(F.U() + (size_t)(row0 + tb * 32 + mt * 16 + fr) * UP + (gg) * 128 + dh * 64 + nd * 16 + 4 * fq); } while (0)
        SGU_LOAD_U(0);
#pragma unroll
        for (int g = 0; g < 4; ++g)
#pragma unroll
            for (int mt = 0; mt < 2; ++mt) bsv[g][mt] = F.b_s()[g * 128 + tb * 32 + mt * 16 + fr];
        float sm = 0.f, sq = 0.f;
#pragma unroll
        for (int g = 0; g < 4; ++g)
#pragma unroll
            for (int i = 0; i < 4; ++i) { const u32x4 ww = raw[g][i];
                const float v0 = bf2f(ww.x & 0xffff), v1 = bf2f(ww.x >> 16), v2 = bf2f(ww.y & 0xffff), v3 = bf2f(ww.y >> 16), v4 = bf2f(ww.z & 0xffff), v5 = bf2f(ww.z >> 16), v6 = bf2f(ww.w & 0xffff), v7 = bf2f(ww.w >> 16);
                sm += ((v0 + v1) + (v2 + v3)) + ((v4 + v5) + (v6 + v7));
                sq = fmaf(v0, v0, sq); sq = fmaf(v1, v1, sq); sq = fmaf(v2, v2, sq); sq = fmaf(v3, v3, sq); sq = fmaf(v4, v4, sq); sq = fmaf(v5, v5, sq); sq = fmaf(v6, v6, sq); sq = fmaf(v7, v7, sq); }
        part[(j4 * 128 + s) * 2] = sm; part[(j4 * 128 + s) * 2 + 1] = sq;
        __syncthreads();
        float S = 0.f, Q = 0.f;
#pragma unroll
        for (int j = 0; j < 4; ++j) { S += part[(j * 128 + s) * 2]; Q += part[(j * 128 + s) * 2 + 1]; }
        const float mean = S * (1.f / 512.f), rstd = 1.0f / sqrtf(fmaxf(Q * (1.f / 512.f) - mean * mean, 0.f) + EPS);
#pragma unroll
        for (int g = 0; g < 4; ++g) {
            LAS bf16_t* vT = (LAS bf16_t*)(F.lds + (g & 1) * VTB);
            bf16x8 wfr[4][2];
#pragma unroll
            for (int ks = 0; ks < 4; ++ks) if (ks <= tb) {
#pragma unroll
                for (int mt = 0; mt < 2; ++mt) wfr[ks][mt] = *(const bf16x8*)(F.WSB() + g * 16384 + (tb * 32 + mt * 16 + fr) * 128 + ks * 32 + 8 * fq); }
            if (g < 3) SGU_LOAD_U(g + 1);
#pragma unroll
            for (int i = 0; i < 4; ++i) { const int d8 = (j4 + 4 * i) * 8; const u32x4 ww = raw[g][i];
                const f32x4 g0 = *(const LAS f32x4*)(gl + g * 128 + d8), g1 = *(const LAS f32x4*)(gl + g * 128 + d8 + 4), b0 = *(const LAS f32x4*)(gl + 512 + g * 128 + d8), b1 = *(const LAS f32x4*)(gl + 512 + g * 128 + d8 + 4);
                float v[8]; v[0] = bf2f(ww.x & 0xffff); v[1] = bf2f(ww.x >> 16); v[2] = bf2f(ww.y & 0xffff); v[3] = bf2f(ww.y >> 16);
                v[4] = bf2f(ww.z & 0xffff); v[5] = bf2f(ww.z >> 16); v[6] = bf2f(ww.w & 0xffff); v[7] = bf2f(ww.w >> 16);
#pragma unroll
                for (int e = 0; e < 8; ++e) { const float gg = e < 4 ? g0[e & 3] : g1[e & 3], bb = e < 4 ? b0[e & 3] : b1[e & 3];
                    vT[(d8 + e) * PITCH + s] = (bf16_t)f2bf((v[e] - mean) * rstd * gg + bb); } }
            __syncthreads();
            f32x4 acc[4][2];
#pragma unroll
            for (int nd = 0; nd < 4; ++nd)
#pragma unroll
                for (int mt = 0; mt < 2; ++mt) acc[nd][mt] = (f32x4){0.f, 0.f, 0.f, 0.f};
#pragma unroll
            for (int ks = 0; ks < 4; ++ks) if (ks <= tb) {
                bf16x8 vf[4];
#pragma unroll
                for (int nd = 0; nd < 4; ++nd) vf[nd] = *(const LAS bf16x8*)(vT + (dh * 64 + nd * 16 + fr) * PITCH + ks * 32 + 8 * fq);
#pragma unroll
                for (int nd = 0; nd < 4; ++nd)
#pragma unroll
                    for (int mt = 0; mt < 2; ++mt) acc[nd][mt] = __builtin_amdgcn_mfma_f32_16x16x32_bf16(vf[nd], wfr[ks][mt], acc[nd][mt], 0, 0, 0);
            }
#pragma unroll
            for (int mt = 0; mt < 2; ++mt) { const int tl = tb * 32 + mt * 16 + fr; const float bs = bsv[g][mt];
#pragma unroll
                for (int nd = 0; nd < 4; ++nd) { bf16_t* up = F.U() + (size_t)(row0 + tl) * UP + g * 128 + dh * 64 + nd * 16 + 4 * fq;
                    const u32x2 uv = uu[g & 1][mt][nd]; u32x2 o;
                    o.x = pk2(bf2f(uv.x & 0xffff) * (acc[nd][mt][0] + bs), bf2f(uv.x >> 16) * (acc[nd][mt][1] + bs));
                    o.y = pk2(bf2f(uv.y & 0xffff) * (acc[nd][mt][2] + bs), bf2f(uv.y >> 16) * (acc[nd][mt][3] + bs));
                    *(u32x2*)up = o; } }
        }
        __syncthreads();
    }
#undef SGU_LOAD_U
}

namespace pg8 {
#define PG8_LAS __attribute__((address_space(3)))
typedef unsigned short bf16_t;
typedef short bf16x8 __attribute__((ext_vector_type(8)));
typedef float f32x4 __attribute__((ext_vector_type(4)));
typedef unsigned u32x4 __attribute__((ext_vector_type(4)));
constexpr int BM = 256, BK = 64, HALF = 128, HTB = HALF * BK * 2  , STAGE_BYTES = 8 * HTB, NXCD = 8, WGM = 8;

__host__ __device__ __forceinline__ int lds_byte(int r, int c) { const int st = (r >> 4) * 2 + (c >> 5), rr = r & 15, cc = c & 31, ob = rr * 64 + cc * 2; return st * 1024 + (ob ^ (((ob >> 9) & 1) << 5)); }
__host__ __device__ __forceinline__ void stage_rc(int b, int& R, int& C) { const int st = b / 1024, sb = b % 1024, swz = sb ^ (((sb >> 9) & 1) << 5); R = (st >> 1) * 16 + swz / 64; C = (st & 1) * 32 + (swz % 64) / 2; }
__host__ __device__ __forceinline__ int perm32(int rho) { const int n = rho >> 4, i = rho & 15; return 8 * (i >> 2) + 4 * n + (i & 3); }

struct Unit { int pm, pn; };
struct Gemm { const bf16_t* A; const bf16_t* Bt; int M, N, K; };

struct StaticOrder {
    int nM, nN, nwg, G, c;
    __host__ __device__ void init(int M, int N, int G_, int c_) { nM = M / BM; nN = N / BM; nwg = nM * nN; G = G_; c = c_; }
    __host__ __device__ bool next(int i, Unit& u) const {
        const long L = (long)i * G + c; if (L >= nwg) return false;
        int wgid = (int)L; { const int q = nwg / NXCD, r = nwg % NXCD, xcd = wgid % NXCD, off = wgid / NXCD; wgid = (xcd < r ? xcd * (q + 1) : r * (q + 1) + (xcd - r) * q) + off; }
        const int nig = WGM * nN, gid = wgid / nig, fm = gid * WGM, gsz = (nM - fm) < WGM ? (nM - fm) : WGM;
        u.pm = fm + ((wgid % nig) % gsz); u.pn = (wgid % nig) / gsz; return true;
    }
    __device__ __forceinline__ void a_ready(const Unit&) const {}
    __device__ __forceinline__ void done(const Unit&) const {}
};
template <class Epi, class Sched, bool ALIGN_EPI = false, bool SP2 = false>
__device__ __forceinline__ void gemm_phase(PG8_LAS unsigned char* lds, const Gemm g, const Sched& S, const Epi& E) {
    const int tid = threadIdx.x, wid = __builtin_amdgcn_readfirstlane(tid >> 6), lane = tid & 63, wr = wid >> 2, wc = wid & 3, fr = lane & 15, fq = lane >> 4;
    const int K = g.K, nt = K / BK;
    unsigned voffA[2], voffB[2];
#pragma unroll
    for (int i = 0; i < 2; ++i) { int R, C; stage_rc(tid * 16 + i * 8192, R, C); const int Rb = Epi::PERM ? ((R & ~31) + perm32(R & 31)) : R;
        voffA[i] = (unsigned)(R * K + C) * 2u; voffB[i] = (unsigned)(Rb * K + C) * 2u; }
    const size_t kstep = (size_t)(BK * 2);
    const size_t hstep = (size_t)HALF * K * 2;
    const size_t tstep = 2 * hstep;
    const unsigned ldsw = (unsigned)wid * 1024u;
    const int aoff = lds_byte(wr * 64 + fr, fq * 8), boff = lds_byte(wc * 32 + fr, fq * 8);
#define PG8_SA(b, h) (((b) * 2 + (h)) * HTB)
#define PG8_SB(b, h) ((4 + (b) * 2 + (h)) * HTB)
#define PG8_STAGE(bufoff, gbase, voff) do { _Pragma("unroll") for (int _i = 0; _i < 2; ++_i) \
        __builtin_amdgcn_global_load_lds((const unsigned*)((const char*)(gbase) + (voff)[_i]), (PG8_LAS unsigned*)(lds + (bufoff) + ldsw + _i * 8192), 16, 0, 0); } while (0)
#define PG8_LDA(dst, b, h) do { _Pragma("unroll") for (int m = 0; m < 4; ++m) _Pragma("unroll") for (int k = 0; k < 2; ++k) dst[m][k] = *(const PG8_LAS bf16x8*)(lds + PG8_SA(b, h) + aoff + m * 2048 + k * 1024); } while (0)
#define PG8_LDB(dst, b, h) do { _Pragma("unroll") for (int n = 0; n < 2; ++n) _Pragma("unroll") for (int k = 0; k < 2; ++k) dst[n][k] = *(const PG8_LAS bf16x8*)(lds + PG8_SB(b, h) + boff + n * 2048 + k * 1024); } while (0)
#define PG8_MMA(ai, bj, At, Bt) do { __builtin_amdgcn_s_setprio(1); _Pragma("unroll") for (int m = 0; m < 4; ++m) _Pragma("unroll") for (int n = 0; n < 2; ++n) _Pragma("unroll") for (int k = 0; k < 2; ++k) \
        acc[ai][bj][m][n] = __builtin_amdgcn_mfma_f32_16x16x32_bf16(Bt[n][k], At[m][k], acc[ai][bj][m][n], 0, 0, 0); __builtin_amdgcn_s_setprio(0); } while (0)
#define PG8_WAIT_V(n) asm volatile("s_waitcnt vmcnt(" #n ")" ::: "memory")
#define PG8_WAIT_L(n) asm volatile("s_waitcnt lgkmcnt(" #n ")" ::: "memory")
#define PG8_BAR __builtin_amdgcn_s_barrier()
#define PG8_SCHED __builtin_amdgcn_sched_barrier(0)
    Unit cur, nxt; int ui = 0;
    if (!S.next(0, cur)) return;
    f32x4 acc[2][2][4][2];
#pragma unroll
    for (int a = 0; a < 2; ++a)
#pragma unroll
        for (int b = 0; b < 2; ++b)
#pragma unroll
            for (int m = 0; m < 4; ++m)
#pragma unroll
                for (int n = 0; n < 2; ++n) acc[a][b][m][n] = (f32x4){0.f, 0.f, 0.f, 0.f};
    bf16x8 At[4][2], B0[2][2], B1[2][2];
    const char* cA = (const char*)g.A + (size_t)cur.pm * tstep; const char* cB = (const char*)g.Bt + (size_t)cur.pn * tstep;
    S.a_ready(cur);
    if constexpr (SP2) {
        PG8_STAGE(PG8_SB(0, 0), cB, voffB); PG8_STAGE(PG8_SB(0, 1), cB + hstep, voffB); PG8_STAGE(PG8_SA(0, 0), cA, voffA); PG8_STAGE(PG8_SA(0, 1), cA + hstep, voffA);
        if (wr == 1) PG8_BAR;
        PG8_WAIT_V(2); PG8_BAR;
        PG8_STAGE(PG8_SB(1, 0), cB + kstep, voffB); PG8_STAGE(PG8_SA(1, 0), cA + kstep, voffA); PG8_STAGE(PG8_SB(1, 1), cB + hstep + kstep, voffB);
        PG8_WAIT_V(6); PG8_BAR;
    } else {
        PG8_STAGE(PG8_SB(0, 0), cB, voffB); PG8_STAGE(PG8_SA(0, 0), cA, voffA); PG8_STAGE(PG8_SB(0, 1), cB + hstep, voffB); PG8_STAGE(PG8_SA(0, 1), cA + hstep, voffA);
        if (wr == 1) PG8_BAR;
        PG8_WAIT_V(4); PG8_BAR;
        PG8_STAGE(PG8_SB(1, 0), cB + kstep, voffB); PG8_STAGE(PG8_SA(1, 0), cA + kstep, voffA); PG8_STAGE(PG8_SB(1, 1), cB + hstep + kstep, voffB);
        PG8_WAIT_V(6); PG8_BAR;
    }
    for (;;) {
        const bool has_next = S.next(ui + 1, nxt);
        const char* nA = has_next ? (const char*)g.A + (size_t)nxt.pm * tstep : cA; const char* nB = has_next ? (const char*)g.Bt + (size_t)nxt.pn * tstep : cB;
        for (int t = 0; t < nt; t += 2) {
            if constexpr (Epi::HAS_MID) { if (t == nt / 2) E.mid(acc, cur, wr, wc, fr, fq); }
            const bool last = (t == nt - 2);
            const char* a1 = cA + (size_t)(t + 1) * kstep;
            const char* a2 = last ? nA : cA + (size_t)(t + 2) * kstep; const char* b2 = last ? nB : cB + (size_t)(t + 2) * kstep;
            const char* a3 = a2 + kstep; const char* b3 = b2 + kstep;
            if (last && has_next) S.a_ready(nxt);
            if constexpr (SP2) {
            PG8_LDB(B0, 0, 0); PG8_LDB(B1, 0, 1); PG8_SCHED; PG8_LDA(At, 0, 0); PG8_STAGE(PG8_SA(1, 1), a1 + hstep, voffA);
            PG8_WAIT_V(8); PG8_WAIT_L(0); PG8_BAR; PG8_MMA(0, 0, At, B0); PG8_MMA(0, 1, At, B1); PG8_BAR; PG8_SCHED;
            PG8_LDA(At, 0, 1); PG8_STAGE(PG8_SB(0, 0), b2, voffB); PG8_STAGE(PG8_SB(0, 1), b2 + hstep, voffB); PG8_STAGE(PG8_SA(0, 0), a2, voffA);
            PG8_WAIT_V(8); PG8_WAIT_L(0); PG8_BAR; PG8_MMA(1, 0, At, B0); PG8_MMA(1, 1, At, B1); PG8_BAR; PG8_SCHED;
            PG8_LDB(B0, 1, 0); PG8_LDB(B1, 1, 1); PG8_SCHED; PG8_LDA(At, 1, 0); PG8_STAGE(PG8_SA(0, 1), a2 + hstep, voffA);
            PG8_WAIT_V(8); PG8_WAIT_L(0); PG8_BAR; PG8_MMA(0, 0, At, B0); PG8_MMA(0, 1, At, B1); PG8_BAR; PG8_SCHED;
            PG8_LDA(At, 1, 1); PG8_STAGE(PG8_SB(1, 0), b3, voffB); PG8_STAGE(PG8_SB(1, 1), b3 + hstep, voffB); PG8_STAGE(PG8_SA(1, 0), a3, voffA);
            PG8_WAIT_V(8); PG8_WAIT_L(0); PG8_BAR; PG8_MMA(1, 0, At, B0); PG8_MMA(1, 1, At, B1); PG8_BAR; PG8_SCHED;
            } else {
            PG8_LDB(B0, 0, 0); PG8_SCHED; PG8_LDA(At, 0, 0); PG8_STAGE(PG8_SA(1, 1), a1 + hstep, voffA);
            PG8_WAIT_L(8); PG8_BAR; PG8_WAIT_L(0); PG8_MMA(0, 0, At, B0); PG8_BAR; PG8_SCHED;
            PG8_LDB(B1, 0, 1); PG8_STAGE(PG8_SB(0, 0), b2, voffB);
            PG8_BAR; PG8_WAIT_L(0); PG8_MMA(0, 1, At, B1); PG8_BAR;
            PG8_LDA(At, 0, 1); PG8_STAGE(PG8_SA(0, 0), a2, voffA);
            PG8_BAR; PG8_WAIT_L(0); PG8_MMA(1, 0, At, B0); PG8_BAR; PG8_SCHED;
            PG8_STAGE(PG8_SB(0, 1), b2 + hstep, voffB);
            PG8_WAIT_V(6); PG8_BAR; PG8_MMA(1, 1, At, B1); PG8_BAR;
            PG8_LDB(B0, 1, 0); PG8_SCHED; PG8_LDA(At, 1, 0); PG8_STAGE(PG8_SA(0, 1), a2 + hstep, voffA);
            PG8_WAIT_L(8); PG8_BAR; PG8_WAIT_L(0); PG8_MMA(0, 0, At, B0); PG8_BAR; PG8_SCHED;
            PG8_LDB(B1, 1, 1); PG8_STAGE(PG8_SB(1, 0), b3, voffB);
            PG8_BAR; PG8_WAIT_L(0); PG8_MMA(0, 1, At, B1); PG8_BAR;
            PG8_LDA(At, 1, 1); PG8_STAGE(PG8_SA(1, 0), a3, voffA);
            PG8_BAR; PG8_WAIT_L(0); PG8_MMA(1, 0, At, B0); PG8_BAR; PG8_SCHED;
            PG8_STAGE(PG8_SB(1, 1), b3 + hstep, voffB);
            PG8_WAIT_V(6); PG8_BAR; PG8_MMA(1, 1, At, B1); PG8_BAR;
            }
        }
        if constexpr (ALIGN_EPI) { if (wr == 0) PG8_BAR; }
        if constexpr (!Epi::AFTER_DRAIN) { E(acc, cur, wr, wc, fr, fq); S.done(cur); }
        if (!has_next) break;
#pragma unroll
        for (int a = 0; a < 2; ++a)
#pragma unroll
            for (int b = 0; b < 2; ++b)
#pragma unroll
                for (int m = 0; m < 4; ++m)
#pragma unroll
                    for (int n = 0; n < 2; ++n) acc[a][b][m][n] = (f32x4){0.f, 0.f, 0.f, 0.f};
        cur = nxt; cA = nA; cB = nB; ++ui;
        if constexpr (ALIGN_EPI) { if (wr == 1) PG8_BAR; }
    }
    PG8_WAIT_V(0);
    if constexpr (!ALIGN_EPI) { if (wr == 0) PG8_BAR; }
    PG8_BAR;
    if constexpr (Epi::AFTER_DRAIN) { E.fused(acc, cur, wr, wc, fr, fq, lds, wid, lane); S.done(cur); }
#undef PG8_SA
#undef PG8_SB
#undef PG8_STAGE
#undef PG8_LDA
#undef PG8_LDB
#undef PG8_MMA
#undef PG8_WAIT_V
#undef PG8_WAIT_L
#undef PG8_BAR
#undef PG8_SCHED
}
}

#define PG8_SP2 true
#define PG8_ALIGN true
namespace pg8 {
__device__ __forceinline__ unsigned cvt_pk_bf16(float lo, float hi) { unsigned r; asm volatile("v_cvt_pk_bf16_f32 %0, %1, %2" : "=v"(r) : "v"(lo), "v"(hi)); return r; }
__device__ __forceinline__ unsigned cvt_pk_f16(float lo, float hi) { const _Float16 a = (_Float16)lo, b = (_Float16)hi; return (unsigned)__builtin_bit_cast(unsigned short, a) | ((unsigned)__builtin_bit_cast(unsigned short, b) << 16); }
__device__ __forceinline__ u32x4 pack8_bf16(const f32x4& a, const f32x4& b) { u32x4 w; w.x = cvt_pk_bf16(a[0], a[1]); w.y = cvt_pk_bf16(a[2], a[3]); w.z = cvt_pk_bf16(b[0], b[1]); w.w = cvt_pk_bf16(b[2], b[3]); return w; }
__device__ __forceinline__ u32x4 pack8_f16(const f32x4& a, const f32x4& b) { u32x4 w; w.x = cvt_pk_f16(a[0], a[1]); w.y = cvt_pk_f16(a[2], a[3]); w.z = cvt_pk_f16(b[0], b[1]); w.w = cvt_pk_f16(b[2], b[3]); return w; }
__device__ __forceinline__ f32x4 bf_lo4(const u32x4& w) { return (f32x4){__uint_as_float(w.x << 16), __uint_as_float(w.x & 0xffff0000u), __uint_as_float(w.y << 16), __uint_as_float(w.y & 0xffff0000u)}; }
__device__ __forceinline__ f32x4 bf_hi4(const u32x4& w) { return (f32x4){__uint_as_float(w.z << 16), __uint_as_float(w.z & 0xffff0000u), __uint_as_float(w.w << 16), __uint_as_float(w.w & 0xffff0000u)}; }
__device__ __forceinline__ f32x4 gelu4(const f32x4& x) { f32x4 r;
#pragma unroll
    for (int i = 0; i < 4; ++i) { const float z = 1.5957691216057308f * (x[i] + 0.044715f * x[i] * x[i] * x[i]); r[i] = x[i] * __builtin_amdgcn_rcpf(1.0f + __builtin_amdgcn_exp2f(-1.4426950408889634f * z)); }
    return r; }
__device__ __forceinline__ f32x4 sigm4(const f32x4& x) { f32x4 r;
#pragma unroll
    for (int i = 0; i < 4; ++i) r[i] = __builtin_amdgcn_rcpf(1.0f + __builtin_amdgcn_exp2f(-1.4426950408889634f * x[i]));
    return r; }

struct EpiProjF {
    static constexpr bool PERM = true, AFTER_DRAIN = false, HAS_MID = false;
    unsigned char* ws;
    __device__ __forceinline__ void operator()(const f32x4 (&acc)[2][2][4][2], const Unit& u, int wr, int wc, int fr, int fq) const {
        const int pn = u.pn, row0 = u.pm * BM + wr * 64 + fr, cb = 32 * wc + 8 * fq;
        const float* RS1 = (const float*)(ws + WS_RS1); const float* COS = (const float*)(ws + WS_COS); const float* SIN = (const float*)(ws + WS_SIN);
        unsigned short* KI = (unsigned short*)(ws + WS_KI); float* WI = (float*)(ws + WS_WI);
        if (pn < 4 || pn == 8 || pn == 9 || pn >= 13) {
            size_t boff; int ld, colt;
            if (pn < 2) { boff = WS_U; ld = UP; colt = pn * 256; } else if (pn < 4) { boff = WS_VG; ld = 512; colt = (pn - 2) * 256; }
            else if (pn < 10) { boff = WS_V; ld = 512; colt = (pn - 8) * 256; } else { boff = WS_G; ld = 2048; colt = (pn - 13) * 256; }
            bf16_t* base = (bf16_t*)(ws + boff);
            const int act = pn < 4 ? 1 : (pn >= 13 ? 2 : 0);
#pragma unroll
            for (int ai = 0; ai < 2; ++ai)
#pragma unroll
                for (int m = 0; m < 4; ++m) { const int r = row0 + ai * HALF + m * 16; const float rs = RS1[r]; bf16_t* rowp = base + (size_t)r * ld + colt + cb;
#pragma unroll
                    for (int bj = 0; bj < 2; ++bj) { f32x4 v0 = acc[ai][bj][m][0] * rs, v1 = acc[ai][bj][m][1] * rs;
                        if (act == 2) {
                            v0 = sigm4(v0) * 255.0f + 0.5f; v1 = sigm4(v1) * 255.0f + 0.5f; unsigned b[8];
#pragma unroll
                            for (int i = 0; i < 4; ++i) { b[i] = (unsigned)fminf(fmaxf(v0[i], 1.0f), 255.0f); b[4 + i] = (unsigned)fminf(fmaxf(v1[i], 1.0f), 255.0f); }
                            u32x2 w8; w8.x = b[0] | (b[1] << 8) | (b[2] << 16) | (b[3] << 24); w8.y = b[4] | (b[5] << 8) | (b[6] << 16) | (b[7] << 24);
                            *(u32x2*)((unsigned char*)base + (size_t)r * 2048 + colt + cb + bj * HALF) = w8;
                        } else {
                            if (act == 1) { v0 = gelu4(v0); v1 = gelu4(v1); }
                            *(u32x4*)(rowp + bj * HALF) = pack8_bf16(v0, v1); } } }
        } else if (pn == 12) {
            if (wc == 0) {
                const int pos0 = row0 & (SEQ - 1);
                f32x4 c0 = *(const f32x4*)(COS + pos0 * 32 + 8 * fq), c1 = *(const f32x4*)(COS + pos0 * 32 + 8 * fq + 4), s0 = *(const f32x4*)(SIN + pos0 * 32 + 8 * fq), s1 = *(const f32x4*)(SIN + pos0 * 32 + 8 * fq + 4);
                const f32x4 dc0 = *(const f32x4*)(COS + 16 * 32 + 8 * fq), dc1 = *(const f32x4*)(COS + 16 * 32 + 8 * fq + 4), ds0 = *(const f32x4*)(SIN + 16 * 32 + 8 * fq), ds1 = *(const f32x4*)(SIN + 16 * 32 + 8 * fq + 4);
#pragma unroll
                for (int ai = 0; ai < 2; ++ai) {
#pragma unroll
                    for (int m = 0; m < 4; ++m) { const int r = row0 + ai * HALF + m * 16; const float rs = RS1[r];
                        const f32x4 a0 = acc[ai][0][m][0] * rs, a1 = acc[ai][0][m][1] * rs, b0 = acc[ai][1][m][0] * rs, b1 = acc[ai][1][m][1] * rs;
                        unsigned short* rowp = KI + (size_t)(r >> 12) * SEQ * 64 + ki_off(r & (SEQ - 1), 8 * fq);
                        *(u32x4*)rowp = pack8_f16(a0 * c0 - b0 * s0, a1 * c1 - b1 * s1);
                        *(u32x4*)(rowp + 1024) = pack8_f16(b0 * c0 + a0 * s0, b1 * c1 + a1 * s1);
                        { const f32x4 t0 = c0 * dc0 - s0 * ds0, t1 = c1 * dc1 - s1 * ds1; s0 = s0 * dc0 + c0 * ds0; s1 = s1 * dc1 + c1 * ds1; c0 = t0; c1 = t1; } }
                    if (ai == 0) {
#pragma unroll
                        for (int k = 0; k < 4; ++k) { const f32x4 t0 = c0 * dc0 - s0 * ds0, t1 = c1 * dc1 - s1 * ds1; s0 = s0 * dc0 + c0 * ds0; s1 = s1 * dc1 + c1 * ds1; c0 = t0; c1 = t1; } }
                }
            } else if (wc == 1) {
                if (fq == 0) {
#pragma unroll
                    for (int ai = 0; ai < 2; ++ai)
#pragma unroll
                        for (int m = 0; m < 4; ++m) { const int r = row0 + ai * HALF + m * 16; const float rs = RS1[r] * IDX_SCALE;
                            *(f32x4*)(WI + (size_t)r * 8) = acc[ai][0][m][0] * rs; *(f32x4*)(WI + (size_t)r * 8 + 4) = acc[ai][0][m][1] * rs; }
                }
            }
        } else {
            const int kind = pn < 6 ? 0 : (pn < 8 ? 1 : 2);
            const int colt = (kind == 0 ? (pn - 4) : kind == 1 ? (pn - 6) : (pn - 10)) * 256 + 64 * wc + 8 * fq;
            unsigned short* base = (unsigned short*)(ws + (kind == 0 ? WS_Q : kind == 1 ? WS_K : WS_QI));
            const float sc = kind == 0 ? C2 : 1.0f;
            const int pos0 = row0 & (SEQ - 1);
            f32x4 c0 = *(const f32x4*)(COS + pos0 * 32 + 8 * fq), c1 = *(const f32x4*)(COS + pos0 * 32 + 8 * fq + 4), s0 = *(const f32x4*)(SIN + pos0 * 32 + 8 * fq), s1 = *(const f32x4*)(SIN + pos0 * 32 + 8 * fq + 4);
            const f32x4 dc0 = *(const f32x4*)(COS + 16 * 32 + 8 * fq), dc1 = *(const f32x4*)(COS + 16 * 32 + 8 * fq + 4), ds0 = *(const f32x4*)(SIN + 16 * 32 + 8 * fq), ds1 = *(const f32x4*)(SIN + 16 * 32 + 8 * fq + 4);
#pragma unroll
            for (int ai = 0; ai < 2; ++ai) {
#pragma unroll
                for (int m = 0; m < 4; ++m) { const int r = row0 + ai * HALF + m * 16; const float rs = RS1[r] * sc;
                    const f32x4 a0 = acc[ai][0][m][0] * rs, a1 = acc[ai][0][m][1] * rs, b0 = acc[ai][1][m][0] * rs, b1 = acc[ai][1][m][1] * rs;
                    unsigned short* rowp = base + (size_t)r * 512 + colt;
                    if (kind == 2) { *(u32x4*)rowp = pack8_f16(a0 * c0 - b0 * s0, a1 * c1 - b1 * s1); *(u32x4*)(rowp + 32) = pack8_f16(b0 * c0 + a0 * s0, b1 * c1 + a1 * s1); }
                    else { *(u32x4*)rowp = pack8_bf16(a0 * c0 - b0 * s0, a1 * c1 - b1 * s1); *(u32x4*)(rowp + 32) = pack8_bf16(b0 * c0 + a0 * s0, b1 * c1 + a1 * s1); }
                    { const f32x4 t0 = c0 * dc0 - s0 * ds0, t1 = c1 * dc1 - s1 * ds1; s0 = s0 * dc0 + c0 * ds0; s1 = s1 * dc1 + c1 * ds1; c0 = t0; c1 = t1; } }
                if (ai == 0) {
#pragma unroll
                    for (int k = 0; k < 4; ++k) { const f32x4 t0 = c0 * dc0 - s0 * ds0, t1 = c1 * dc1 - s1 * ds1; s0 = s0 * dc0 + c0 * ds0; s1 = s1 * dc1 + c1 * ds1; c0 = t0; c1 = t1; } }
            }
        }
    }
};
template <int BR> struct EpiMergeF {
    static constexpr bool PERM = true, AFTER_DRAIN = false, HAS_MID = false;
    const bf16_t* G; bf16_t* MG;
    __device__ __forceinline__ void operator()(const f32x4 (&acc)[2][2][4][2], const Unit& u, int wr, int wc, int fr, int fq) const {
        const int row0 = u.pm * BM + wr * 64 + fr, col0 = u.pn * BM + 32 * wc + 8 * fq;
#pragma unroll
        for (int ai = 0; ai < 2; ++ai)
#pragma unroll
            for (int m = 0; m < 4; ++m) { const int r = row0 + ai * HALF + m * 16; const bf16_t* gp = G + (size_t)r * 2048 + BR * 1024 + col0; bf16_t* op = MG + (size_t)r * 1024 + col0;
#pragma unroll
                for (int bj = 0; bj < 2; ++bj) { const u32x4 g = *(const u32x4*)(gp + bj * HALF);
                    f32x4 v0 = bf_lo4(g) * acc[ai][bj][m][0], v1 = bf_hi4(g) * acc[ai][bj][m][1];
                    if (BR == 1) { const u32x4 o = *(const u32x4*)(op + bj * HALF); v0 = v0 + bf_lo4(o); v1 = v1 + bf_hi4(o); }
                    *(u32x4*)(op + bj * HALF) = pack8_bf16(v0, v1); } }
    }
};
struct EpiMergeFused {
    static constexpr bool PERM = true, AFTER_DRAIN = false, HAS_MID = true;
    const unsigned char* G; bf16_t* MG;
    static __device__ __forceinline__ f32x4 ub4(unsigned w) { return (f32x4){(float)(w & 255u), (float)((w >> 8) & 255u), (float)((w >> 16) & 255u), (float)(w >> 24)}; }
    __device__ __forceinline__ void mid(f32x4 (&acc)[2][2][4][2], const Unit& u, int wr, int wc, int fr, int fq) const {
        const unsigned char* gp = G + (size_t)(u.pm * BM + wr * 64 + fr) * 2048 + (u.pn * BM + 32 * wc + 8 * fq);
#pragma unroll
        for (int ai = 0; ai < 2; ++ai) {
#pragma unroll
            for (int m = 0; m < 4; ++m) {
#pragma unroll
                for (int bj = 0; bj < 2; ++bj) { const u32x2 g0 = *(const u32x2*)(gp + bj * HALF), g1 = *(const u32x2*)(gp + 1024 + bj * HALF);
                    const f32x4 a0 = ub4(g0.x), a1 = ub4(g0.y), b0 = ub4(g1.x), b1 = ub4(g1.y); f32x4 r0, r1;
#pragma unroll
                    for (int i = 0; i < 4; ++i) { r0[i] = a0[i] * __builtin_amdgcn_rcpf(b0[i]); r1[i] = a1[i] * __builtin_amdgcn_rcpf(b1[i]); }
                    acc[ai][bj][m][0] = acc[ai][bj][m][0] * r0; acc[ai][bj][m][1] = acc[ai][bj][m][1] * r1; }
                gp += (m == 3 ? (HALF - 48) : 16) * 2048; asm volatile("" : "+v"(gp) :: "memory"); } }
    }
    __device__ __forceinline__ void operator()(const f32x4 (&acc)[2][2][4][2], const Unit& u, int wr, int wc, int fr, int fq) const {
        const int row0 = u.pm * BM + wr * 64 + fr, col0 = u.pn * BM + 32 * wc + 8 * fq;
#pragma unroll
        for (int ai = 0; ai < 2; ++ai)
#pragma unroll
            for (int m = 0; m < 4; ++m) { const int r = row0 + ai * HALF + m * 16; const unsigned char* gp = G + (size_t)r * 2048 + 1024 + col0; bf16_t* op = MG + (size_t)r * 1024 + col0;
#pragma unroll
                for (int bj = 0; bj < 2; ++bj) { const u32x2 g = *(const u32x2*)(gp + bj * HALF);
                    *(u32x4*)(op + bj * HALF) = pack8_bf16(ub4(g.x) * (1.0f / 255.0f) * acc[ai][bj][m][0], ub4(g.y) * (1.0f / 255.0f) * acc[ai][bj][m][1]); } }
    }
};
struct EpiWoF {
    static constexpr bool PERM = true, AFTER_DRAIN = false, HAS_MID = false;
    const bf16_t* XBF; bf16_t* X1B; float* SS2;
    __device__ __forceinline__ void operator()(const f32x4 (&acc)[2][2][4][2], const Unit& u, int wr, int wc, int fr, int fq) const {
        const int row0 = u.pm * BM + wr * 64 + fr, col0 = u.pn * BM + 32 * wc + 8 * fq;
#pragma unroll
        for (int ai = 0; ai < 2; ++ai)
#pragma unroll
            for (int m = 0; m < 4; ++m) { const int r = row0 + ai * HALF + m * 16; const size_t o = (size_t)r * 1024 + col0; float ss = 0.f;
#pragma unroll
                for (int bj = 0; bj < 2; ++bj) { const u32x4 xw = *(const u32x4*)(XBF + o + bj * HALF); const f32x4 r0 = bf_lo4(xw) + acc[ai][bj][m][0], r1 = bf_hi4(xw) + acc[ai][bj][m][1];
                    *(u32x4*)(X1B + o + bj * HALF) = pack8_bf16(r0, r1);
                    ss += (r0[0] * r0[0] + r0[1] * r0[1]) + (r0[2] * r0[2] + r0[3] * r0[3]) + (r1[0] * r1[0] + r1[1] * r1[1]) + (r1[2] * r1[2] + r1[3] * r1[3]); }
                ss += __shfl_xor(ss, 16); ss += __shfl_xor(ss, 32);
                if (fq == 0) SS2[(size_t)r * 16 + u.pn * 4 + wc] = ss; }
    }
};
struct EpiFF1F {
    static constexpr bool PERM = true, AFTER_DRAIN = false, HAS_MID = false;
    const float* SS2; bf16_t* H;
    __device__ __forceinline__ void operator()(const f32x4 (&acc)[2][2][4][2], const Unit& u, int wr, int wc, int fr, int fq) const {
        const int row0 = u.pm * BM + wr * 64 + fr, col0 = u.pn * BM + 32 * wc + 8 * fq;
#pragma unroll
        for (int ai = 0; ai < 2; ++ai)
#pragma unroll
            for (int m = 0; m < 4; ++m) { const int r = row0 + ai * HALF + m * 16; const f32x4* sp = (const f32x4*)(SS2 + (size_t)r * 16);
                const f32x4 t = (sp[0] + sp[1]) + (sp[2] + sp[3]); const float rq = 1.0f / (((t[0] + t[1]) + (t[2] + t[3])) * (1.0f / 1024.f) + EPS);
                bf16_t* hp = H + (size_t)r * 4096 + col0;
#pragma unroll
                for (int bj = 0; bj < 2; ++bj) { f32x4 v0 = __builtin_elementwise_max(acc[ai][bj][m][0], (f32x4){0.f, 0.f, 0.f, 0.f}), v1 = __builtin_elementwise_max(acc[ai][bj][m][1], (f32x4){0.f, 0.f, 0.f, 0.f});
                    v0 = v0 * v0 * rq; v1 = v1 * v1 * rq; *(u32x4*)(hp + bj * HALF) = pack8_bf16(v0, v1); } }
    }
};
struct EpiFF2F {
    static constexpr bool PERM = true, AFTER_DRAIN = false, HAS_MID = false;
    bf16_t* XR;
    __device__ __forceinline__ void operator()(const f32x4 (&acc)[2][2][4][2], const Unit& u, int wr, int wc, int fr, int fq) const {
        const int row0 = u.pm * BM + wr * 64 + fr, col0 = u.pn * BM + 32 * wc + 8 * fq;
#pragma unroll
        for (int ai = 0; ai < 2; ++ai)
#pragma unroll
            for (int m = 0; m < 4; ++m) { bf16_t* p = XR + (size_t)(row0 + ai * HALF + m * 16) * 1024 + col0;
#pragma unroll
                for (int bj = 0; bj < 2; ++bj) { const u32x4 xr = *(const u32x4*)(p + bj * HALF);
                    *(u32x4*)(p + bj * HALF) = pack8_bf16(bf_lo4(xr) + acc[ai][bj][m][0], bf_hi4(xr) + acc[ai][bj][m][1]); } }
    }
};
}

#include <hip/hip_bf16.h>
#include <cmath>
namespace attn_body {
using bf16=__hip_bfloat16;
using bf16x8=__attribute__((ext_vector_type(8)))short;
using s16x4=__attribute__((ext_vector_type(4)))short;
using f32x16=__attribute__((ext_vector_type(16)))float;
using u32x4=__attribute__((ext_vector_type(4)))unsigned;
constexpr int BATCH=8,NHEAD=8,SEQ=4096,D=64,DM=NHEAD*D;
constexpr int NW=8,QBLK=32,QB=QBLK*NW,KVBLK=64,NQB=SEQ/QB;
constexpr int ATTN_PITCH=DM, ATTN_UNIT_ROWS=QB, OPITCH=1024;
__device__ __forceinline__ int crow(int r,int hi){return (r&3)+8*(r>>2)+4*hi;}
#define SBAR() __builtin_amdgcn_sched_barrier(0)
constexpr int NSLOT=3, SLOTB=8192;
constexpr int LDS_K=0, LDS_V=NSLOT*SLOTB, LDS_WS=2*NSLOT*SLOTB, LDS_OST=LDS_WS+NW*64*4, LDS_MASK=LDS_OST+NW*4096, LDS_BYTES=LDS_MASK+NW*768;
constexpr float C2=0.125f*1.4426950408889634f;
__device__ __forceinline__ void glds16(const void*gsrc,unsigned lds_dst){unsigned keep;
  asm volatile("s_mov_b32 %0, m0\n\ts_mov_b32 m0, %2\n\ts_nop 0\n\tglobal_load_lds_dwordx4 %1, off\n\ts_mov_b32 m0, %0":"=&s"(keep):"v"(gsrc),"s"(lds_dst):"memory");}
__device__ __forceinline__ void glds4(const void*gsrc,unsigned lds_dst){unsigned keep;
  asm volatile("s_mov_b32 %0, m0\n\ts_mov_b32 m0, %2\n\ts_nop 0\n\tglobal_load_lds_dword %1, off\n\ts_mov_b32 m0, %0":"=&s"(keep):"v"(gsrc),"s"(lds_dst):"memory");}
template<int POS> __device__ __forceinline__ float mk1t(float x,unsigned m){unsigned t;asm("v_bfe_i32 %0, %1, %2, 1":"=v"(t):"v"(m),"n"(POS));return __uint_as_float(__float_as_uint(x)&t);}
#define mk1(x,m,pos) mk1t<(pos)>((x),(m))
__device__ __forceinline__ float mk1r(float x,unsigned m,int pos){return __uint_as_float(__float_as_uint(x)&(unsigned)__builtin_amdgcn_sbfe((int)m,pos,1));}
__device__ __forceinline__ float max3f(float a,float b,float c){float r;asm("v_max3_f32 %0, %1, %2, %3":"=v"(r):"v"(a),"v"(b),"v"(c));return r;}
__device__ __forceinline__ float max2f(float a,float b){float r;asm("v_max_f32_e32 %0, %1, %2":"=v"(r):"v"(a),"v"(b));return r;}
__device__ __forceinline__ float fadd_s(float a,float b){float r;asm("v_add_f32_e32 %0, %1, %2":"=v"(r):"v"(a),"v"(b));return r;}
__device__ __forceinline__ float fsub_s(float a,float b){float r;asm("v_sub_f32_e32 %0, %1, %2":"=v"(r):"v"(a),"v"(b));return r;}
typedef float f32x2_t __attribute__((ext_vector_type(2))); typedef __bf16 bf16x2_t __attribute__((ext_vector_type(2)));
__device__ __forceinline__ unsigned cvtpk_s(float lo,float hi){f32x2_t v={lo,hi};bf16x2_t b=__builtin_convertvector(v,bf16x2_t);return __builtin_bit_cast(unsigned,b);}
#define WAIT_BAR(N) asm volatile("s_waitcnt vmcnt(" #N ") lgkmcnt(0)\n\ts_barrier":::"memory")

__device__ __forceinline__ void qkt(f32x16&p0,f32x16&p1,const char*Kslot,const bf16x8*qr,const f32x16&negm,int r32,int hi){
  const char*kb=Kslot+hi*1024+r32*16;
  #pragma unroll
  for(int d0=0;d0<4;++d0){
    const bf16x8 b0=*reinterpret_cast<const bf16x8*>(kb+d0*2048);
    const bf16x8 b1=*reinterpret_cast<const bf16x8*>(kb+d0*2048+512);
    if(d0==0){p0=__builtin_amdgcn_mfma_f32_32x32x16_bf16(b0,qr[0],negm,0,0,0);p1=__builtin_amdgcn_mfma_f32_32x32x16_bf16(b1,qr[0],negm,0,0,0);}
    else{p0=__builtin_amdgcn_mfma_f32_32x32x16_bf16(b0,qr[d0],p0,0,0,0);p1=__builtin_amdgcn_mfma_f32_32x32x16_bf16(b1,qr[d0],p1,0,0,0);}}
}
typedef __attribute__((address_space(3))) const char* lds_cptr;
typedef short v4i16_t __attribute__((ext_vector_type(4)));
__device__ __forceinline__ void kload8(bf16x8*kf,lds_cptr kp){
  kf[0]=*(const __attribute__((address_space(3))) bf16x8*)(kp);      kf[1]=*(const __attribute__((address_space(3))) bf16x8*)(kp+512);
  kf[2]=*(const __attribute__((address_space(3))) bf16x8*)(kp+2048); kf[3]=*(const __attribute__((address_space(3))) bf16x8*)(kp+2560);
  kf[4]=*(const __attribute__((address_space(3))) bf16x8*)(kp+4096); kf[5]=*(const __attribute__((address_space(3))) bf16x8*)(kp+4608);
  kf[6]=*(const __attribute__((address_space(3))) bf16x8*)(kp+6144); kf[7]=*(const __attribute__((address_space(3))) bf16x8*)(kp+6656);
}
__device__ __forceinline__ void kload2(bf16x8*kf,lds_cptr kp,int j){ kf[2*j]=*(const __attribute__((address_space(3))) bf16x8*)(kp+j*2048); kf[2*j+1]=*(const __attribute__((address_space(3))) bf16x8*)(kp+j*2048+512); }
__device__ __forceinline__ s16x4 vtr(lds_cptr p){ return __builtin_bit_cast(s16x4,__builtin_amdgcn_ds_read_tr16_b64_v4i16((__attribute__((address_space(3))) v4i16_t*)p)); }
__device__ __forceinline__ float rowmax(const f32x16&p0,const f32x16&p1){
  float a=max3f(p0[0],p0[1],p1[0]),b=max3f(p0[2],p0[3],p1[1]);a=max3f(a,p1[2],p1[3]);
  #pragma unroll
  for(int r=4;r<16;r+=4){a=max3f(a,p0[r],p0[r+1]);b=max3f(b,p0[r+2],p0[r+3]);a=max3f(a,p1[r],p1[r+1]);b=max3f(b,p1[r+2],p1[r+3]);}
  const float m=max2f(a,b);
  auto rr=__builtin_amdgcn_permlane32_swap(__float_as_uint(m),__float_as_uint(m),false,false);
  return max2f(__uint_as_float(rr[0]),__uint_as_float(rr[1]));
}
__device__ __forceinline__ void pv(f32x16*o,int vb,bf16x8 pa0,bf16x8 pa1,bf16x8 pa2,bf16x8 pa3){
  #pragma unroll
  for(int d0=0;d0<2;++d0){s16x4 lo[4],hi[4];
    #pragma unroll
    for(int ks=0;ks<4;++ks){
      asm volatile("ds_read_b64_tr_b16 %0,%1 offset:%c2":"=&v"(lo[ks]):"v"(vb),"i"(d0*4096+ks*1024):"memory");
      asm volatile("ds_read_b64_tr_b16 %0,%1 offset:%c2":"=&v"(hi[ks]):"v"(vb),"i"(d0*4096+ks*1024+512):"memory");}
    asm volatile("s_waitcnt lgkmcnt(0)":::"memory");SBAR();
    #define PK(k) (bf16x8){lo[k][0],lo[k][1],lo[k][2],lo[k][3],hi[k][0],hi[k][1],hi[k][2],hi[k][3]}
    o[d0]=__builtin_amdgcn_mfma_f32_32x32x16_bf16(pa0,PK(0),o[d0],0,0,0);
    o[d0]=__builtin_amdgcn_mfma_f32_32x32x16_bf16(pa1,PK(1),o[d0],0,0,0);
    o[d0]=__builtin_amdgcn_mfma_f32_32x32x16_bf16(pa2,PK(2),o[d0],0,0,0);
    o[d0]=__builtin_amdgcn_mfma_f32_32x32x16_bf16(pa3,PK(3),o[d0],0,0,0);
    #undef PK
  }
}

#ifndef ATTN_STORE16
#define ATTN_STORE16(p,v) (*(u32x4*)(p)=(v))
#endif
template<int THRL> __device__ __forceinline__ void attn_unit(int b,int h,int qb,const bf16*Q,const bf16*__restrict__ K,const bf16*__restrict__ V,bf16*O,const unsigned long long*MK,char*shm){
  const int tid=threadIdx.x,lane=tid&63,r32=lane&31,hi=lane>>5; const int wid=__builtin_amdgcn_readfirstlane(tid>>6);
  const long rowbase=(long)b*SEQ; const int q0=qb*QB;
  const bf16*Qw=Q+(rowbase+q0+wid*QBLK)*DM+h*D;
  const bf16*Kh=K+rowbase*DM+h*D,*Vh=V+rowbase*DM+h*D;
  const unsigned lds0=(unsigned)(uintptr_t)shm;
  float*wsf=(float*)(shm+LDS_WS)+wid*64;
  const bf16*ksrc=Kh+(long)lane*DM+wid*8;
  const bf16*vsrc=Vh+(long)(16*(wid&3)+(lane>>2))*DM+(wid>>2)*32+(lane&3)*8;
  const unsigned kdst=lds0+LDS_K+wid*1024, vdst=lds0+LDS_V+wid*1024;
  #define DMA_K(t,slot) glds16(ksrc+(long)(t)*KVBLK*DM,(unsigned)__builtin_amdgcn_readfirstlane(kdst+(slot)))
  #define DMA_V(t,slot) glds16(vsrc+(long)(t)*KVBLK*DM,(unsigned)__builtin_amdgcn_readfirstlane(vdst+(slot)))
  const char*msrc=(const char*)MK+((size_t)b*64*SEQ+q0+wid*QBLK)*8+lane*4;
  const unsigned mdst=lds0+LDS_MASK+wid*768;
  #define DMA_M(t,slot) glds4(msrc+(size_t)(t)*SEQ*8,(unsigned)__builtin_amdgcn_readfirstlane(mdst+((slot)>>5)))
  typedef __attribute__((address_space(3))) const unsigned long long* lds_u64p;
  const lds_cptr mp0=(lds_cptr)shm+LDS_MASK+wid*768+8*r32;
  unsigned mlo,mhi;
  #define MRD(slot) do{ const unsigned long long mw_=*(lds_u64p)(mp0+((slot)>>5)); mlo=((unsigned)mw_)>>(4*hi); mhi=((unsigned)(mw_>>32))>>(4*hi); }while(0)
  const int vb0=(int)(lds0+LDS_V)+((lane>>4)&1)*32+(lane&3)*8+(4*hi+((lane&15)>>2))*64;
  const char*Kbase=shm+LDS_K; bf16x8 kf[8];
  const lds_cptr shm3=(lds_cptr)shm; const lds_cptr kp0=shm3+LDS_K+hi*1024+r32*16; const lds_cptr vp0=shm3+LDS_V+((lane>>4)&1)*32+(lane&3)*8+(4*hi+((lane&15)>>2))*64;
  const int NT=(q0+QB)/KVBLK;
  DMA_M(0,0);DMA_K(0,0);DMA_V(0,0);DMA_K(1,SLOTB);
  bf16x8 qr[4];
  #pragma unroll
  for(int d0=0;d0<4;++d0)qr[d0]=*reinterpret_cast<const bf16x8*>(&Qw[(long)r32*DM+d0*16+hi*8]);
  float mhat=0.f,l_reg=0.f;f32x16 o[2];o[0]=f32x16{};o[1]=f32x16{};f32x16 negm=f32x16{};asm volatile("":"+v"(negm));
  const int qrel=wid*QBLK+r32;
  bool resc=false;
  #define START(P0,P1) do{ const float rm=rowmax(P0,P1); resc=false; \
    { const float dl=rm; mhat=fadd_s(mhat,dl); \
      _Pragma("unroll") for(int r=0;r<16;++r){P0[r]=fsub_s(P0[r],dl);P1[r]=fsub_s(P1[r],dl);} \
      _Pragma("unroll") for(int r=0;r<16;++r)negm[r]=-mhat; asm volatile("":"+v"(negm)); } \
    _Pragma("unroll") for(int r=0;r<16;++r)P0[r]=__builtin_amdgcn_exp2f(P0[r]); }while(0)
  #define RESC() do{ if(resc){ asm volatile("s_waitcnt lgkmcnt(0)":::"memory"); \
      _Pragma("unroll") for(int d_=0;d_<2;++d_) _Pragma("unroll") for(int r=0;r<16;++r)o[d_][r]*=wsf[crow(r,hi)]; } }while(0)
  f32x16 pA0,pA1,pB0,pB1;
  int sl_prev=0,sl_cur=0,sl_next=SLOTB;
  #define ROT() do{sl_prev=sl_cur;sl_cur=sl_next;sl_next=(sl_next==(NSLOT-1)*SLOTB)?0:sl_next+SLOTB;}while(0)
  DMA_K(2,2*SLOTB);
  WAIT_BAR(3);
  qkt(pA0,pA1,Kbase,qr,negm,r32,hi);asm volatile("s_nop 15\n\ts_nop 7":"+v"(pA0),"+v"(pA1));
  START(pA0,pA1);
  _Pragma("unroll") for(int r=0;r<16;++r)pA1[r]=__builtin_amdgcn_exp2f(pA1[r]);
  MRD(0);
  _Pragma("unroll") for(int r=0;r<16;++r){pA0[r]=mk1r(pA0[r],mlo,(r&3)+8*(r>>2));pA1[r]=mk1r(pA1[r],mhi,(r&3)+8*(r>>2));}
  WAIT_BAR(0);
  DMA_M(1,SLOTB);DMA_M(2,2*SLOTB);DMA_K(3,0);DMA_V(1,SLOTB);
  ROT();
  kload8(kf,kp0+sl_cur);
  WAIT_BAR(2);
  s16x4 vlo[8],vhi[8]; u32x4 pw0,pw1,pw2,pw3;
  #define PKW(P,B) cvtpk_s(P[B],P[B+1])
  #define PAF(k) __builtin_bit_cast(bf16x8,pw##k)
  #define VFR(i) (bf16x8){vlo[i][0],vlo[i][1],vlo[i][2],vlo[i][3],vhi[i][0],vhi[i][1],vhi[i][2],vhi[i][3]}
  #define PIN(x) asm volatile("":"+v"(x))
  #define MX3(a,b,c) __builtin_fmaxf(__builtin_fmaxf((a),(b)),(c))
  #define GAPA(MF,A0,A1,A2,A3,W0,W1,PW) do{ MF; sacc+=A0; sacc+=A1; sacc+=A2; sacc+=A3; PIN(sacc); W0; W1; PIN(PW); SBAR(); }while(0)
  #define EX(v) __builtin_amdgcn_exp2f(v)
  #define GAPB(MF,X,B,MW) do{ MF; X[B]=mk1(EX(X[B]),MW,2*(B)); X[B+1]=mk1(EX(X[B+1]),MW,2*(B)+1); X[B+2]=mk1(EX(X[B+2]),MW,2*(B)+2); X[B+3]=mk1(EX(X[B+3]),MW,2*(B)+3); PIN(X); SBAR(); }while(0)
  #define VRD(i) do{ vlo[i]=vtr(vp_+(((i)>>2)*4096+((i)&3)*1024)); vhi[i]=vtr(vp_+(((i)>>2)*4096+((i)&3)*1024+512)); }while(0)
  #define KRD(G,j) do{ if(G){ kload2(kf,kp0+sl_next,j); SBAR(); } }while(0)
  #define STEP(C0,C1,P0,P1,t,GK,GV,GL,GM) do{ SBAR(); \
    const lds_cptr vp_=vp0+sl_prev; MRD(sl_cur); \
    VRD(0); SBAR(); float sacc=(P0[0]+P0[1]); \
    GAPA(C0=__builtin_amdgcn_mfma_f32_32x32x16_bf16(kf[0],qr[0],negm,0,0,0), P0[2],P0[3],P0[4],P0[5],     pw0[0]=PKW(P0,0), pw0[1]=PKW(P0,2), pw0); \
    VRD(4); SBAR(); GAPA(C1=__builtin_amdgcn_mfma_f32_32x32x16_bf16(kf[1],qr[0],negm,0,0,0), P0[6],P0[7],P0[8],P0[9],     pw0[2]=PKW(P0,4), pw0[3]=PKW(P0,6), pw0); \
    VRD(1); SBAR(); GAPA(C0=__builtin_amdgcn_mfma_f32_32x32x16_bf16(kf[2],qr[1],C0,0,0,0),   P0[10],P0[11],P0[12],P0[13], pw1[0]=PKW(P0,8), pw1[1]=PKW(P0,10), pw1); \
    VRD(5); SBAR(); GAPA(C1=__builtin_amdgcn_mfma_f32_32x32x16_bf16(kf[3],qr[1],C1,0,0,0),   P0[14],P0[15],P1[0],P1[1],   pw1[2]=PKW(P0,12),pw1[3]=PKW(P0,14), pw1); \
    VRD(2); SBAR(); GAPA(C0=__builtin_amdgcn_mfma_f32_32x32x16_bf16(kf[4],qr[2],C0,0,0,0),   P1[2],P1[3],P1[4],P1[5],     pw2[0]=PKW(P1,0), pw2[1]=PKW(P1,2), pw2); \
    VRD(6); SBAR(); GAPA(C1=__builtin_amdgcn_mfma_f32_32x32x16_bf16(kf[5],qr[2],C1,0,0,0),   P1[6],P1[7],P1[8],P1[9],     pw2[2]=PKW(P1,4), pw2[3]=PKW(P1,6), pw2); \
    VRD(3); SBAR(); GAPA(C0=__builtin_amdgcn_mfma_f32_32x32x16_bf16(kf[6],qr[3],C0,0,0,0),   P1[10],P1[11],P1[12],P1[13], pw3[0]=PKW(P1,8), pw3[1]=PKW(P1,10), pw3); \
    VRD(7); SBAR(); GAPA(C1=__builtin_amdgcn_mfma_f32_32x32x16_bf16(kf[7],qr[3],C1,0,0,0),   P1[14],P1[15],0.f,0.f,       pw3[2]=PKW(P1,12),pw3[3]=PKW(P1,14), pw3); \
    l_reg+=sacc; \
    if(GK){DMA_K((t)+3,sl_cur);} if(GV){DMA_V((t)+1,sl_next);} if(GM){DMA_M((t)+2,sl_prev);} \
    { float a=MX3(C0[0],C0[1],C1[0]),b=MX3(C0[2],C0[3],C1[1]); a=MX3(a,C1[2],C1[3]); \
      _Pragma("unroll") for(int r=4;r<16;r+=4){a=MX3(a,C0[r],C0[r+1]);b=MX3(b,C0[r+2],C0[r+3]);a=MX3(a,C1[r],C1[r+1]);b=MX3(b,C1[r+2],C1[r+3]);} \
      float rm=__builtin_fmaxf(a,b); { auto rr=__builtin_amdgcn_permlane32_swap(__float_as_uint(rm),__float_as_uint(rm),false,false); rm=__builtin_fmaxf(__uint_as_float(rr[0]),__uint_as_float(rr[1])); } \
      resc=false; \
      if(__builtin_expect(__any(rm>(float)THRL),0)){ const float dl=__builtin_fmaxf(rm,0.f); mhat+=dl; \
        _Pragma("unroll") for(int r=0;r<16;++r){C0[r]-=dl;C1[r]-=dl;} \
        _Pragma("unroll") for(int r=0;r<16;++r)negm[r]=-mhat; asm volatile("":"+v"(negm)); \
        const float f=__builtin_amdgcn_exp2f(-dl); l_reg*=f; if(hi==0)wsf[r32]=f; resc=true; } } \
    SBAR(); \
    GAPB(o[0]=__builtin_amdgcn_mfma_f32_32x32x16_bf16(PAF(0),VFR(0),o[0],0,0,0), C0,0,mlo); \
    GAPB(o[1]=__builtin_amdgcn_mfma_f32_32x32x16_bf16(PAF(0),VFR(4),o[1],0,0,0), C0,4,mlo); \
    KRD(GL,0); GAPB(o[0]=__builtin_amdgcn_mfma_f32_32x32x16_bf16(PAF(1),VFR(1),o[0],0,0,0), C0,8,mlo); \
    KRD(GL,1); GAPB(o[1]=__builtin_amdgcn_mfma_f32_32x32x16_bf16(PAF(1),VFR(5),o[1],0,0,0), C0,12,mlo); \
    KRD(GL,2); GAPB(o[0]=__builtin_amdgcn_mfma_f32_32x32x16_bf16(PAF(2),VFR(2),o[0],0,0,0), C1,0,mhi); \
    KRD(GL,3); GAPB(o[1]=__builtin_amdgcn_mfma_f32_32x32x16_bf16(PAF(2),VFR(6),o[1],0,0,0), C1,4,mhi); \
    GAPB(o[0]=__builtin_amdgcn_mfma_f32_32x32x16_bf16(PAF(3),VFR(3),o[0],0,0,0), C1,8,mhi); \
    GAPB(o[1]=__builtin_amdgcn_mfma_f32_32x32x16_bf16(PAF(3),VFR(7),o[1],0,0,0), C1,12,mhi); \
    }while(0)
  int t=1;
  for(;t+5<NT;t+=2){
    STEP(pB0,pB1,pA0,pA1,t,true,true,true,true);     WAIT_BAR(3); RESC(); ROT();
    STEP(pA0,pA1,pB0,pB1,t+1,true,true,true,true);   WAIT_BAR(3); RESC(); ROT();
  }
  #define ENDW(tt) do{ if((tt)+3<NT){WAIT_BAR(3);} else if((tt)+2<NT){WAIT_BAR(2);} else {WAIT_BAR(0);} }while(0)
  for(;t+1<NT;t+=2){
    STEP(pB0,pB1,pA0,pA1,t,(t+3<NT),(t+1<NT),(t+1<NT),(t+2<NT));       ENDW(t);   RESC(); ROT();
    STEP(pA0,pA1,pB0,pB1,t+1,(t+4<NT),(t+2<NT),(t+2<NT),(t+3<NT));     ENDW(t+1); RESC(); ROT();
  }
  STEP(pB0,pB1,pA0,pA1,NT-1,false,false,false,false); RESC();
  { float sacc=pB0[0]+pB0[1]; _Pragma("unroll") for(int r=2;r<16;++r)sacc+=pB0[r]; _Pragma("unroll") for(int r=0;r<16;++r)sacc+=pB1[r]; l_reg+=sacc;
    pw0=(u32x4){PKW(pB0,0),PKW(pB0,2),PKW(pB0,4),PKW(pB0,6)};pw1=(u32x4){PKW(pB0,8),PKW(pB0,10),PKW(pB0,12),PKW(pB0,14)};pw2=(u32x4){PKW(pB1,0),PKW(pB1,2),PKW(pB1,4),PKW(pB1,6)};pw3=(u32x4){PKW(pB1,8),PKW(pB1,10),PKW(pB1,12),PKW(pB1,14)};
    SBAR(); pv(o,vb0+sl_cur,PAF(0),PAF(1),PAF(2),PAF(3)); }
  #undef PKW
  #undef PAF
  #undef VFR
  #undef PIN
  #undef MX3
  #undef GAPA
  #undef GAPB
  #undef EX
  #undef VRD
  #undef KRD
  #undef STEP
  #undef ENDW
  {auto rr=__builtin_amdgcn_permlane32_swap(__float_as_uint(l_reg),__float_as_uint(l_reg),false,false);l_reg=__uint_as_float(rr[0])+__uint_as_float(rr[1]);}
  if(hi==0)wsf[32+r32]=l_reg;asm volatile("s_waitcnt lgkmcnt(0)":::"memory");
  float rli[16];
  #pragma unroll
  for(int r=0;r<16;++r)rli[r]=__builtin_amdgcn_rcpf(wsf[32+crow(r,hi)]);
  bf16*Ow=O+(rowbase+q0+wid*QBLK)*OPITCH+h*D;
  { bf16*stg=(bf16*)(shm+LDS_OST)+wid*2048;
    #pragma unroll
    for(int r=0;r<16;++r){const int orow=crow(r,hi);
      #pragma unroll
      for(int d0=0;d0<2;++d0)stg[orow*64+d0*32+r32]=__float2bfloat16(o[d0][r]*rli[r]);}
    asm volatile("s_waitcnt lgkmcnt(0)":::"memory");
    #pragma unroll
    for(int i=0;i<4;++i){const int row=i*8+(lane>>3),ch=lane&7; const u32x4 v=*(const u32x4*)(stg+row*64+ch*8); ATTN_STORE16(Ow+(long)row*OPITCH+ch*8,v);} }
  asm volatile("s_waitcnt lgkmcnt(0)\n\ts_barrier":::"memory");
  #undef DMA_K
  #undef DMA_V
  #undef DMA_M
  #undef MRD
  #undef START
  #undef RESC
  #undef ROT
}
constexpr int ATTN_LDS_BYTES=LDS_BYTES;
struct AttnTensors { const bf16* Q; const bf16* K; const bf16* V; bf16* O; const unsigned long long* MK; };
struct AttnUnit { int bh; int qb; };
struct StaticOrder {
  int vcu, G;
  __device__ __forceinline__ explicit StaticOrder(int grid,int block):vcu((grid%8==0)?(block%8)*(grid/8)+block/8:block),G(grid){}
  __device__ __forceinline__ bool next(int i,AttnUnit&u)const{
    if(G==256){ if(i>=4)return false; const int s=vcu&3; u.bh=vcu>>2; u.qb=(i==0)?s:(i==1)?15-s:(i==2)?4+s:11-s; return true; }
    const int id=i*G+vcu; if(id>=BATCH*NHEAD*NQB)return false; u.bh=id/NQB; u.qb=NQB-1-(id%NQB); return true; }
  __device__ __forceinline__ void a_ready(const AttnUnit&)const{}
  __device__ __forceinline__ void done(const AttnUnit&)const{}
};
template<class Sched,int THRL=8> __device__ __forceinline__ void attn_phase(char*lds,const AttnTensors&T,const Sched&S){
  AttnUnit u;
  for(int i=0;S.next(i,u);++i){ S.a_ready(u); attn_unit<THRL>(u.bh/NHEAD,u.bh%NHEAD,u.qb,T.Q,T.K,T.V,T.O,T.MK,lds); S.done(u); }
}
#undef SBAR
#undef WAIT_BAR
}

#define GAS __attribute__((address_space(1)))
#define XB_TMO      128
#define XB_XCNT(j)  (256  + 64 * (j))
#define XB_XSUB(j)  (1280 + 64 * (j))
#define XB_XGEN(j)  (2304 + 64 * (j))
#define XB_TOP      3328
#define XB_TOPGEN   3392
#define XCD_BAR_WORDS 3456
#define XB_SPIN_CAP (1u << 18)

__device__ __forceinline__ unsigned xb_ld(unsigned* p)              { return __hip_atomic_load(p, __ATOMIC_RELAXED, __HIP_MEMORY_SCOPE_AGENT); }
__device__ __forceinline__ unsigned xb_add(unsigned* p, unsigned v) { return __hip_atomic_fetch_add(p, v, __ATOMIC_RELAXED, __HIP_MEMORY_SCOPE_AGENT); }
__device__ __forceinline__ unsigned xb_xcc_id() { return (unsigned)__builtin_amdgcn_s_getreg((3 << 11) | 20) & 0xFu; }
#define XB_SPIN(cond, bar) do { unsigned _sp = 0; while (cond) { __builtin_amdgcn_s_sleep(1); \
    if ((++_sp & 255u) == 0u) { if (xb_ld(&(bar)[XB_TMO])) break; if (_sp > XB_SPIN_CAP) { atomicAdd(&(bar)[XB_TMO], 1u); break; } } } } while (0)

struct XcdBarrier {
    unsigned* bar; unsigned x;
    volatile LAS unsigned* st;
};

__device__ __forceinline__ XcdBarrier xcd_barrier_post(unsigned* bar, volatile LAS unsigned* st) {
    XcdBarrier b; b.bar = bar; b.x = xb_xcc_id(); b.st = st;
    if (threadIdx.x == 0) (void)xb_add(&bar[XB_XCNT(b.x)], 1u);
    return b;
}
__device__ __forceinline__ void xcd_barrier_complete(unsigned* bar, unsigned x, unsigned& nloc, unsigned& nx) {
    const unsigned G = gridDim.x * gridDim.y * gridDim.z;
    unsigned sum, cnt, mine, sp = 0u;
    for (;;) {
        sum = 0u; cnt = 0u; mine = 0u;
#pragma unroll
        for (unsigned j = 0; j < 16; ++j) { const unsigned c = xb_ld(&bar[XB_XCNT(j)]); sum += c; cnt += (c > 0u) ? 1u : 0u; mine = (j == x) ? c : mine; }
        if (sum == G) break;
        __builtin_amdgcn_s_sleep(1);
        if ((++sp & 255u) == 0u) { if (xb_ld(&bar[XB_TMO])) break; if (sp > XB_SPIN_CAP) { atomicAdd(&bar[XB_TMO], 1u); break; } }
    }
    nloc = mine > 0u ? mine : 1u; nx = cnt > 0u ? cnt : 1u;
}

__device__ __forceinline__ void xcd_barrier(const XcdBarrier& b) {
    asm volatile("s_waitcnt vmcnt(0)" ::: "memory");
    __syncthreads();
    if (threadIdx.x == 0) {
        unsigned* bar = b.bar;
        __builtin_amdgcn_s_waitcnt(0);
        unsigned nloc = b.st[0], nx = b.st[1];
        if (nloc == 0u) { xcd_barrier_complete(bar, b.x, nloc, nx); b.st[0] = nloc; b.st[1] = nx; }
        const unsigned old = xb_add(&bar[XB_XSUB(b.x)], 1u);
        const unsigned gen = old / nloc;
        if (old + 1u == (gen + 1u) * nloc) {
            __builtin_amdgcn_fence(__ATOMIC_RELEASE, "agent");
            asm volatile("s_waitcnt vmcnt(0)" ::: "memory");
            const unsigned og = xb_add(&bar[XB_TOP], 1u);
            const unsigned tg = og / nx;
            if (og + 1u == (tg + 1u) * nx) xb_add(&bar[XB_TOPGEN], 1u);
            else XB_SPIN(xb_ld(&bar[XB_TOPGEN]) == tg, bar);
            __builtin_amdgcn_fence(__ATOMIC_ACQUIRE, "agent");
            xb_add(&bar[XB_XGEN(b.x)], 1u);
            asm volatile("s_waitcnt vmcnt(0)" ::: "memory");
        } else {
            XB_SPIN(xb_ld(&bar[XB_XGEN(b.x)]) == gen, bar);
            __builtin_amdgcn_fence(__ATOMIC_ACQUIRE, "agent");
            asm volatile("s_waitcnt vmcnt(0)" ::: "memory");
        }
    }
    __syncthreads();
}

constexpr int LDSCTL_OFF = 131072, MISC_OFF = LDSCTL_OFF + 320;
constexpr size_t WS_BAR = 4096 * 4;
__global__ void __launch_bounds__(NT, 2) fwd_kernel(Args args) {
    extern __shared__ __attribute__((aligned(16))) unsigned char lds[];
    Frame F;
    F.lds = (LAS unsigned char*)lds;
    F.tid = threadIdx.x; F.lane = F.tid & 63; F.wave = __builtin_amdgcn_readfirstlane(F.tid >> 6);
    F.gw = blockIdx.x * NWAVES + F.wave; F.ngw = gridDim.x * NWAVES;
    F.a = &args;
    F.out = args.out; F.ws = args.ws;
    unsigned char* ws = args.ws;
    for (int u = F.tid; u < (LDS_BYTES - LDSCTL_OFF) / 4; u += NT) ((LAS unsigned*)(F.lds + LDSCTL_OFF))[u] = 0u;
    __syncthreads();
    XcdBarrier bar = xcd_barrier_post((unsigned*)(args.ws + WS_BAR), (volatile LAS unsigned*)(F.lds + MISC_OFF) + 8);
    const int lo = args.ph_lo, hi = args.ph_hi;
#define IN(k) (lo <= (k) && (k) < hi)
#ifdef PROBE_PH
    unsigned long long pt0_ = 0;
#define PB(k) do { if (PROBE_MASK & (1 << (k))) { pt0_ = __builtin_amdgcn_s_memrealtime(); } } while (0)
#define PE(k) do { if (PROBE_MASK & (1 << (k))) { const unsigned long long t1_ = __builtin_amdgcn_s_memrealtime(); const unsigned long long d_ = t1_ - pt0_; while (__builtin_amdgcn_s_memrealtime() - t1_ < d_) __builtin_amdgcn_s_sleep(8); } } while (0)
#else
#define PB(k) do {} while (0)
#define PE(k) do {} while (0)
#endif
#if USE_CG_SYNC
#define SEAM(k) do { if (IN(k) && IN((k) + 1)) { __threadfence(); cg::this_grid().sync(); } } while (0)
#else
#define SEAM(k) do { if (IN(k) && IN((k) + 1)) { xcd_barrier(bar); } asm volatile("" : "+v"(F.tid)); F.lane = F.tid & 63; } while (0)
#endif
    PB(0); if (IN(0)) p0_prologue(F);
    SEAM(0); PE(0);
    PB(1);
#define GEMM_FAST(EPI_T, EPI_INIT, AP, BP, NN, KK) do { pg8::Gemm g{AP, BP, M, NN, KK}; pg8::StaticOrder S; S.init(M, NN, (int)gridDim.x, (int)blockIdx.x); EPI_T E EPI_INIT; \
        pg8::gemm_phase<EPI_T, pg8::StaticOrder, PG8_ALIGN, PG8_SP2>(F.lds, g, S, E); } while (0)
    if (IN(1)) {
#if FAST_G1
        GEMM_FAST(pg8::EpiProjF, ({F.ws}), F.XB(), F.WIN(), NP, 1024);
#else
        EpiProj E{F.RS1(), F.COS(), F.SIN(), F.U(), F.VG(), F.Q(), F.K(), F.V(), F.G(), F.QI(), F.KI(), F.WI()}; sgemm(F.XB(), F.WIN(), M, NP, 1024, E, F.gw, F.ngw, F.lane);
#endif
    }
    SEAM(1); PE(1); PB(2);
    if (IN(2)) {
#if FAST_SGU
        PB(11); sgu_fast(F); PE(11);
#else
        sgu_simple(F);
#endif
        __syncthreads();
#if FAST_IDX
        PB(12); indexer_fast(F); PE(12);
#else
        indexer_simple(F);
#endif
    }
    SEAM(2); PE(2); PB(3);
    if (IN(3)) {
#if FAST_ATTN
        const attn_body::AttnTensors AT{(const attn_body::bf16*)F.Q(), (const attn_body::bf16*)F.K(), (const attn_body::bf16*)F.V(), (attn_body::bf16*)(F.U() + 512), F.MASK()};
        const attn_body::StaticOrder S((int)gridDim.x, (int)blockIdx.x);
        attn_body::attn_phase<attn_body::StaticOrder>((char*)lds, AT, S);
#else
        attn_simple(F);
#endif
    }
    SEAM(3); PE(3); PB(4);
#if FAST_MERGE
    if (IN(4)) { GEMM_FAST(pg8::EpiMergeFused, ({(const unsigned char*)F.G(), F.MG()}), F.U(), F.WA(), 1024, 1024); }
#else
    if (IN(4)) { EpiMergeA E{F.G(), F.XB()}; sgemm(F.U(), F.WA(), M, 1024, 512, E, F.gw, F.ngw, F.lane); }
    SEAM(4);
    if (IN(5)) { EpiMergeB E{F.G(), F.XB()}; sgemm(F.Q(), F.WB(), M, 1024, 512, E, F.gw, F.ngw, F.lane); }
#endif
    SEAM(5); PE(4); PB(6);
    if (IN(6)) {
#if FAST_WO
        GEMM_FAST(pg8::EpiWoF, ({F.XB(), F.X1B(), F.SS2()}), F.MG(), F.WO(), 1024, 1024);
#else
        EpiWo E{F.x(), F.out, F.X1B()}; sgemm(F.XB(), F.WO(), M, 1024, 1024, E, F.gw, F.ngw, F.lane);
#endif
    }
    SEAM(6); PE(6); PB(8);
#if !(FAST_WO && FAST_FF1)
    if (IN(7)) rs2_rows(F);
    SEAM(7);
#endif
    if (IN(8)) {
#if FAST_FF1
        GEMM_FAST(pg8::EpiFF1F, ({F.SS2(), F.HID()}), F.X1B(), F.W1(), 4096, 1024);
#else
        EpiFF1 E{F.RS2(), F.HID()}; sgemm(F.X1B(), F.W1(), M, 4096, 1024, E, F.gw, F.ngw, F.lane);
#endif
    }
    SEAM(8); PE(8); PB(9);
    if (IN(9)) {
#if FAST_FF2
        GEMM_FAST(pg8::EpiFF2F, ({F.X1B()}), F.HID(), F.W2(), 1024, 4096);
#else
        EpiFF2 E{F.out}; sgemm(F.HID(), F.W2(), M, 1024, 4096, E, F.gw, F.ngw, F.lane);
#endif
    }
    SEAM(9); PE(9); PB(10);
    if (IN(10)) final_norm(F);
    PE(10);
#undef SEAM
#undef IN
}

extern "C" void kernel_launch(void* const* d_in, const int* in_sizes, int n_in, void* d_out, int out_size, void* d_ws, size_t ws_size, hipStream_t stream) {
    static int grid = 0;
    if (grid == 0) {
        if (n_in != 14 || out_size != M * D || ws_size < WS_END) { fprintf(stderr, "kernel_launch: unexpected shapes (n_in %d out %d ws %zu)\n", n_in, out_size, ws_size); grid = -1; return; }
        int dev = 0, cus = 0, per_cu = 0;
        hipGetDevice(&dev); hipDeviceGetAttribute(&cus, hipDeviceAttributeMultiprocessorCount, dev);
        hipFuncSetAttribute((const void*)fwd_kernel, hipFuncAttributeMaxDynamicSharedMemorySize, LDS_BYTES);
        hipOccupancyMaxActiveBlocksPerMultiprocessor(&per_cu, (const void*)fwd_kernel, NT, LDS_BYTES);
        if (per_cu < 1) { fprintf(stderr, "kernel_launch: occupancy query says %d blocks per CU\n", per_cu); per_cu = 1; }
        (void)hipGetLastError();
        grid = cus * (per_cu < 1 ? 1 : 1);
    }
    if (grid < 0) return;
    Args a{};
    for (int i = 0; i < 14; ++i) a.in[i] = (const float*)d_in[i];
    a.out = (float*)d_out; a.ws = (unsigned char*)d_ws;
#if ONE_LAUNCH
    hipMemsetAsync((char*)d_ws + WS_CTL, 0, 64 * 1024, stream);
    a.ph_lo = 0; a.ph_hi = 11;
    void* kargs[] = {&a};
    hipError_t e = hipLaunchCooperativeKernel((const void*)fwd_kernel, dim3(grid), dim3(NT), kargs, LDS_BYTES, stream);
    if (e != hipSuccess) fprintf(stderr, "cooperative launch failed: %s (grid %d)\n", hipGetErrorString(e), grid);
#else
    for (int ph = 0; ph <= 10; ++ph) {
        a.ph_lo = ph; a.ph_hi = ph + 1;
        hipLaunchKernelGGL(fwd_kernel, dim3(grid), dim3(NT), LDS_BYTES, stream, a);
    }
#endif
}
```

```cpp
#include <hip/hip_runtime.h>
#include <hip/hip_cooperative_groups.h>
#include <cstdio>
#include <cstdint>

namespace cg = cooperative_groups;
#ifndef ONE_LAUNCH
#define ONE_LAUNCH 1
#endif
#ifndef FAST_G1
#define FAST_G1 1
#endif
#ifndef USE_CG_SYNC
#define USE_CG_SYNC 0
#endif
#ifndef FAST_ATTN
#define FAST_ATTN 1
#endif
#ifndef FAST_SGU
#define FAST_SGU 1
#endif
#ifndef FAST_IDX
#define FAST_IDX 1
#endif
#ifndef FAST_MERGE
#define FAST_MERGE 1
#endif
#ifndef FAST_WO
#define FAST_WO 1
#endif
#ifndef FAST_FF1
#define FAST_FF1 1
#endif
#ifndef FAST_FF2
#define FAST_FF2 1
#endif
#define LAS __attribute__((address_space(3)))
typedef unsigned short bf16_t;
typedef short bf16x8 __attribute__((ext_vector_type(8)));
typedef _Float16 f16x8 __attribute__((ext_vector_type(8)));
typedef float f32x4 __attribute__((ext_vector_type(4)));
typedef float f32x2 __attribute__((ext_vector_type(2)));
typedef unsigned u32x4 __attribute__((ext_vector_type(4)));
typedef unsigned u32x2 __attribute__((ext_vector_type(2)));

constexpr int BATCH = 8, SEQ = 4096, D = 1024, M = BATCH * SEQ;
constexpr int DIN = 5192, NP = 5376;
constexpr int FF = 4096;
constexpr float EPS = 1e-6f;
constexpr float IDX_SCALE = 0.04419417382415922f;
constexpr float C2 = 0.125f * 1.4426950408889634f;
constexpr int NWAVES = 8, NT = NWAVES * 64;
constexpr int LDS_BYTES = 147456;

constexpr size_t MiB = 1u << 20;
constexpr size_t WS_CTL = 0;
constexpr size_t WS_COS = 1 * MiB;
constexpr size_t WS_SIN = WS_COS + 512 * 1024;
constexpr size_t WS_RS1 = 2 * MiB;
constexpr size_t WS_RS2 = WS_RS1 + 128 * 1024;
constexpr size_t WS_WI = 3 * MiB;
constexpr size_t WS_WSB = 4 * MiB;
constexpr size_t WS_WIN = 5 * MiB;
constexpr size_t WS_WA = 16 * MiB;
constexpr size_t WS_WB = 17 * MiB;
constexpr size_t WS_WO = 18 * MiB;
constexpr size_t WS_W1 = 20 * MiB;
constexpr size_t WS_W2 = 28 * MiB;
constexpr size_t WS_SS2 = 36 * MiB;
constexpr size_t WS_MG = 40 * MiB;
constexpr size_t WS_XB = 444 * MiB;
constexpr size_t WS_U = 104 * MiB;
constexpr int UP = 1024;
constexpr size_t WS_VG = 380 * MiB;
constexpr size_t WS_Q = 168 * MiB;
constexpr size_t WS_K = 200 * MiB;
constexpr size_t WS_V = 232 * MiB;
constexpr size_t WS_QI = 264 * MiB;
constexpr size_t WS_KI = 296 * MiB;
constexpr size_t WS_MASK = 300 * MiB;
constexpr size_t WS_G = 316 * MiB;
constexpr size_t WS_X1B = 444 * MiB;
constexpr size_t WS_HID = 104 * MiB;
constexpr size_t WS_END = 508 * MiB;

__device__ __forceinline__ unsigned f2bf(float f) { unsigned u = __float_as_uint(f); return (u + 0x7fffu + ((u >> 16) & 1u)) >> 16; }
__device__ __forceinline__ float bf2f(unsigned b) { return __uint_as_float(b << 16); }
__device__ __forceinline__ unsigned pk2(float lo, float hi) { return f2bf(lo) | (f2bf(hi) << 16); }
__device__ __forceinline__ unsigned short f2h(float f) { _Float16 h = (_Float16)f; return __builtin_bit_cast(unsigned short, h); }
__device__ __forceinline__ float h2f(unsigned b) { return (float)__builtin_bit_cast(_Float16, (unsigned short)b); }
__device__ __forceinline__ float wave_sum(float v) {
#pragma unroll
    for (int o = 1; o < 64; o <<= 1) v += __shfl_xor(v, o);
    return v;
}
__device__ __forceinline__ unsigned wave_sum_u(unsigned v) {
#pragma unroll
    for (int o = 1; o < 64; o <<= 1) v += (unsigned)__shfl_xor((int)v, o);
    return v;
}
__device__ __forceinline__ float gelu_tanh(float x) {
    const float z = 1.5957691216057308f * (x + 0.044715f * x * x * x);
    return x / (1.0f + __builtin_amdgcn_exp2f(-1.4426950408889634f * z));
}
__device__ __forceinline__ float sigmoidf(float x) { return 1.0f / (1.0f + __builtin_amdgcn_exp2f(-1.4426950408889634f * x)); }
__device__ __forceinline__ unsigned ukey(float f) { const unsigned u = __float_as_uint(f); return (u & 0x80000000u) ? ~u : (u | 0x80000000u); }

__device__ __forceinline__ size_t ki_off(int t, int d) { return (size_t)((((t >> 5) * 4 + (d >> 4)) * 64 + ((d >> 3) & 1) * 32 + (t & 31)) * 8 + (d & 7)); }
struct Args { const float* in[14]; float* out; unsigned char* ws; int ph_lo, ph_hi; };

struct Frame {
    LAS unsigned char* lds;
    int tid, lane, wave, gw, ngw;
    int vb, evenx;
    const Args* a;
    __device__ __forceinline__ const float* x() const { return a->in[0]; }
    __device__ __forceinline__ const float* norm1_g() const { return a->in[1]; }
    __device__ __forceinline__ const float* w_in() const { return a->in[2]; }
    __device__ __forceinline__ const float* w_s() const { return a->in[3]; }
    __device__ __forceinline__ const float* b_s() const { return a->in[4]; }
    __device__ __forceinline__ const float* ln_g() const { return a->in[5]; }
    __device__ __forceinline__ const float* ln_b() const { return a->in[6]; }
    __device__ __forceinline__ const float* w_out_a() const { return a->in[7]; }
    __device__ __forceinline__ const float* w_out_b() const { return a->in[8]; }
    __device__ __forceinline__ const float* w_o() const { return a->in[9]; }
    __device__ __forceinline__ const float* norm2_g() const { return a->in[10]; }
    __device__ __forceinline__ const float* w_ff_in() const { return a->in[11]; }
    __device__ __forceinline__ const float* w_ff_out() const { return a->in[12]; }
    __device__ __forceinline__ const float* norm_f_g() const { return a->in[13]; }
    float* out; unsigned char* ws;
    __device__ __forceinline__ float* COS() const { return (float*)(ws + WS_COS); }
    __device__ __forceinline__ float* SIN() const { return (float*)(ws + WS_SIN); }
    __device__ __forceinline__ float* RS1() const { return (float*)(ws + WS_RS1); }
    __device__ __forceinline__ float* RS2() const { return (float*)(ws + WS_RS2); }
    __device__ __forceinline__ float* WI() const { return (float*)(ws + WS_WI); }
    __device__ __forceinline__ float* SS2() const { return (float*)(ws + WS_SS2); }
    __device__ __forceinline__ bf16_t* WSB() const { return (bf16_t*)(ws + WS_WSB); }
    __device__ __forceinline__ bf16_t* WIN() const { return (bf16_t*)(ws + WS_WIN); }
    __device__ __forceinline__ bf16_t* WA() const { return (bf16_t*)(ws + WS_WA); }
    __device__ __forceinline__ bf16_t* WB() const { return (bf16_t*)(ws + WS_WB); }
    __device__ __forceinline__ bf16_t* WO() const { return (bf16_t*)(ws + WS_WO); }
    __device__ __forceinline__ bf16_t* W1() const { return (bf16_t*)(ws + WS_W1); }
    __device__ __forceinline__ bf16_t* W2() const { return (bf16_t*)(ws + WS_W2); }
    __device__ __forceinline__ bf16_t* XB() const { return (bf16_t*)(ws + WS_XB); }
    __device__ __forceinline__ bf16_t* MG() const { return (bf16_t*)(ws + WS_MG); }
    __device__ __forceinline__ bf16_t* U() const { return (bf16_t*)(ws + WS_U); }
    __device__ __forceinline__ bf16_t* VG() const { return (bf16_t*)(ws + WS_VG); }
    __device__ __forceinline__ bf16_t* Q() const { return (bf16_t*)(ws + WS_Q); }
    __device__ __forceinline__ bf16_t* K() const { return (bf16_t*)(ws + WS_K); }
    __device__ __forceinline__ bf16_t* V() const { return (bf16_t*)(ws + WS_V); }
    __device__ __forceinline__ bf16_t* G() const { return (bf16_t*)(ws + WS_G); }
    __device__ __forceinline__ bf16_t* X1B() const { return (bf16_t*)(ws + WS_X1B); }
    __device__ __forceinline__ bf16_t* HID() const { return (bf16_t*)(ws + WS_HID); }
    __device__ __forceinline__ unsigned short* QI() const { return (unsigned short*)(ws + WS_QI); }
    __device__ __forceinline__ unsigned short* KI() const { return (unsigned short*)(ws + WS_KI); }
    __device__ __forceinline__ unsigned long long* MASK() const { return (unsigned long long*)(ws + WS_MASK); }
};

__device__ __forceinline__ void win_group(int n0, int& src, int& nv) {
    const int pn = n0 >> 8, p = n0 & 255;
    nv = 32;
    if (pn < 4) { src = n0; }
    else if (pn < 8 || (pn >= 10 && pn < 12)) {
        const int base = (pn < 6) ? 1024 + 256 * (pn - 4) : (pn < 8) ? 1536 + 256 * (pn - 6) : 2560 + 256 * (pn - 10);
        src = base + 64 * ((p & 127) >> 5) + 32 * (p >> 7);
    } else if (pn < 10) { src = n0; }
    else if (pn == 12) {
        if (p < 32) src = 3072; else if (p < 64) { src = 3136; nv = 8; } else if (p >= 128 && p < 160) src = 3104; else { src = 0; nv = 0; }
    } else { src = 3144 + (n0 - 3328); }
}
__device__ __forceinline__ void transpose_item(const float* W, int K, int N, int src0, int nv, const float* kscale, bf16_t* WT, int dstrow0, LAS float* scr, int k0, int lane, int pitch = 0, int kdst = 0) {
    if (pitch == 0) pitch = K;
    const int c4 = (lane & 7) * 4, rr = lane >> 3;
    float ksv[8];
#pragma unroll
    for (int i = 0; i < 8; ++i) ksv[i] = kscale ? kscale[k0 + 8 * i + rr] : 1.0f;
    f32x4 v[8];
#pragma unroll
    for (int i = 0; i < 8; ++i) v[i] = (c4 < nv) ? __builtin_nontemporal_load((const f32x4*)(W + (size_t)(k0 + 8 * i + rr) * N + src0 + c4)) : (f32x4){0.f, 0.f, 0.f, 0.f};
#pragma unroll
    for (int i = 0; i < 8; ++i) { const int kk = 8 * i + rr; const float ks = ksv[i];
        scr[kk * 33 + c4] = v[i][0] * ks; scr[kk * 33 + c4 + 1] = v[i][1] * ks; scr[kk * 33 + c4 + 2] = v[i][2] * ks; scr[kk * 33 + c4 + 3] = v[i][3] * ks; }
    asm volatile("s_waitcnt lgkmcnt(0)" ::: "memory");
    const int c8 = lane & 7;
#pragma unroll
    for (int j = 0; j < 4; ++j) {
        const int n = (lane >> 3) + 8 * j; const LAS float* s = scr + (8 * c8) * 33 + n;
        u32x4 o; o.x = pk2(s[0 * 33], s[1 * 33]); o.y = pk2(s[2 * 33], s[3 * 33]); o.z = pk2(s[4 * 33], s[5 * 33]); o.w = pk2(s[6 * 33], s[7 * 33]);
        *(u32x4*)(WT + (size_t)(dstrow0 + n) * pitch + kdst + k0 + 8 * c8) = o;
    }
    asm volatile("s_waitcnt lgkmcnt(0)" ::: "memory");
}
__device__ __forceinline__ void p0_prologue(Frame& F) {
    LAS float* scr = (LAS float*)(F.lds + F.wave * 8704);
    for (int m = F.gw; m < M; m += 4 * F.ngw) {
        f32x4 v[4][4]; float ss[4];
#pragma unroll
        for (int r = 0; r < 4; ++r) { const int mr = (m + r * F.ngw < M) ? m + r * F.ngw : m; const f32x4* xr = (const f32x4*)(F.x() + (size_t)mr * D) + F.lane;
#pragma unroll
            for (int j = 0; j < 4; ++j) v[r][j] = __builtin_nontemporal_load(xr + 64 * j); }
#pragma unroll
        for (int r = 0; r < 4; ++r) { const int mr = m + r * F.ngw; if (mr < M) {
            float s2 = 0.f;
#pragma unroll
            for (int j = 0; j < 4; ++j) s2 += (v[r][j].x * v[r][j].x + v[r][j].y * v[r][j].y) + (v[r][j].z * v[r][j].z + v[r][j].w * v[r][j].w);
            ss[r] = s2;
            u32x2* o = (u32x2*)(F.XB() + (size_t)mr * D) + F.lane;
#pragma unroll
            for (int j = 0; j < 4; ++j) { u32x2 w; w.x = pk2(v[r][j].x, v[r][j].y); w.y = pk2(v[r][j].z, v[r][j].w); o[64 * j] = w; } } else ss[r] = 0.f; }
#pragma unroll
        for (int o = 1; o < 64; o <<= 1) {
#pragma unroll
            for (int r = 0; r < 4; ++r) ss[r] += __shfl_xor(ss[r], o); }
        if (F.lane == 0) {
#pragma unroll
            for (int r = 0; r < 4; ++r) { const int mr = m + r * F.ngw; if (mr < M) F.RS1()[mr] = 1.0f / sqrtf(ss[r] * (1.0f / D) + EPS); } }
    }
    constexpr int I_WIN = 16 * (NP / 32), I_WA = 8 * 32, I_WB = 8 * 32, I_WO = 16 * 32, I_W1 = 16 * 128, I_W2 = 64 * 32;
    constexpr int NITEMS = I_WIN + I_WA + I_WB + I_WO + I_W1 + I_W2;
    for (int it = F.gw; it < NITEMS; it += F.ngw) {
        int r = it;
        if (r < I_WIN) { const int nb = r % (NP / 32), kb = r / (NP / 32); int src, nv; win_group(nb * 32, src, nv);
            transpose_item(F.w_in(), 1024, DIN, src, nv, F.norm1_g(), F.WIN(), nb * 32, scr, kb * 64, F.lane); continue; } r -= I_WIN;
        if (r < I_WA) { const int nb = r % 32, kb = r / 32; transpose_item(F.w_out_a(), 512, 1024, nb * 32, 32, nullptr, F.WA(), nb * 32, scr, kb * 64, F.lane, 1024, 0); continue; } r -= I_WA;
        if (r < I_WB) { const int nb = r % 32, kb = r / 32; transpose_item(F.w_out_b(), 512, 1024, nb * 32, 32, nullptr, F.WA(), nb * 32, scr, kb * 64, F.lane, 1024, 512); continue; } r -= I_WB;
        if (r < I_WO) { const int nb = r % 32, kb = r / 32; transpose_item(F.w_o(), 1024, 1024, nb * 32, 32, nullptr, F.WO(), nb * 32, scr, kb * 64, F.lane); continue; } r -= I_WO;
        if (r < I_W1) { const int nb = r % 128, kb = r / 128; transpose_item(F.w_ff_in(), 1024, 4096, nb * 32, 32, F.norm2_g(), F.W1(), nb * 32, scr, kb * 64, F.lane); continue; } r -= I_W1;
        { const int nb = r % 32, kb = r / 32; transpose_item(F.w_ff_out(), 4096, 1024, nb * 32, 32, nullptr, F.W2(), nb * 32, scr, kb * 64, F.lane); }
    }
    const int gt = F.gw * 64 + F.lane, ngt = F.ngw * 64;
    for (int i = gt; i < SEQ * 32; i += ngt) {
        const int pos = i >> 5, j = i & 31;
        const float inv = (float)pow(10000.0, -(double)j / 32.0);
        const float ang = (float)pos * inv;
        F.COS()[i] = (float)cos((double)ang); F.SIN()[i] = (float)sin((double)ang);
    }
    for (int i = gt; i < 4 * 128 * 128; i += ngt) { const int t = (i >> 7) & 127, s = i & 127; F.WSB()[i] = (bf16_t)f2bf(s <= t ? F.w_s()[i] : 0.f); }
}

template <class Epi>
__device__ __forceinline__ void sgemm(const bf16_t* A, const bf16_t* Bt, int Mr, int N, int K, const Epi& epi, int gw, int ngw, int lane) {
    const int c = lane & 15, q = lane >> 4;
    const int ntn = (N / 256) * 4, ntiles = (Mr / 64) * ntn;
    for (int t = gw; t < ntiles; t += ngw) {
        const int tm = t / ntn, r = t % ntn, pn = r >> 2, wc = r & 3;
        const int row0 = tm * 64, col0 = pn * 256 + wc * 32;
        f32x4 acc[4][2][2];
#pragma unroll
        for (int m = 0; m < 4; ++m)
#pragma unroll
            for (int bj = 0; bj < 2; ++bj)
#pragma unroll
                for (int n = 0; n < 2; ++n) acc[m][bj][n] = (f32x4){0.f, 0.f, 0.f, 0.f};
        const bf16_t* ap = A + (size_t)(row0 + c) * K + 8 * q;
        const bf16_t* bp = Bt + (size_t)(col0 + c) * K + 8 * q;
        for (int k0 = 0; k0 < K; k0 += 32) {
            bf16x8 a[4], b[2][2];
#pragma unroll
            for (int m = 0; m < 4; ++m) a[m] = *(const bf16x8*)(ap + (size_t)(16 * m) * K + k0);
#pragma unroll
            for (int bj = 0; bj < 2; ++bj)
#pragma unroll
                for (int n = 0; n < 2; ++n) b[bj][n] = *(const bf16x8*)(bp + (size_t)(128 * bj + 16 * n) * K + k0);
#pragma unroll
            for (int m = 0; m < 4; ++m)
#pragma unroll
                for (int bj = 0; bj < 2; ++bj)
#pragma unroll
                    for (int n = 0; n < 2; ++n) acc[m][bj][n] = __builtin_amdgcn_mfma_f32_16x16x32_bf16(a[m], b[bj][n], acc[m][bj][n], 0, 0, 0);
        }
#pragma unroll
        for (int m = 0; m < 4; ++m)
#pragma unroll
            for (int n = 0; n < 2; ++n)
#pragma unroll
                for (int i = 0; i < 4; ++i) epi(row0 + 16 * m + 4 * q + i, col0 + 16 * n + c, acc[m][0][n][i], acc[m][1][n][i]);
    }
}

struct EpiProj {
    const float *RS1, *COS, *SIN; bf16_t *U, *VG, *Q, *K, *V, *G; unsigned short *QI, *KI; float* WI;
    __device__ __forceinline__ void operator()(int row, int pcol, float a0, float a1) const {
        const float rs = RS1[row]; const float v0 = a0 * rs, v1 = a1 * rs;
        const int pn = pcol >> 8, p = pcol & 255;
        if (pn < 2) { bf16_t* o = U + (size_t)row * UP + pn * 256 + p; o[0] = (bf16_t)f2bf(gelu_tanh(v0)); o[128] = (bf16_t)f2bf(gelu_tanh(v1)); }
        else if (pn < 4) { bf16_t* o = VG + (size_t)row * 512 + (pn - 2) * 256 + p; o[0] = (bf16_t)f2bf(gelu_tanh(v0)); o[128] = (bf16_t)f2bf(gelu_tanh(v1)); }
        else if (pn < 8 || pn == 10 || pn == 11) {
            const int pos = row & (SEQ - 1), d = p & 31, hit = p >> 5;
            const float cs = COS[pos * 32 + d], sn = SIN[pos * 32 + d];
            const float lo = v0 * cs - v1 * sn, hi = v1 * cs + v0 * sn;
            if (pn < 6) { bf16_t* o = Q + (size_t)row * 512 + (pn - 4) * 256 + hit * 64 + d; o[0] = (bf16_t)f2bf(lo * C2); o[32] = (bf16_t)f2bf(hi * C2); }
            else if (pn < 8) { bf16_t* o = K + (size_t)row * 512 + (pn - 6) * 256 + hit * 64 + d; o[0] = (bf16_t)f2bf(lo); o[32] = (bf16_t)f2bf(hi); }
            else { unsigned short* o = QI + (size_t)row * 512 + (pn - 10) * 256 + hit * 64 + d; o[0] = f2h(lo); o[32] = f2h(hi); }
        }
        else if (pn < 10) { bf16_t* o = V + (size_t)row * 512 + (pn - 8) * 256 + p; o[0] = (bf16_t)f2bf(v0); o[128] = (bf16_t)f2bf(v1); }
        else if (pn == 12) {
            if (p < 32) { const int pos = row & (SEQ - 1); const float cs = COS[pos * 32 + p], sn = SIN[pos * 32 + p];
                unsigned short* o = KI + (size_t)(row >> 12) * SEQ * 64; o[ki_off(pos, p)] = f2h(v0 * cs - v1 * sn); o[ki_off(pos, p + 32)] = f2h(v1 * cs + v0 * sn); }
            else if (p < 40) { WI[(size_t)row * 8 + (p - 32)] = v0 * IDX_SCALE; }
        }
        else { bf16_t* o = G + (size_t)row * 2048 + (pn - 13) * 256 + p; o[0] = (bf16_t)f2bf(sigmoidf(v0)); o[128] = (bf16_t)f2bf(sigmoidf(v1)); }
    }
};
struct EpiMergeA { const bf16_t* G; bf16_t* MG;
    __device__ __forceinline__ void operator()(int row, int col, float a0, float a1) const {
        const bf16_t* g = G + (size_t)row * 2048 + col; bf16_t* o = MG + (size_t)row * 1024 + col;
        o[0] = (bf16_t)f2bf(bf2f(g[0]) * a0); o[128] = (bf16_t)f2bf(bf2f(g[128]) * a1); } };
struct EpiMergeB { const bf16_t* G; bf16_t* MG;
    __device__ __forceinline__ void operator()(int row, int col, float a0, float a1) const {
        const bf16_t* g = G + (size_t)row * 2048 + 1024 + col; bf16_t* o = MG + (size_t)row * 1024 + col;
        o[0] = (bf16_t)f2bf(bf2f(o[0]) + bf2f(g[0]) * a0); o[128] = (bf16_t)f2bf(bf2f(o[128]) + bf2f(g[128]) * a1); } };
struct EpiWo { const float* x; float* X1; bf16_t* X1B;
    __device__ __forceinline__ void operator()(int row, int col, float a0, float a1) const {
        const size_t o = (size_t)row * 1024 + col; const float r0 = x[o] + a0, r1 = x[o + 128] + a1;
        X1[o] = r0; X1[o + 128] = r1; X1B[o] = (bf16_t)f2bf(r0); X1B[o + 128] = (bf16_t)f2bf(r1); } };
struct EpiFF1 { const float* RS2; bf16_t* H;
    __device__ __forceinline__ void operator()(int row, int col, float a0, float a1) const {
        const float rs = RS2[row]; const float h0 = fmaxf(a0 * rs, 0.f), h1 = fmaxf(a1 * rs, 0.f);
        bf16_t* o = H + (size_t)row * 4096 + col; o[0] = (bf16_t)f2bf(h0 * h0); o[128] = (bf16_t)f2bf(h1 * h1); } };
struct EpiFF2 { float* X;
    __device__ __forceinline__ void operator()(int row, int col, float a0, float a1) const {
        const size_t o = (size_t)row * 1024 + col; X[o] += a0; X[o + 128] += a1; } };

__device__ __forceinline__ void sgu_simple(Frame& F) {
    LAS float* vs = (LAS float*)F.lds;
    LAS bf16_t* wsl = (LAS bf16_t*)(F.lds + 65536);
    LAS float* st = (LAS float*)(F.lds + 65536 + 32768);
    for (int bc = blockIdx.x; bc < M / 128; bc += gridDim.x) {
        const int row0 = bc * 128;
        for (int i = 0; i < 16; ++i) {
            const int r = F.wave * 16 + i;
            const u32x4 w = *(const u32x4*)(F.VG() + (size_t)(row0 + r) * 512 + F.lane * 8);
            float v[8]; v[0] = bf2f(w.x & 0xffff); v[1] = bf2f(w.x >> 16); v[2] = bf2f(w.y & 0xffff); v[3] = bf2f(w.y >> 16);
            v[4] = bf2f(w.z & 0xffff); v[5] = bf2f(w.z >> 16); v[6] = bf2f(w.w & 0xffff); v[7] = bf2f(w.w >> 16);
            float s = 0.f;
#pragma unroll
            for (int j = 0; j < 8; ++j) s += v[j];
            const float mean = wave_sum(s) * (1.f / 512.f); float q = 0.f;
#pragma unroll
            for (int j = 0; j < 8; ++j) { const float d = v[j] - mean; q += d * d; }
            const float rstd = 1.0f / sqrtf(wave_sum(q) * (1.f / 512.f) + EPS);
            if (F.lane == 0) { st[2 * r] = mean; st[2 * r + 1] = rstd; }
        }
        __syncthreads();
        for (int g = 0; g < 4; ++g) {
            for (int idx = F.tid; idx < 16384; idx += NT) {
                const int s = idx >> 7, d = idx & 127;
                const float v = bf2f(F.VG()[(size_t)(row0 + s) * 512 + g * 128 + d]);
                vs[idx] = (v - st[2 * s]) * st[2 * s + 1] * F.ln_g()[g * 128 + d] + F.ln_b()[g * 128 + d];
                wsl[idx] = F.WSB()[g * 16384 + idx];
            }
            __syncthreads();
            for (int idx = F.tid; idx < 16384; idx += NT) {
                const int t = idx >> 7, d = idx & 127; float acc = 0.f;
                for (int s = 0; s <= t; ++s) acc += bf2f(wsl[t * 128 + s]) * vs[s * 128 + d];
                const float sf = acc + F.b_s()[g * 128 + t];
                bf16_t* u = F.U() + (size_t)(row0 + t) * UP + g * 128 + d;
                *u = (bf16_t)f2bf(bf2f(*u) * sf);
            }
            __syncthreads();
        }
    }
}

__device__ __forceinline__ void indexer_simple(Frame& F) {
    LAS float* sc = (LAS float*)F.lds;
    LAS float* qf = (LAS float*)(F.lds + 16384);
    LAS float* wl = (LAS float*)(F.lds + 16384 + 2048);
    LAS unsigned* cnt = (LAS unsigned*)(F.lds + 16384 + 2048 + 64);
    LAS unsigned* eqc = (LAS unsigned*)(F.lds + 20480);
    for (int r = blockIdx.x; r < M; r += gridDim.x) {
        const int t = r & (SEQ - 1), b = r >> 12;
        unsigned char* mrow = (unsigned char*)(F.MASK() + ((size_t)(b * 64 + (F.tid >> 3)) * SEQ + t)) + (F.tid & 7);
        if (t < 255) {
            unsigned m = 0;
#pragma unroll
            for (int i = 0; i < 8; ++i) m |= ((8 * F.tid + i) <= t) ? (1u << i) : 0u;
            *mrow = (unsigned char)m;
            continue;
        }
        qf[F.tid] = h2f(F.QI()[(size_t)r * 512 + F.tid]);
        if (F.tid < 8) wl[F.tid] = F.WI()[(size_t)r * 8 + F.tid];
        if (F.tid == 0) { cnt[0] = 0; cnt[1] = 0; }
        __syncthreads();
        for (int s = F.tid; s < SEQ; s += NT) {
            float score = 0.f;
            if (s <= t) {
                const unsigned short* kb_ = F.KI() + (size_t)b * SEQ * 64;
                float kf[64];
#pragma unroll
                for (int j = 0; j < 8; ++j) { const u32x4 w = *(const u32x4*)(kb_ + ki_off(s, 8 * j));
                    kf[8 * j + 0] = h2f(w.x & 0xffff); kf[8 * j + 1] = h2f(w.x >> 16); kf[8 * j + 2] = h2f(w.y & 0xffff); kf[8 * j + 3] = h2f(w.y >> 16);
                    kf[8 * j + 4] = h2f(w.z & 0xffff); kf[8 * j + 5] = h2f(w.z >> 16); kf[8 * j + 6] = h2f(w.w & 0xffff); kf[8 * j + 7] = h2f(w.w >> 16); }
#pragma unroll 1
                for (int h = 0; h < 8; ++h) {
                    float dot = 0.f;
#pragma unroll
                    for (int d = 0; d < 64; ++d) dot += qf[h * 64 + d] * kf[d];
                    score += wl[h] * fmaxf(dot, 0.f);
                }
            }
            sc[s] = score;
        }
        __syncthreads();
        unsigned key[8];
#pragma unroll
        for (int i = 0; i < 8; ++i) { const int s = 8 * F.tid + i; key[i] = (s <= t) ? ukey(sc[s]) : 0u; }
        unsigned lo = 1u, hi = 0xFFFFFFFFu; int it = 0;
        while (hi - lo > 1u) {
            const unsigned mid = lo + ((hi - lo) >> 1);
            unsigned c = 0;
#pragma unroll
            for (int i = 0; i < 8; ++i) c += (key[i] >= mid) ? 1u : 0u;
            c = wave_sum_u(c);
            __syncthreads();
            if (F.tid == 0) cnt[(it + 1) & 1] = 0;
            if (F.lane == 0) atomicAdd((unsigned*)&cnt[it & 1], c);
            __syncthreads();
            const unsigned tot = cnt[it & 1];
            if (tot >= 256u) lo = mid; else hi = mid;
            ++it;
        }
        const unsigned T = lo;
        unsigned cgt = 0, ceq = 0;
#pragma unroll
        for (int i = 0; i < 8; ++i) { cgt += (key[i] > T) ? 1u : 0u; ceq += (key[i] == T) ? 1u : 0u; }
        eqc[F.tid] = ceq;
        const unsigned cg = wave_sum_u(cgt);
        __syncthreads();
        if (F.tid == 0) cnt[(it + 1) & 1] = 0;
        if (F.lane == 0) atomicAdd((unsigned*)&cnt[it & 1], cg);
        __syncthreads();
        const unsigned need = 256u - cnt[it & 1];
        unsigned before = 0;
        for (int j = 0; j < F.tid; ++j) before += eqc[j];
        unsigned m = 0;
#pragma unroll
        for (int i = 0; i < 8; ++i) {
            bool sel = key[i] > T;
            if (key[i] == T) { sel = before < need; ++before; }
            m |= sel ? (1u << i) : 0u;
        }
        *mrow = (unsigned char)m;
        __syncthreads();
    }
}

__device__ __forceinline__ void attn_simple(Frame& F) {
    for (int task = F.gw; task < M * 8; task += F.ngw) {
        const int row = task >> 3, h = task & 7, t = row & (SEQ - 1), b = row >> 12;
        const float q = bf2f(F.Q()[(size_t)row * 512 + h * 64 + F.lane]);
        float m = -INFINITY, l = 0.f, acc = 0.f;
        for (int tile = 0; tile <= (t >> 6); ++tile) {
            unsigned long long w = F.MASK()[(size_t)(b * 64 + tile) * SEQ + t];
            w = (unsigned long long)(unsigned)__builtin_amdgcn_readfirstlane((unsigned)w) | ((unsigned long long)(unsigned)__builtin_amdgcn_readfirstlane((unsigned)(w >> 32)) << 32);
            while (w) {
                const int i = __builtin_ctzll(w); w &= w - 1;
                const size_t kr = (size_t)(b * SEQ + tile * 64 + i) * 512 + h * 64 + F.lane;
                const float logit = wave_sum(q * bf2f(F.K()[kr]));
                const float mn = fmaxf(m, logit), scl = __builtin_amdgcn_exp2f(m - mn), pe = __builtin_amdgcn_exp2f(logit - mn);
                l = l * scl + pe; acc = acc * scl + pe * bf2f(F.V()[kr]); m = mn;
            }
        }
        F.Q()[(size_t)row * 512 + h * 64 + F.lane] = (bf16_t)f2bf(acc / l);
    }
}

__device__ __forceinline__ void rs2_rows(Frame& F) {
    for (int m = F.gw; m < M; m += F.ngw) {
        const f32x4* xr = (const f32x4*)(F.out + (size_t)m * D) + F.lane; float s = 0.f;
#pragma unroll
        for (int j = 0; j < 4; ++j) { const f32x4 v = xr[64 * j]; s += (v.x * v.x + v.y * v.y) + (v.z * v.z + v.w * v.w); }
        s = wave_sum(s);
        if (F.lane == 0) F.RS2()[m] = 1.0f / sqrtf(s * (1.0f / D) + EPS);
        if (F.lane < 16) F.SS2()[(size_t)m * 16 + F.lane] = F.lane == 0 ? s : 0.f;
    }
}
__device__ __forceinline__ f32x4 bfx_lo4(const u32x4& w) { return (f32x4){__uint_as_float(w.x << 16), __uint_as_float(w.x & 0xffff0000u), __uint_as_float(w.y << 16), __uint_as_float(w.y & 0xffff0000u)}; }
__device__ __forceinline__ f32x4 bfx_hi4(const u32x4& w) { return (f32x4){__uint_as_float(w.z << 16), __uint_as_float(w.z & 0xffff0000u), __uint_as_float(w.w << 16), __uint_as_float(w.w & 0xffff0000u)}; }
__device__ __forceinline__ void final_norm(Frame& F) {
    const int m0 = F.evenx ? (F.vb & 7) * SEQ + (F.vb >> 3) * NWAVES + F.wave : F.gw, mst = F.evenx ? 256 : F.ngw, mend = F.evenx ? ((F.vb & 7) + 1) * SEQ : M;
    f32x4 gv[2][2];
#pragma unroll
    for (int j = 0; j < 2; ++j)
#pragma unroll
        for (int h = 0; h < 2; ++h) gv[j][h] = *((const f32x4*)F.norm_f_g() + 2 * (F.lane + 64 * j) + h);
    for (int m = m0; m < mend; m += 2 * mst) {
        const int mb = (m + mst < mend) ? m + mst : m;
        u32x4 wa[2], wb[2];
#pragma unroll
        for (int j = 0; j < 2; ++j) { wa[j] = *((const u32x4*)(F.X1B() + (size_t)m * D) + F.lane + 64 * j); wb[j] = *((const u32x4*)(F.X1B() + (size_t)mb * D) + F.lane + 64 * j); }
        f32x4 va[2][2], vb[2][2]; float sa = 0.f, sb = 0.f;
#pragma unroll
        for (int j = 0; j < 2; ++j) { va[j][0] = bfx_lo4(wa[j]); va[j][1] = bfx_hi4(wa[j]); vb[j][0] = bfx_lo4(wb[j]); vb[j][1] = bfx_hi4(wb[j]);
#pragma unroll
            for (int h = 0; h < 2; ++h) { sa += (va[j][h].x * va[j][h].x + va[j][h].y * va[j][h].y) + (va[j][h].z * va[j][h].z + va[j][h].w * va[j][h].w);
                sb += (vb[j][h].x * vb[j][h].x + vb[j][h].y * vb[j][h].y) + (vb[j][h].z * vb[j][h].z + vb[j][h].w * vb[j][h].w); } }
#pragma unroll
        for (int o = 1; o < 64; o <<= 1) { sa += __shfl_xor(sa, o); sb += __shfl_xor(sb, o); }
        const float ra = 1.0f / sqrtf(sa * (1.0f / D) + EPS), rb = 1.0f / sqrtf(sb * (1.0f / D) + EPS);
#pragma unroll
        for (int j = 0; j < 2; ++j)
#pragma unroll
            for (int h = 0; h < 2; ++h) { const f32x4 g = gv[j][h];
                *((f32x4*)(F.out + (size_t)m * D) + 2 * (F.lane + 64 * j) + h) = va[j][h] * ra * g;
                if (mb != m) *((f32x4*)(F.out + (size_t)mb * D) + 2 * (F.lane + 64 * j) + h) = vb[j][h] * rb * g; }
    }
}

typedef float f32x16 __attribute__((ext_vector_type(16)));
#ifndef DUP_MFMA
#define DUP_MFMA 0
#endif
#ifndef DUP_VALU
#define DUP_VALU 0
#endif
#ifndef DUP_LOAD
#define DUP_LOAD 0
#endif
__device__ __forceinline__ float relu1(float x) { const int b = __float_as_int(x); return __int_as_float(b > 0 ? b : 0); }
__device__ __forceinline__ float fkey(unsigned k) { return __uint_as_float((k & 0x80000000u) ? (k ^ 0x80000000u) : ~k); }
__device__ __forceinline__ void indexer_fast(Frame& F) {
    LAS float* sc = (LAS float*)F.lds;
    const int lane = F.lane, w = F.wave, c = lane & 31, hf = lane >> 5;
    const int qr = ((c >> 2) & 1) * 2 + (c >> 4), hr = (c & 3) + 4 * ((c >> 3) & 1);
#ifdef PROBE_SUB
    unsigned long long tacc_[5] = {0ull, 0ull, 0ull, 0ull, 0ull}; unsigned long long ts_ = 0;
#define TS0() do { ts_ = __builtin_amdgcn_s_memrealtime(); } while (0)
#define TS1(k) do { const unsigned long long e_ = __builtin_amdgcn_s_memrealtime(); tacc_[k] += e_ - ts_; ts_ = e_; } while (0)
#else
#define TS0() do {} while (0)
#define TS1(k) do {} while (0)
#endif
    constexpr int QIS_OFF = 131072 + 2048, WIS_OFF = QIS_OFF + 8192, TCNT_OFF = WIS_OFF + 256, HIST_OFF = TCNT_OFF + 64, HIST_WB = 608;
    LAS unsigned* tcnt = (LAS unsigned*)(F.lds + TCNT_OFF);
    if (F.tid == 0) *tcnt = 0u;
    u32x4 sa = {0u, 0u, 0u, 0u}, sw = {0u, 0u, 0u, 0u};
#define IDX_REAL(gg) ((((gg) >> 3) * 8 + 7) > 255)
#define STAGE_LOAD(gg) do { const size_t r_ = (size_t)((gg) & 7) * SEQ + (size_t)((gg) >> 3) * 8; int tq_ = F.tid; asm volatile("" : "+v"(tq_));      \
        sa = *(const u32x4*)(F.QI() + r_ * 512 + tq_ * 8); if (tq_ < 16) sw = *(const u32x4*)(F.WI() + r_ * 8 + tq_ * 4); } while (0)
#define STAGE_WRITE() do { *(LAS u32x4*)(F.lds + QIS_OFF + F.tid * 16) = sa; if (F.tid < 16) *(LAS u32x4*)(F.lds + WIS_OFF + F.tid * 16) = sw; } while (0)
#define G_OF(i) ((i) * (int)gridDim.x + (((i) & 1) ? (F.evenx ? (F.vb & 7) + 8 * (31 - (F.vb >> 3)) : (int)gridDim.x - 1 - F.vb) : F.vb))
    { int i_f = 0; while (G_OF(i_f) < BATCH * (SEQ / 8) && !IDX_REAL(G_OF(i_f))) ++i_f;
      const int gf = G_OF(i_f); if (gf < BATCH * (SEQ / 8)) { STAGE_LOAD(gf); STAGE_WRITE(); } }
    __syncthreads();
    for (int it = 0;; ++it) {
        const int g = G_OF(it); if (g >= BATCH * (SEQ / 8)) break;
        const int b = g & 7, t0 = (g >> 3) * 8, t = t0 + w;
        const size_t rowbase = (size_t)b * SEQ;
        unsigned long long myword = 0ull;
        if (t0 + 7 <= 255) {
            const int jm = t >> 6;
            myword = lane < jm ? ~0ull : (lane == jm ? ((2ull << (t & 63)) - 1ull) : 0ull);
        } else {
            TS0();
#define LOAD_WQ() float wq[2][2][8]; do { int wo_ = WIS_OFF + 64 * hf; asm volatile("" : "+v"(wo_)); \
                _Pragma("unroll") for (int s = 0; s < 2; ++s) _Pragma("unroll") for (int g2 = 0; g2 < 2; ++g2) { const LAS f32x4* wp = (const LAS f32x4*)(F.lds + wo_ + (4 * s + g2) * 32); const f32x4 a = wp[0], bb = wp[1]; \
                    wq[s][g2][0] = a[0]; wq[s][g2][1] = a[1]; wq[s][g2][2] = a[2]; wq[s][g2][3] = a[3]; wq[s][g2][4] = bb[0]; wq[s][g2][5] = bb[1]; wq[s][g2][6] = bb[2]; wq[s][g2][7] = bb[3]; } } while (0)
            f16x8 af[2][4];
#pragma unroll
            for (int s = 0; s < 2; ++s)
#pragma unroll
                for (int ks = 0; ks < 4; ++ks) af[s][ks] = *(const LAS f16x8*)(F.lds + QIS_OFF + ((4 * s + qr) * 512 + hr * 64 + 16 * ks + 8 * hf) * 2);
            const int gn = G_OF(it + 1); const bool stage_next = gn < BATCH * (SEQ / 8) && IDX_REAL(gn);
            if (stage_next) STAGE_LOAD(gn);
            const int ntile = (t0 + 8 + 31) >> 5;
            const unsigned short* kp0 = F.KI() + rowbase * 64 + lane * 8;
#define LOAD_PAIR(BUF, TB) do { _Pragma("unroll") for (int u2 = 0; u2 < 2; ++u2) { const int tl_ = (TB) + u2; const int tc_ = tl_ < ntile ? tl_ : 0; \
                _Pragma("unroll") for (int ks = 0; ks < 4; ++ks) BUF[u2][ks] = *(const f16x8*)(kp0 + (size_t)tc_ * 2048 + 512 * ks); } } while (0)
#define SCORE_PAIR(BUF, TB) do { const int tl0 = (TB), tl1 = (TB) + 1; \
                f32x16 d00 = {0.f, 0.f, 0.f, 0.f, 0.f, 0.f, 0.f, 0.f, 0.f, 0.f, 0.f, 0.f, 0.f, 0.f, 0.f, 0.f}, d01 = d00, d10 = d00, d11 = d00; \
                __builtin_amdgcn_s_setprio(1);     \
                _Pragma("unroll") for (int ks = 0; ks < 4; ++ks) { d00 = __builtin_amdgcn_mfma_f32_32x32x16_f16(af[0][ks], BUF[0][ks], d00, 0, 0, 0); d01 = __builtin_amdgcn_mfma_f32_32x32x16_f16(af[1][ks], BUF[0][ks], d01, 0, 0, 0); \
                    d10 = __builtin_amdgcn_mfma_f32_32x32x16_f16(af[0][ks], BUF[1][ks], d10, 0, 0, 0); d11 = __builtin_amdgcn_mfma_f32_32x32x16_f16(af[1][ks], BUF[1][ks], d11, 0, 0, 0); } \
                __builtin_amdgcn_s_setprio(0); \
                LOAD_WQ(); float sA[2][2], sB[2][2]; \
                _Pragma("unroll") for (int g2 = 0; g2 < 2; ++g2) { sA[0][g2] = wq[0][g2][0] * relu1(d00[8 * g2]); sA[1][g2] = wq[1][g2][0] * relu1(d01[8 * g2]); sB[0][g2] = wq[0][g2][0] * relu1(d10[8 * g2]); sB[1][g2] = wq[1][g2][0] * relu1(d11[8 * g2]); } \
                _Pragma("unroll") for (int h = 1; h < 8; ++h) _Pragma("unroll") for (int g2 = 0; g2 < 2; ++g2) { sA[0][g2] += wq[0][g2][h] * relu1(d00[8 * g2 + h]); sA[1][g2] += wq[1][g2][h] * relu1(d01[8 * g2 + h]); \
                    sB[0][g2] += wq[0][g2][h] * relu1(d10[8 * g2 + h]); sB[1][g2] += wq[1][g2][h] * relu1(d11[8 * g2 + h]); } \
                _Pragma("unroll") for (int s2 = 0; s2 < 2; ++s2) _Pragma("unroll") for (int g2 = 0; g2 < 2; ++g2) { sc[(4 * s2 + 2 * hf + g2) * 4096 + tl0 * 32 + c] = sA[s2][g2]; if (tl1 < ntile) sc[(4 * s2 + 2 * hf + g2) * 4096 + tl1 * 32 + c] = sB[s2][g2]; } } while (0)
            f16x8 kb0[2][4], kb1[2][4], kb2[2][4];
#define GRAB() ((int)__builtin_amdgcn_readfirstlane((int)(lane == 0 ? __hip_atomic_fetch_add(tcnt, 2u, __ATOMIC_RELAXED, __HIP_MEMORY_SCOPE_WORKGROUP) : 0u)))
            int p0 = GRAB(), p1, p2;
            LOAD_PAIR(kb0, p0); p1 = GRAB(); LOAD_PAIR(kb1, p1);
            for (;;) {
                p2 = GRAB(); LOAD_PAIR(kb2, p2); if (p0 >= ntile) break; SCORE_PAIR(kb0, p0);
                p0 = GRAB(); LOAD_PAIR(kb0, p0); if (p1 >= ntile) break; SCORE_PAIR(kb1, p1);
                p1 = GRAB(); LOAD_PAIR(kb1, p1); if (p2 >= ntile) break; SCORE_PAIR(kb2, p2);
            }
#undef GRAB
#undef LOAD_PAIR
#undef SCORE_PAIR
#undef LOAD_WQ
            TS1(0);
            __syncthreads();
            TS1(1);
            typedef float f32x2v __attribute__((ext_vector_type(2)));
            f32x2v sf[32];
            const int jm = t >> 6;
#pragma unroll
            for (int blk = 0; blk < 4; ++blk) {
                if (jm >= 16 * blk) {
                    float v[16];
#pragma unroll
                    for (int jj = 0; jj < 16; ++jj) v[jj] = sc[w * 4096 + (16 * blk + jj) * 64 + lane];
#pragma unroll
                    for (int jj = 0; jj < 16; ++jj) asm volatile("" : "+v"(v[jj]));
#pragma unroll
                    for (int jj = 0; jj < 16; ++jj) { const int j = 16 * blk + jj, idx = j * 64 + lane; sf[j >> 1][j & 1] = (idx <= t) ? v[jj] : -1048576.0f; }
                } else {
#pragma unroll
                    for (int jj = 0; jj < 16; ++jj) sf[(16 * blk + jj) >> 1][jj & 1] = -1048576.0f;
                }
            }
            if (F.tid == 0) *tcnt = 0u;
            if (stage_next) STAGE_WRITE();
            asm volatile("s_waitcnt lgkmcnt(0)" ::: "memory");
            __syncthreads();
#define COUNT_GE(MID, OUT) do { const unsigned pm_ = (MID) - 1u; const float pf_ = (pm_ - 0x7FFFFFFEu <= 1u) ? -7.8886091e-31f : fkey(pm_);     \
                const float cc_ = -pf_ * 1.2676506e30f; const f32x2v big_ = {1.2676506e30f, 1.2676506e30f}; \
                float q0_ = 0.f, q1_ = 0.f, q2_ = 0.f, q3_ = 0.f; \
                _Pragma("unroll") for (int blk = 0; blk < 4; ++blk) if (jm >= 16 * blk) { \
                    _Pragma("unroll") for (int pp = 0; pp < 8; pp += 2) { float t0_, t1_, t2_, t3_; \
                        asm("v_fma_f32 %0, %1, %2, %3 clamp" : "=v"(t0_) : "v"(sf[8 * blk + pp][0]), "v"(big_[0]), "v"(cc_)); asm("v_fma_f32 %0, %1, %2, %3 clamp" : "=v"(t1_) : "v"(sf[8 * blk + pp][1]), "v"(big_[0]), "v"(cc_)); \
                        asm("v_fma_f32 %0, %1, %2, %3 clamp" : "=v"(t2_) : "v"(sf[8 * blk + pp + 1][0]), "v"(big_[0]), "v"(cc_)); asm("v_fma_f32 %0, %1, %2, %3 clamp" : "=v"(t3_) : "v"(sf[8 * blk + pp + 1][1]), "v"(big_[0]), "v"(cc_)); \
                        asm("v_add_f32 %0, %0, %1" : "+v"(q0_) : "v"(t0_)); asm("v_add_f32 %0, %0, %1" : "+v"(q1_) : "v"(t1_)); asm("v_add_f32 %0, %0, %1" : "+v"(q2_) : "v"(t2_)); asm("v_add_f32 %0, %0, %1" : "+v"(q3_) : "v"(t3_)); } } \
                int cl_ = (int)((q0_ + q1_) + (q2_ + q3_)); \
                cl_ += __builtin_amdgcn_update_dpp(0, cl_, 0xB1, 0xF, 0xF, true); cl_ += __builtin_amdgcn_update_dpp(0, cl_, 0x4E, 0xF, 0xF, true);        \
                cl_ += __builtin_amdgcn_update_dpp(0, cl_, 0x141, 0xF, 0xF, true); cl_ += __builtin_amdgcn_update_dpp(0, cl_, 0x140, 0xF, 0xF, true);      \
                OUT = (unsigned)((__builtin_amdgcn_readlane(cl_, 0) + __builtin_amdgcn_readlane(cl_, 16)) + (__builtin_amdgcn_readlane(cl_, 32) + __builtin_amdgcn_readlane(cl_, 48))); } while (0)
            float mxf = -1048576.0f;
#pragma unroll
            for (int blk = 0; blk < 4; ++blk) if (jm >= 16 * blk) {
#pragma unroll
                for (int pp = 0; pp < 8; ++pp) mxf = fmaxf(mxf, fmaxf(sf[8 * blk + pp][0], sf[8 * blk + pp][1])); }
#pragma unroll
            for (int o = 1; o < 64; o <<= 1) mxf = fmaxf(mxf, __shfl_xor(mxf, o));
            const unsigned mx = (unsigned)__builtin_amdgcn_readfirstlane((int)ukey(mxf));
            unsigned lo = 1u, hi = mx + 1u; bool exact = false;
            const int sh = t >= 2048 ? 18 : (t >= 1024 ? 19 : 20);
            if (mx > (0x80000000u | (130u << sh))) {
                LAS unsigned* hw = (LAS unsigned*)(F.lds + HIST_OFF + w * HIST_WB);
                const int l15 = lane & 15;
#define HIST_PASS(SH, LOBIN, HICLAMP, ROUT, COUT, CNEXT) do { \
                    hw[lane] = 0u; hw[lane + 64] = 0u; if (lane < 24) hw[lane + 128] = 0u; \
                    const int lc_ = (LOBIN) - 1 - l15, hc_ = (HICLAMP); const int cb_ = HIST_OFF + w * HIST_WB + 4 * (16 - (LOBIN)); \
                    _Pragma("unroll") for (int blk = 0; blk < 4; ++blk) if (jm >= 16 * blk) { \
                        _Pragma("unroll") for (int pp = 0; pp < 8; ++pp) _Pragma("unroll") for (int e = 0; e < 2; ++e) { int b_ = __float_as_int(sf[8 * blk + pp][e]) >> (SH); \
                            asm("v_med3_i32 %0, %1, %2, %3" : "=v"(b_) : "v"(b_), "v"(lc_), "v"(hc_)); \
                            __hip_atomic_fetch_add((LAS unsigned*)(F.lds + ((b_ << 2) + cb_)), 1u, __ATOMIC_RELAXED, __HIP_MEMORY_SCOPE_WORKGROUP); } } \
                    asm volatile("s_waitcnt lgkmcnt(0)" ::: "memory"); \
                    const u32x2 hp_ = *(const LAS u32x2*)(hw + 16 + 2 * lane), ha_ = *(const LAS u32x2*)(hw + 144); \
                    int v_ = (int)(hp_.x + hp_.y); \
                    v_ += __builtin_amdgcn_update_dpp(0, v_, 0x101, 0xF, 0xF, true); v_ += __builtin_amdgcn_update_dpp(0, v_, 0x102, 0xF, 0xF, true);        \
                    v_ += __builtin_amdgcn_update_dpp(0, v_, 0x104, 0xF, 0xF, true); v_ += __builtin_amdgcn_update_dpp(0, v_, 0x108, 0xF, 0xF, true);        \
                    const int r1_ = __builtin_amdgcn_readlane(v_, 16), r2_ = __builtin_amdgcn_readlane(v_, 32), r3_ = __builtin_amdgcn_readlane(v_, 48); \
                    v_ += (lane < 16 ? r1_ : 0) + (lane < 32 ? r2_ : 0) + (lane < 48 ? r3_ : 0); \
                    const int se_ = v_ + (int)(ha_.x + ha_.y), so_ = se_ - (int)hp_.x;                  \
                    const unsigned long long bm_ = __ballot(se_ >= 256); \
                    if (bm_ == 0ull) { ROUT = -1; COUT = 0; } \
                    else { const int il_ = 63 - __builtin_clzll(bm_); const int e_ = __builtin_amdgcn_readlane(se_, il_), o_ = __builtin_amdgcn_readlane(so_, il_); \
                        if (o_ >= 256) { ROUT = 2 * il_ + 1; COUT = o_; CNEXT = il_ < 63 ? __builtin_amdgcn_readlane(se_, (il_ + 1) & 63) : (int)(__builtin_amdgcn_readfirstlane((int)(ha_.x + ha_.y))); } \
                        else { ROUT = 2 * il_; COUT = e_; CNEXT = o_; } } } while (0)
                const int bhi = (int)(mx & 0x7FFFFFFFu) >> sh, blo = bhi - 127;
                int r1, c1, cn1 = 0; HIST_PASS(sh, blo, bhi, r1, c1, cn1);
                if (r1 < 0) hi = 0x80000000u | ((unsigned)blo << sh);
                else if (c1 == 256) { lo = 0x80000000u | ((unsigned)(blo + r1) << sh); exact = true; }
                else { lo = 0x80000000u | ((unsigned)(blo + r1) << sh); hi = lo + (1u << sh);
                    if (c1 - cn1 <= 128) {
                        const int bstar = blo + r1; unsigned nc = 0u;
#pragma unroll
                        for (int blk = 0; blk < 4; ++blk) if (jm >= 16 * blk) {
#pragma unroll
                            for (int pp = 0; pp < 8; ++pp)
#pragma unroll
                                for (int e = 0; e < 2; ++e) { const float v = sf[8 * blk + pp][e]; const bool in = (__float_as_int(v) >> sh) == bstar; const unsigned long long bm = __ballot(in);
                                    if (bm != 0ull) { const unsigned off = nc + __builtin_amdgcn_mbcnt_hi((unsigned)(bm >> 32), __builtin_amdgcn_mbcnt_lo((unsigned)bm, 0u)); if (in) hw[off & 127u] = __float_as_uint(v); nc += (unsigned)__builtin_popcountll(bm); } } }
                        asm volatile("s_waitcnt lgkmcnt(0)" ::: "memory");
                        const float cand = lane < (int)nc ? __uint_as_float(hw[lane]) : -1048576.0f, cand1 = lane + 64 < (int)nc ? __uint_as_float(hw[lane + 64]) : -1048576.0f;
                        while (!exact && hi - lo > 1u) {
                            const unsigned mid = lo + ((hi - lo) >> 1); const float pf = fkey(mid - 1u);
                            const unsigned cnt = (unsigned)cn1 + (unsigned)__builtin_popcountll(__ballot(cand > pf)) + (unsigned)__builtin_popcountll(__ballot(cand1 > pf));
                            if (cnt == 256u) { lo = mid; exact = true; break; }
                            if (cnt > 256u) lo = mid; else hi = mid; } } }
#undef HIST_PASS
            }
            while (!exact && hi - lo > 1u) {
                const unsigned mid = lo + ((hi - lo) >> 1);
                unsigned cnt; COUNT_GE(mid, cnt);
                if (cnt == 256u) { lo = mid; exact = true; break; }
                if (cnt > 256u) lo = mid; else hi = mid;
            }
#undef COUNT_GE
            TS1(2);
            const float Tf = fkey(lo);
            int lq = lane; asm volatile("" : "+v"(lq));
            if (exact) {
                unsigned mw_lo = 0u, mw_hi = 0u;
#pragma unroll
                for (int j = 0; j < 64; ++j) { const unsigned long long m = __ballot(sf[j >> 1][j & 1] >= Tf);
                    asm("s_nop 3\n\tv_writelane_b32 %0, %2, %4\n\tv_writelane_b32 %1, %3, %4" : "+v"(mw_lo), "+v"(mw_hi) : "s"((unsigned)m), "s"((unsigned)(m >> 32)), "n"(j)); }
                myword = ((unsigned long long)mw_hi << 32) | mw_lo;
            } else {
                unsigned cgt = 0;
#pragma unroll
                for (int j = 0; j < 64; ++j) cgt += (unsigned)__builtin_popcountll(__ballot(sf[j >> 1][j & 1] > Tf));
                unsigned need = 256u - cgt;
#pragma unroll
                for (int j = 0; j < 64; ++j) { const unsigned long long gt = __ballot(sf[j >> 1][j & 1] > Tf); unsigned long long eq = __ballot(sf[j >> 1][j & 1] == Tf), take = 0ull;
                    while (need != 0u && eq != 0ull) { const unsigned long long low = eq & (0ull - eq); take |= low; eq ^= low; --need; }
                    if (lq == j) myword = gt | take; }
            }
            TS1(4);
        }
        F.MASK()[((size_t)(b * 64 + lane)) * SEQ + t] = myword;
    }
#ifdef PROBE_SUB
    { const unsigned long long d_ = tacc_[PROBE_SUB]; const unsigned long long t1_ = __builtin_amdgcn_s_memrealtime(); while (__builtin_amdgcn_s_memrealtime() - t1_ < d_) __builtin_amdgcn_s_sleep(8); }
#endif
}

__device__ __forceinline__ void sgu_fast(Frame& F) {
    constexpr int PITCH = 136, VTB = 128 * PITCH * 2;
    LAS float* part = (LAS float*)(F.lds + 2 * VTB);
    LAS float* gl = (LAS float*)(F.lds + 2 * VTB + 4096);
    const int w = F.wave, tb = w >> 1, dh = w & 1;
    if (F.tid < 128) *(LAS f32x4*)(gl + F.tid * 4) = *(const f32x4*)(F.ln_g() + F.tid * 4);
    else if (F.tid < 256) *(LAS f32x4*)(gl + 512 + (F.tid - 128) * 4) = *(const f32x4*)(F.ln_b() + (F.tid - 128) * 4);
    for (int bc = F.evenx ? (F.vb & 7) * 32 + (F.vb >> 3) : (int)blockIdx.x; bc < M / 128; bc += gridDim.x) {
        const int row0 = bc * 128;
        int tq = F.tid; asm volatile("" : "+v"(tq));
        const int lane = tq & 63, fr = lane & 15, fq = lane >> 4;
        const int p8 = tq & 7, s0 = tq >> 3;
        u32x4 raw[4][4];
#pragma unroll
        for (int g = 0; g < 4; ++g)
#pragma unroll
            for (int i = 0; i < 4; ++i) raw[g][i] = *(const u32x4*)(F.VG() + (size_t)(row0 + s0 + 64 * (i >> 1)) * 512 + g * 128 + (p8 + 8 * (i & 1)) * 8);
        u32x2 uu[2][4]; float bsv[4][2];
#define SGU_LOAD_U(gg) do { _Pragma("unroll") for (int mt = 0; mt < 2; ++mt) _Pragma("unroll") for (int nd = 0; nd < 4; ++nd) \
            uu[mt][nd] = *(const u32x2*)(F.U() + (size_t)(row0 + tb * 32 + mt * 16 + fr) * UP + (gg) * 128 + dh * 64 + nd * 16 + 4 * fq); } while (0)
#pragma unroll
        for (int g = 0; g < 4; ++g)
#pragma unroll
            for (int mt = 0; mt < 2; ++mt) bsv[g][mt] = F.b_s()[g * 128 + tb * 32 + mt * 16 + fr];
        float sm[2] = {0.f, 0.f}, sq[2] = {0.f, 0.f};
#pragma unroll
        for (int g = 0; g < 4; ++g)
#pragma unroll
            for (int i = 0; i < 4; ++i) { const u32x4 ww = raw[g][i]; const int it = i >> 1;
                const float v0 = bf2f(ww.x & 0xffff), v1 = bf2f(ww.x >> 16), v2 = bf2f(ww.y & 0xffff), v3 = bf2f(ww.y >> 16), v4 = bf2f(ww.z & 0xffff), v5 = bf2f(ww.z >> 16), v6 = bf2f(ww.w & 0xffff), v7 = bf2f(ww.w >> 16);
                sm[it] += ((v0 + v1) + (v2 + v3)) + ((v4 + v5) + (v6 + v7));
                sq[it] = fmaf(v0, v0, sq[it]); sq[it] = fmaf(v1, v1, sq[it]); sq[it] = fmaf(v2, v2, sq[it]); sq[it] = fmaf(v3, v3, sq[it]); sq[it] = fmaf(v4, v4, sq[it]); sq[it] = fmaf(v5, v5, sq[it]); sq[it] = fmaf(v6, v6, sq[it]); sq[it] = fmaf(v7, v7, sq[it]); }
        float meanv[2], rstdv[2];
#pragma unroll
        for (int it = 0; it < 2; ++it) {
#pragma unroll
            for (int o = 1; o < 8; o <<= 1) { sm[it] += __shfl_xor(sm[it], o); sq[it] += __shfl_xor(sq[it], o); }
            meanv[it] = sm[it] * (1.f / 512.f); rstdv[it] = 1.0f / sqrtf(fmaxf(sq[it] * (1.f / 512.f) - meanv[it] * meanv[it], 0.f) + EPS); }
        __syncthreads();
#pragma unroll
        for (int g = 0; g < 4; ++g) {
            LAS bf16_t* vT = (LAS bf16_t*)(F.lds + (g & 1) * VTB);
            bf16x8 wfr[4][2];
#pragma unroll
            for (int ks = 0; ks < 4; ++ks) if (ks <= tb) {
#pragma unroll
                for (int mt = 0; mt < 2; ++mt) wfr[ks][mt] = *(const bf16x8*)(F.WSB() + g * 16384 + (tb * 32 + mt * 16 + fr) * 128 + ks * 32 + 8 * fq); }
            SGU_LOAD_U(g);
#pragma unroll
            for (int i = 0; i < 4; ++i) { const int d8 = (p8 + 8 * (i & 1)) * 8, sw = (s0 + 64 * (i >> 1)) ^ (8 * p8); const u32x4 ww = raw[g][i];
                const float mean = meanv[i >> 1], rstd = rstdv[i >> 1];
                const f32x4 g0 = *(const LAS f32x4*)(gl + g * 128 + d8), g1 = *(const LAS f32x4*)(gl + g * 128 + d8 + 4), b0 = *(const LAS f32x4*)(gl + 512 + g * 128 + d8), b1 = *(const LAS f32x4*)(gl + 512 + g * 128 + d8 + 4);
                float v[8]; v[0] = bf2f(ww.x & 0xffff); v[1] = bf2f(ww.x >> 16); v[2] = bf2f(ww.y & 0xffff); v[3] = bf2f(ww.y >> 16);
                v[4] = bf2f(ww.z & 0xffff); v[5] = bf2f(ww.z >> 16); v[6] = bf2f(ww.w & 0xffff); v[7] = bf2f(ww.w >> 16);
#pragma unroll
                for (int e = 0; e < 8; ++e) { const float gg = e < 4 ? g0[e & 3] : g1[e & 3], bb = e < 4 ? b0[e & 3] : b1[e & 3];
                    vT[(d8 + e) * PITCH + sw] = (bf16_t)f2bf((v[e] - mean) * rstd * gg + bb); } }
            __syncthreads();
            f32x4 acc[4][2];
#pragma unroll
            for (int nd = 0; nd < 4; ++nd)
#pragma unroll
                for (int mt = 0; mt < 2; ++mt) acc[nd][mt] = (f32x4){0.f, 0.f, 0.f, 0.f};
#pragma unroll
            for (int ks = 0; ks < 4; ++ks) if (ks <= tb) {
                bf16x8 vf[4];
#pragma unroll
                for (int nd = 0; nd < 4; ++nd) vf[nd] = *(const LAS bf16x8*)(vT + (dh * 64 + nd * 16 + fr) * PITCH + ((ks * 32 + 8 * fq) ^ (8 * (2 * nd + (fr >> 3)))));
#pragma unroll
                for (int nd = 0; nd < 4; ++nd)
#pragma unroll
                    for (int mt = 0; mt < 2; ++mt) acc[nd][mt] = __builtin_amdgcn_mfma_f32_16x16x32_bf16(vf[nd], wfr[ks][mt], acc[nd][mt], 0, 0, 0);
            }
#pragma unroll
            for (int mt = 0; mt < 2; ++mt) { const int tl = tb * 32 + mt * 16 + fr; const float bs = bsv[g][mt];
#pragma unroll
                for (int nd = 0; nd < 4; ++nd) { bf16_t* up = F.U() + (size_t)(row0 + tl) * UP + g * 128 + dh * 64 + nd * 16 + 4 * fq;
                    const u32x2 uv = uu[mt][nd]; u32x2 o;
                    o.x = pk2(bf2f(uv.x & 0xffff) * (acc[nd][mt][0] + bs), bf2f(uv.x >> 16) * (acc[nd][mt][1] + bs));
                    o.y = pk2(bf2f(uv.y & 0xffff) * (acc[nd][mt][2] + bs), bf2f(uv.y >> 16) * (acc[nd][mt][3] + bs));
                    *(u32x2*)up = o; } }
        }
        __syncthreads();
    }
#undef SGU_LOAD_U
}

namespace pg8 {
#define PG8_LAS __attribute__((address_space(3)))
typedef unsigned short bf16_t;
typedef short bf16x8 __attribute__((ext_vector_type(8)));
typedef float f32x4 __attribute__((ext_vector_type(4)));
typedef unsigned u32x4 __attribute__((ext_vector_type(4)));
constexpr int BM = 256, BK = 64, HALF = 128, HTB = HALF * BK * 2  , STAGE_BYTES = 8 * HTB, NXCD = 8, WGM = 8;

__host__ __device__ __forceinline__ int lds_byte(int r, int c) { const int st = (r >> 4) * 2 + (c >> 5), rr = r & 15, cc = c & 31, ob = rr * 64 + cc * 2; return st * 1024 + (ob ^ (((ob >> 9) & 1) << 5)); }
__host__ __device__ __forceinline__ void stage_rc(int b, int& R, int& C) { const int st = b / 1024, sb = b % 1024, swz = sb ^ (((sb >> 9) & 1) << 5); R = (st >> 1) * 16 + swz / 64; C = (st & 1) * 32 + (swz % 64) / 2; }
__host__ __device__ __forceinline__ int perm32(int rho) { const int n = rho >> 4, i = rho & 15; return 8 * (i >> 2) + 4 * n + (i & 3); }

struct Unit { int pm, pn; };
__host__ __device__ __forceinline__ size_t hid_tile_off(int pm) {
    const size_t b = (size_t)(pm >> 4); const int j = pm & 15;
    return j < 4 ? WS_U + b * 8 * MiB + (size_t)j * 2 * MiB : j < 8 ? WS_G + b * 8 * MiB + (size_t)(j - 4) * 2 * MiB : j < 12 ? WS_MG + b * 8 * MiB + (size_t)(j - 8) * 2 * MiB
         : j < 14 ? WS_Q + b * 4 * MiB + (size_t)(j - 12) * 2 * MiB : WS_K + b * 4 * MiB + (size_t)(j - 14) * 2 * MiB;
}
struct Gemm { const bf16_t* A; const bf16_t* Bt; int M, N, K; int amap = 0; };

struct StaticOrder {
    int nM, nN, nwg, G, c;
    __host__ __device__ void init(int M, int N, int G_, int c_) { nM = M / BM; nN = N / BM; nwg = nM * nN; G = G_; c = c_; }
    __host__ __device__ bool next(int i, Unit& u) const {
        const long L = (long)i * G + c; if (L >= nwg) return false;
        int wgid = (int)L; { const int q = nwg / NXCD, r = nwg % NXCD, xcd = wgid % NXCD, off = wgid / NXCD; wgid = (xcd < r ? xcd * (q + 1) : r * (q + 1) + (xcd - r) * q) + off; }
        const int nig = WGM * nN, gid = wgid / nig, fm = gid * WGM, gsz = (nM - fm) < WGM ? (nM - fm) : WGM;
        u.pm = fm + ((wgid % nig) % gsz); u.pn = (wgid % nig) / gsz; return true;
    }
    __device__ __forceinline__ void a_ready(const Unit&) const {}
    __device__ __forceinline__ void done(const Unit&) const {}
};
template <class Epi, class Sched, bool ALIGN_EPI = false, bool SP2 = false>
__device__ __forceinline__ void gemm_phase(PG8_LAS unsigned char* lds, const Gemm g, const Sched& S, const Epi& E) {
    const int tid = threadIdx.x, wid = __builtin_amdgcn_readfirstlane(tid >> 6), lane = tid & 63, wr = wid >> 2, wc = wid & 3, fr = lane & 15, fq = lane >> 4;
    const int K = g.K, nt = K / BK;
    unsigned voffA[2], voffB[2];
#pragma unroll
    for (int i = 0; i < 2; ++i) { int R, C; stage_rc(tid * 16 + i * 8192, R, C); const int Rb = Epi::PERM ? ((R & ~31) + perm32(R & 31)) : R;
        voffA[i] = (unsigned)(R * K + C) * 2u; voffB[i] = (unsigned)(Rb * K + C) * 2u; }
    const size_t kstep = (size_t)(BK * 2);
    const size_t hstep = (size_t)HALF * K * 2;
    const size_t tstep = 2 * hstep;
    const unsigned ldsw = (unsigned)wid * 1024u;
    const int aoff = lds_byte(wr * 64 + fr, fq * 8), boff = lds_byte(wc * 32 + fr, fq * 8);
#define PG8_SA(b, h) (((b) * 2 + (h)) * HTB)
#define PG8_SB(b, h) ((4 + (b) * 2 + (h)) * HTB)
#define PG8_STAGE(bufoff, gbase, voff) do { _Pragma("unroll") for (int _i = 0; _i < 2; ++_i) \
        __builtin_amdgcn_global_load_lds((const unsigned*)((const char*)(gbase) + (voff)[_i]), (PG8_LAS unsigned*)(lds + (bufoff) + ldsw + _i * 8192), 16, 0, 0); } while (0)
#define PG8_LDA(dst, b, h) do { _Pragma("unroll") for (int m = 0; m < 4; ++m) _Pragma("unroll") for (int k = 0; k < 2; ++k) dst[m][k] = *(const PG8_LAS bf16x8*)(lds + PG8_SA(b, h) + aoff + m * 2048 + k * 1024); } while (0)
#define PG8_LDB(dst, b, h) do { _Pragma("unroll") for (int n = 0; n < 2; ++n) _Pragma("unroll") for (int k = 0; k < 2; ++k) dst[n][k] = *(const PG8_LAS bf16x8*)(lds + PG8_SB(b, h) + boff + n * 2048 + k * 1024); } while (0)
#define PG8_MMA(ai, bj, At, Bt) do { __builtin_amdgcn_s_setprio(1); _Pragma("unroll") for (int m = 0; m < 4; ++m) _Pragma("unroll") for (int n = 0; n < 2; ++n) _Pragma("unroll") for (int k = 0; k < 2; ++k) \
        acc[ai][bj][m][n] = __builtin_amdgcn_mfma_f32_16x16x32_bf16(Bt[n][k], At[m][k], acc[ai][bj][m][n], 0, 0, 0); __builtin_amdgcn_s_setprio(0); } while (0)
#define PG8_WAIT_V(n) asm volatile("s_waitcnt vmcnt(" #n ")" ::: "memory")
#define PG8_WAIT_L(n) asm volatile("s_waitcnt lgkmcnt(" #n ")" ::: "memory")
#define PG8_BAR __builtin_amdgcn_s_barrier()
#define PG8_SCHED __builtin_amdgcn_sched_barrier(0)
    Unit cur, nxt; int ui = 0;
    if (!S.next(0, cur)) return;
    f32x4 acc[2][2][4][2];
#pragma unroll
    for (int a = 0; a < 2; ++a)
#pragma unroll
        for (int b = 0; b < 2; ++b)
#pragma unroll
            for (int m = 0; m < 4; ++m)
#pragma unroll
                for (int n = 0; n < 2; ++n) acc[a][b][m][n] = (f32x4){0.f, 0.f, 0.f, 0.f};
    bf16x8 At[4][2], B0[2][2], B1[2][2];
    const char* cA = (const char*)g.A + (g.amap ? hid_tile_off(cur.pm) : (size_t)cur.pm * tstep); const char* cB = (const char*)g.Bt + (size_t)cur.pn * tstep;
    S.a_ready(cur);
    if constexpr (SP2) {
        PG8_STAGE(PG8_SB(0, 0), cB, voffB); PG8_STAGE(PG8_SB(0, 1), cB + hstep, voffB); PG8_STAGE(PG8_SA(0, 0), cA, voffA); PG8_STAGE(PG8_SA(0, 1), cA + hstep, voffA);
        if (wr == 1) PG8_BAR;
        PG8_WAIT_V(2); PG8_BAR;
        PG8_STAGE(PG8_SB(1, 0), cB + kstep, voffB); PG8_STAGE(PG8_SA(1, 0), cA + kstep, voffA); PG8_STAGE(PG8_SB(1, 1), cB + hstep + kstep, voffB);
        PG8_WAIT_V(6); PG8_BAR;
    } else {
        PG8_STAGE(PG8_SB(0, 0), cB, voffB); PG8_STAGE(PG8_SA(0, 0), cA, voffA); PG8_STAGE(PG8_SB(0, 1), cB + hstep, voffB); PG8_STAGE(PG8_SA(0, 1), cA + hstep, voffA);
        if (wr == 1) PG8_BAR;
        PG8_WAIT_V(4); PG8_BAR;
        PG8_STAGE(PG8_SB(1, 0), cB + kstep, voffB); PG8_STAGE(PG8_SA(1, 0), cA + kstep, voffA); PG8_STAGE(PG8_SB(1, 1), cB + hstep + kstep, voffB);
        PG8_WAIT_V(6); PG8_BAR;
    }
    for (;;) {
        const bool has_next = S.next(ui + 1, nxt);
        const char* nA = has_next ? (const char*)g.A + (g.amap ? hid_tile_off(nxt.pm) : (size_t)nxt.pm * tstep) : cA; const char* nB = has_next ? (const char*)g.Bt + (size_t)nxt.pn * tstep : cB;
        for (int t = 0; t < nt; t += 2) {
            if constexpr (Epi::HAS_MID) { if (t == nt / 2) E.mid(acc, cur, wr, wc, fr, fq); }
            const bool last = (t == nt - 2);
            const char* a1 = cA + (size_t)(t + 1) * kstep;
            const char* a2 = last ? nA : cA + (size_t)(t + 2) * kstep; const char* b2 = last ? nB : cB + (size_t)(t + 2) * kstep;
            const char* a3 = a2 + kstep; const char* b3 = b2 + kstep;
            if (last && has_next) S.a_ready(nxt);
            if constexpr (SP2) {
            PG8_LDB(B0, 0, 0); PG8_LDB(B1, 0, 1); PG8_SCHED; PG8_LDA(At, 0, 0); PG8_STAGE(PG8_SA(1, 1), a1 + hstep, voffA);
            PG8_WAIT_V(8); PG8_WAIT_L(0); PG8_BAR; PG8_MMA(0, 0, At, B0); PG8_MMA(0, 1, At, B1); PG8_BAR; PG8_SCHED;
            PG8_LDA(At, 0, 1); PG8_STAGE(PG8_SB(0, 0), b2, voffB); PG8_STAGE(PG8_SB(0, 1), b2 + hstep, voffB); PG8_STAGE(PG8_SA(0, 0), a2, voffA);
            PG8_WAIT_V(8); PG8_WAIT_L(0); PG8_BAR; PG8_MMA(1, 0, At, B0); PG8_MMA(1, 1, At, B1); PG8_BAR; PG8_SCHED;
            PG8_LDB(B0, 1, 0); PG8_LDB(B1, 1, 1); PG8_SCHED; PG8_LDA(At, 1, 0); PG8_STAGE(PG8_SA(0, 1), a2 + hstep, voffA);
            PG8_WAIT_V(8); PG8_WAIT_L(0); PG8_BAR; PG8_MMA(0, 0, At, B0); PG8_MMA(0, 1, At, B1); PG8_BAR; PG8_SCHED;
            PG8_LDA(At, 1, 1); PG8_STAGE(PG8_SB(1, 0), b3, voffB); PG8_STAGE(PG8_SB(1, 1), b3 + hstep, voffB); PG8_STAGE(PG8_SA(1, 0), a3, voffA);
            PG8_WAIT_V(8); PG8_WAIT_L(0); PG8_BAR; PG8_MMA(1, 0, At, B0); PG8_MMA(1, 1, At, B1); PG8_BAR; PG8_SCHED;
            } else {
            PG8_LDB(B0, 0, 0); PG8_SCHED; PG8_LDA(At, 0, 0); PG8_STAGE(PG8_SA(1, 1), a1 + hstep, voffA);
            PG8_WAIT_L(8); PG8_BAR; PG8_WAIT_L(0); PG8_MMA(0, 0, At, B0); PG8_BAR; PG8_SCHED;
            PG8_LDB(B1, 0, 1); PG8_STAGE(PG8_SB(0, 0), b2, voffB);
            PG8_BAR; PG8_WAIT_L(0); PG8_MMA(0, 1, At, B1); PG8_BAR;
            PG8_LDA(At, 0, 1); PG8_STAGE(PG8_SA(0, 0), a2, voffA);
            PG8_BAR; PG8_WAIT_L(0); PG8_MMA(1, 0, At, B0); PG8_BAR; PG8_SCHED;
            PG8_STAGE(PG8_SB(0, 1), b2 + hstep, voffB);
            PG8_WAIT_V(6); PG8_BAR; PG8_MMA(1, 1, At, B1); PG8_BAR;
            PG8_LDB(B0, 1, 0); PG8_SCHED; PG8_LDA(At, 1, 0); PG8_STAGE(PG8_SA(0, 1), a2 + hstep, voffA);
            PG8_WAIT_L(8); PG8_BAR; PG8_WAIT_L(0); PG8_MMA(0, 0, At, B0); PG8_BAR; PG8_SCHED;
            PG8_LDB(B1, 1, 1); PG8_STAGE(PG8_SB(1, 0), b3, voffB);
            PG8_BAR; PG8_WAIT_L(0); PG8_MMA(0, 1, At, B1); PG8_BAR;
            PG8_LDA(At, 1, 1); PG8_STAGE(PG8_SA(1, 0), a3, voffA);
            PG8_BAR; PG8_WAIT_L(0); PG8_MMA(1, 0, At, B0); PG8_BAR; PG8_SCHED;
            PG8_STAGE(PG8_SB(1, 1), b3 + hstep, voffB);
            PG8_WAIT_V(6); PG8_BAR; PG8_MMA(1, 1, At, B1); PG8_BAR;
            }
        }
        if constexpr (ALIGN_EPI) { if (wr == 0) PG8_BAR; }
        if constexpr (!Epi::AFTER_DRAIN) { E(acc, cur, wr, wc, fr, fq); S.done(cur); }
        if (!has_next) break;
#pragma unroll
        for (int a = 0; a < 2; ++a)
#pragma unroll
            for (int b = 0; b < 2; ++b)
#pragma unroll
                for (int m = 0; m < 4; ++m)
#pragma unroll
                    for (int n = 0; n < 2; ++n) acc[a][b][m][n] = (f32x4){0.f, 0.f, 0.f, 0.f};
        cur = nxt; cA = nA; cB = nB; ++ui;
        if constexpr (ALIGN_EPI) { if (wr == 1) PG8_BAR; }
    }
    PG8_WAIT_V(0);
    if constexpr (!ALIGN_EPI) { if (wr == 0) PG8_BAR; }
    PG8_BAR;
    if constexpr (Epi::AFTER_DRAIN) { E.fused(acc, cur, wr, wc, fr, fq, lds, wid, lane); S.done(cur); }
#undef PG8_SA
#undef PG8_SB
#undef PG8_STAGE
#undef PG8_LDA
#undef PG8_LDB
#undef PG8_MMA
#undef PG8_WAIT_V
#undef PG8_WAIT_L
#undef PG8_BAR
#undef PG8_SCHED
}
}

#define PG8_SP2 true
#define PG8_ALIGN true
namespace pg8 {
__device__ __forceinline__ unsigned cvt_pk_bf16(float lo, float hi) { unsigned r; asm volatile("v_cvt_pk_bf16_f32 %0, %1, %2" : "=v"(r) : "v"(lo), "v"(hi)); return r; }
__device__ __forceinline__ unsigned cvt_pk_f16(float lo, float hi) { const _Float16 a = (_Float16)lo, b = (_Float16)hi; return (unsigned)__builtin_bit_cast(unsigned short, a) | ((unsigned)__builtin_bit_cast(unsigned short, b) << 16); }
__device__ __forceinline__ u32x4 pack8_bf16(const f32x4& a, const f32x4& b) { u32x4 w; w.x = cvt_pk_bf16(a[0], a[1]); w.y = cvt_pk_bf16(a[2], a[3]); w.z = cvt_pk_bf16(b[0], b[1]); w.w = cvt_pk_bf16(b[2], b[3]); return w; }
__device__ __forceinline__ u32x4 pack8_f16(const f32x4& a, const f32x4& b) { u32x4 w; w.x = cvt_pk_f16(a[0], a[1]); w.y = cvt_pk_f16(a[2], a[3]); w.z = cvt_pk_f16(b[0], b[1]); w.w = cvt_pk_f16(b[2], b[3]); return w; }
__device__ __forceinline__ f32x4 bf_lo4(const u32x4& w) { return (f32x4){__uint_as_float(w.x << 16), __uint_as_float(w.x & 0xffff0000u), __uint_as_float(w.y << 16), __uint_as_float(w.y & 0xffff0000u)}; }
__device__ __forceinline__ f32x4 bf_hi4(const u32x4& w) { return (f32x4){__uint_as_float(w.z << 16), __uint_as_float(w.z & 0xffff0000u), __uint_as_float(w.w << 16), __uint_as_float(w.w & 0xffff0000u)}; }
__device__ __forceinline__ f32x4 gelu4(const f32x4& x) { f32x4 r;
#pragma unroll
    for (int i = 0; i < 4; ++i) { const float z = 1.5957691216057308f * (x[i] + 0.044715f * x[i] * x[i] * x[i]); r[i] = x[i] * __builtin_amdgcn_rcpf(1.0f + __builtin_amdgcn_exp2f(-1.4426950408889634f * z)); }
    return r; }
__device__ __forceinline__ f32x4 sigm4(const f32x4& x) { f32x4 r;
#pragma unroll
    for (int i = 0; i < 4; ++i) r[i] = __builtin_amdgcn_rcpf(1.0f + __builtin_amdgcn_exp2f(-1.4426950408889634f * x[i]));
    return r; }

struct EpiProjF {
    static constexpr bool PERM = true, AFTER_DRAIN = false, HAS_MID = false;
    unsigned char* ws; const PG8_LAS float* lrs;
    __device__ __forceinline__ float rsof(const float* RS1, int r) const { return lrs ? lrs[((r >> 11) & 1) * 256 + (r & 255)] : RS1[r]; }
    __device__ __forceinline__ void operator()(const f32x4 (&acc)[2][2][4][2], const Unit& u, int wr, int wc, int fr, int fq) const {
        const int pn = u.pn, row0 = u.pm * BM + wr * 64 + fr, cb = 32 * wc + 8 * fq;
        const float* RS1 = (const float*)(ws + WS_RS1); const float* COS = (const float*)(ws + WS_COS); const float* SIN = (const float*)(ws + WS_SIN);
        unsigned short* KI = (unsigned short*)(ws + WS_KI); float* WI = (float*)(ws + WS_WI);
        if (pn < 4 || pn == 8 || pn == 9 || pn >= 13) {
            size_t boff; int ld, colt;
            if (pn < 2) { boff = WS_U; ld = UP; colt = pn * 256; } else if (pn < 4) { boff = WS_VG; ld = 512; colt = (pn - 2) * 256; }
            else if (pn < 10) { boff = WS_V; ld = 512; colt = (pn - 8) * 256; } else { boff = WS_G; ld = 2048; colt = (pn - 13) * 256; }
            bf16_t* base = (bf16_t*)(ws + boff);
            const int act = pn < 4 ? 1 : (pn >= 13 ? 2 : 0);
#pragma unroll
            for (int ai = 0; ai < 2; ++ai)
#pragma unroll
                for (int m = 0; m < 4; ++m) { const int r = row0 + ai * HALF + m * 16; const float rs = rsof(RS1, r); bf16_t* rowp = base + (size_t)r * ld + colt + cb;
#pragma unroll
                    for (int bj = 0; bj < 2; ++bj) { f32x4 v0 = acc[ai][bj][m][0] * rs, v1 = acc[ai][bj][m][1] * rs;
                        if (act == 2) {
                            v0 = sigm4(v0) * 255.0f + 0.5f; v1 = sigm4(v1) * 255.0f + 0.5f; unsigned b[8];
#pragma unroll
                            for (int i = 0; i < 4; ++i) { b[i] = (unsigned)fminf(fmaxf(v0[i], 1.0f), 255.0f); b[4 + i] = (unsigned)fminf(fmaxf(v1[i], 1.0f), 255.0f); }
                            u32x2 w8; w8.x = b[0] | (b[1] << 8) | (b[2] << 16) | (b[3] << 24); w8.y = b[4] | (b[5] << 8) | (b[6] << 16) | (b[7] << 24);
                            *(u32x2*)((unsigned char*)base + (size_t)r * 2048 + colt + cb + bj * HALF) = w8;
                        } else {
                            if (act == 1) { v0 = gelu4(v0); v1 = gelu4(v1); }
                            *(u32x4*)(rowp + bj * HALF) = pack8_bf16(v0, v1); } } }
        } else if (pn == 12) {
            if (wc == 0) {
                const int pos0 = row0 & (SEQ - 1);
                f32x4 c0 = *(const f32x4*)(COS + pos0 * 32 + 8 * fq), c1 = *(const f32x4*)(COS + pos0 * 32 + 8 * fq + 4), s0 = *(const f32x4*)(SIN + pos0 * 32 + 8 * fq), s1 = *(const f32x4*)(SIN + pos0 * 32 + 8 * fq + 4);
                const f32x4 dc0 = *(const f32x4*)(COS + 16 * 32 + 8 * fq), dc1 = *(const f32x4*)(COS + 16 * 32 + 8 * fq + 4), ds0 = *(const f32x4*)(SIN + 16 * 32 + 8 * fq), ds1 = *(const f32x4*)(SIN + 16 * 32 + 8 * fq + 4);
#pragma unroll
                for (int ai = 0; ai < 2; ++ai) {
#pragma unroll
                    for (int m = 0; m < 4; ++m) { const int r = row0 + ai * HALF + m * 16; const float rs = rsof(RS1, r);
                        const f32x4 a0 = acc[ai][0][m][0] * rs, a1 = acc[ai][0][m][1] * rs, b0 = acc[ai][1][m][0] * rs, b1 = acc[ai][1][m][1] * rs;
                        unsigned short* rowp = KI + (size_t)(r >> 12) * SEQ * 64 + ki_off(r & (SEQ - 1), 8 * fq);
                        *(u32x4*)rowp = pack8_f16(a0 * c0 - b0 * s0, a1 * c1 - b1 * s1);
                        *(u32x4*)(rowp + 1024) = pack8_f16(b0 * c0 + a0 * s0, b1 * c1 + a1 * s1);
                        { const f32x4 t0 = c0 * dc0 - s0 * ds0, t1 = c1 * dc1 - s1 * ds1; s0 = s0 * dc0 + c0 * ds0; s1 = s1 * dc1 + c1 * ds1; c0 = t0; c1 = t1; } }
                    if (ai == 0) {
#pragma unroll
                        for (int k = 0; k < 4; ++k) { const f32x4 t0 = c0 * dc0 - s0 * ds0, t1 = c1 * dc1 - s1 * ds1; s0 = s0 * dc0 + c0 * ds0; s1 = s1 * dc1 + c1 * ds1; c0 = t0; c1 = t1; } }
                }
            } else if (wc == 1) {
                if (fq == 0) {
#pragma unroll
                    for (int ai = 0; ai < 2; ++ai)
#pragma unroll
                        for (int m = 0; m < 4; ++m) { const int r = row0 + ai * HALF + m * 16; const float rs = rsof(RS1, r) * IDX_SCALE;
                            *(f32x4*)(WI + (size_t)r * 8) = acc[ai][0][m][0] * rs; *(f32x4*)(WI + (size_t)r * 8 + 4) = acc[ai][0][m][1] * rs; }
                }
            }
        } else {
            const int kind = pn < 6 ? 0 : (pn < 8 ? 1 : 2);
            const int colt = (kind == 0 ? (pn - 4) : kind == 1 ? (pn - 6) : (pn - 10)) * 256 + 64 * wc + 8 * fq;
            unsigned short* base = (unsigned short*)(ws + (kind == 0 ? WS_Q : kind == 1 ? WS_K : WS_QI));
            const float sc = kind == 0 ? C2 : 1.0f;
            const int pos0 = row0 & (SEQ - 1);
            f32x4 c0 = *(const f32x4*)(COS + pos0 * 32 + 8 * fq), c1 = *(const f32x4*)(COS + pos0 * 32 + 8 * fq + 4), s0 = *(const f32x4*)(SIN + pos0 * 32 + 8 * fq), s1 = *(const f32x4*)(SIN + pos0 * 32 + 8 * fq + 4);
            const f32x4 dc0 = *(const f32x4*)(COS + 16 * 32 + 8 * fq), dc1 = *(const f32x4*)(COS + 16 * 32 + 8 * fq + 4), ds0 = *(const f32x4*)(SIN + 16 * 32 + 8 * fq), ds1 = *(const f32x4*)(SIN + 16 * 32 + 8 * fq + 4);
#pragma unroll
            for (int ai = 0; ai < 2; ++ai) {
#pragma unroll
                for (int m = 0; m < 4; ++m) { const int r = row0 + ai * HALF + m * 16; const float rs = rsof(RS1, r) * sc;
                    const f32x4 a0 = acc[ai][0][m][0] * rs, a1 = acc[ai][0][m][1] * rs, b0 = acc[ai][1][m][0] * rs, b1 = acc[ai][1][m][1] * rs;
                    unsigned short* rowp = base + (size_t)r * 512 + colt;
                    if (kind == 2) { *(u32x4*)rowp = pack8_f16(a0 * c0 - b0 * s0, a1 * c1 - b1 * s1); *(u32x4*)(rowp + 32) = pack8_f16(b0 * c0 + a0 * s0, b1 * c1 + a1 * s1); }
                    else { *(u32x4*)rowp = pack8_bf16(a0 * c0 - b0 * s0, a1 * c1 - b1 * s1); *(u32x4*)(rowp + 32) = pack8_bf16(b0 * c0 + a0 * s0, b1 * c1 + a1 * s1); }
                    { const f32x4 t0 = c0 * dc0 - s0 * ds0, t1 = c1 * dc1 - s1 * ds1; s0 = s0 * dc0 + c0 * ds0; s1 = s1 * dc1 + c1 * ds1; c0 = t0; c1 = t1; } }
                if (ai == 0) {
#pragma unroll
                    for (int k = 0; k < 4; ++k) { const f32x4 t0 = c0 * dc0 - s0 * ds0, t1 = c1 * dc1 - s1 * ds1; s0 = s0 * dc0 + c0 * ds0; s1 = s1 * dc1 + c1 * ds1; c0 = t0; c1 = t1; } }
            }
        }
    }
};
template <int BR> struct EpiMergeF {
    static constexpr bool PERM = true, AFTER_DRAIN = false, HAS_MID = false;
    const bf16_t* G; bf16_t* MG;
    __device__ __forceinline__ void operator()(const f32x4 (&acc)[2][2][4][2], const Unit& u, int wr, int wc, int fr, int fq) const {
        const int row0 = u.pm * BM + wr * 64 + fr, col0 = u.pn * BM + 32 * wc + 8 * fq;
#pragma unroll
        for (int ai = 0; ai < 2; ++ai)
#pragma unroll
            for (int m = 0; m < 4; ++m) { const int r = row0 + ai * HALF + m * 16; const bf16_t* gp = G + (size_t)r * 2048 + BR * 1024 + col0; bf16_t* op = MG + (size_t)r * 1024 + col0;
#pragma unroll
                for (int bj = 0; bj < 2; ++bj) { const u32x4 g = *(const u32x4*)(gp + bj * HALF);
                    f32x4 v0 = bf_lo4(g) * acc[ai][bj][m][0], v1 = bf_hi4(g) * acc[ai][bj][m][1];
                    if (BR == 1) { const u32x4 o = *(const u32x4*)(op + bj * HALF); v0 = v0 + bf_lo4(o); v1 = v1 + bf_hi4(o); }
                    *(u32x4*)(op + bj * HALF) = pack8_bf16(v0, v1); } }
    }
};
struct EpiMergeFused {
    static constexpr bool PERM = true, AFTER_DRAIN = false, HAS_MID = true;
    const unsigned char* G; bf16_t* MG;
    static __device__ __forceinline__ f32x4 ub4(unsigned w) { return (f32x4){(float)(w & 255u), (float)((w >> 8) & 255u), (float)((w >> 16) & 255u), (float)(w >> 24)}; }
    __device__ __forceinline__ void mid(f32x4 (&acc)[2][2][4][2], const Unit& u, int wr, int wc, int fr, int fq) const {
        const unsigned char* gp = G + (size_t)(u.pm * BM + wr * 64 + fr) * 2048 + (u.pn * BM + 32 * wc + 8 * fq);
#pragma unroll
        for (int ai = 0; ai < 2; ++ai) {
#pragma unroll
            for (int m = 0; m < 4; ++m) {
#pragma unroll
                for (int bj = 0; bj < 2; ++bj) { const u32x2 g0 = *(const u32x2*)(gp + bj * HALF), g1 = *(const u32x2*)(gp + 1024 + bj * HALF);
                    const f32x4 a0 = ub4(g0.x), a1 = ub4(g0.y), b0 = ub4(g1.x), b1 = ub4(g1.y); f32x4 r0, r1;
#pragma unroll
                    for (int i = 0; i < 4; ++i) { r0[i] = a0[i] * __builtin_amdgcn_rcpf(b0[i]); r1[i] = a1[i] * __builtin_amdgcn_rcpf(b1[i]); }
                    acc[ai][bj][m][0] = acc[ai][bj][m][0] * r0; acc[ai][bj][m][1] = acc[ai][bj][m][1] * r1; }
                gp += (m == 3 ? (HALF - 48) : 16) * 2048; asm volatile("" : "+v"(gp) :: "memory"); } }
    }
    __device__ __forceinline__ void operator()(const f32x4 (&acc)[2][2][4][2], const Unit& u, int wr, int wc, int fr, int fq) const {
        const int row0 = u.pm * BM + wr * 64 + fr, col0 = u.pn * BM + 32 * wc + 8 * fq;
        u32x2 gin[2][4][2];
#pragma unroll
        for (int ai = 0; ai < 2; ++ai)
#pragma unroll
            for (int m = 0; m < 4; ++m)
#pragma unroll
                for (int bj = 0; bj < 2; ++bj) gin[ai][m][bj] = *(const u32x2*)(G + (size_t)(row0 + ai * HALF + m * 16) * 2048 + 1024 + col0 + bj * HALF);
#pragma unroll
        for (int ai = 0; ai < 2; ++ai)
#pragma unroll
            for (int m = 0; m < 4; ++m) { const int r = row0 + ai * HALF + m * 16; bf16_t* op = MG + (size_t)r * 1024 + col0;
#pragma unroll
                for (int bj = 0; bj < 2; ++bj) { const u32x2 g = gin[ai][m][bj];
                    *(u32x4*)(op + bj * HALF) = pack8_bf16(ub4(g.x) * (1.0f / 255.0f) * acc[ai][bj][m][0], ub4(g.y) * (1.0f / 255.0f) * acc[ai][bj][m][1]); } }
    }
};
struct EpiWoF {
    static constexpr bool PERM = true, AFTER_DRAIN = false, HAS_MID = false;
    const bf16_t* XBF; bf16_t* X1B; float* SS2;
    __device__ __forceinline__ void operator()(const f32x4 (&acc)[2][2][4][2], const Unit& u, int wr, int wc, int fr, int fq) const {
        const int row0 = u.pm * BM + wr * 64 + fr, col0 = u.pn * BM + 32 * wc + 8 * fq;
        u32x4 xin[2][4][2];
#pragma unroll
        for (int ai = 0; ai < 2; ++ai)
#pragma unroll
            for (int m = 0; m < 4; ++m)
#pragma unroll
                for (int bj = 0; bj < 2; ++bj) xin[ai][m][bj] = *(const u32x4*)(XBF + (size_t)(row0 + ai * HALF + m * 16) * 1024 + col0 + bj * HALF);
#pragma unroll
        for (int ai = 0; ai < 2; ++ai)
#pragma unroll
            for (int m = 0; m < 4; ++m) { const int r = row0 + ai * HALF + m * 16; const size_t o = (size_t)r * 1024 + col0; float ss = 0.f;
#pragma unroll
                for (int bj = 0; bj < 2; ++bj) { const u32x4 xw = xin[ai][m][bj]; const f32x4 r0 = bf_lo4(xw) + acc[ai][bj][m][0], r1 = bf_hi4(xw) + acc[ai][bj][m][1];
                    *(u32x4*)(X1B + o + bj * HALF) = pack8_bf16(r0, r1);
                    ss += (r0[0] * r0[0] + r0[1] * r0[1]) + (r0[2] * r0[2] + r0[3] * r0[3]) + (r1[0] * r1[0] + r1[1] * r1[1]) + (r1[2] * r1[2] + r1[3] * r1[3]); }
                ss += __shfl_xor(ss, 16); ss += __shfl_xor(ss, 32);
                if (fq == 0) SS2[(size_t)r * 16 + u.pn * 4 + wc] = ss; }
    }
};
struct EpiFF1F {
    static constexpr bool PERM = true, AFTER_DRAIN = false, HAS_MID = false;
    const float* SS2; unsigned char* ws; const PG8_LAS float* lrq;
    __device__ __forceinline__ void operator()(const f32x4 (&acc)[2][2][4][2], const Unit& u, int wr, int wc, int fr, int fq) const {
        const int row0 = u.pm * BM + wr * 64 + fr, col0 = u.pn * BM + 32 * wc + 8 * fq;
#pragma unroll
        for (int ai = 0; ai < 2; ++ai)
#pragma unroll
            for (int m = 0; m < 4; ++m) { const int r = row0 + ai * HALF + m * 16; float rq;
                if (lrq) rq = lrq[((r >> 11) & 1) * 256 + (r & 255)];
                else { const f32x4* sp = (const f32x4*)(SS2 + (size_t)r * 16); const f32x4 t = (sp[0] + sp[1]) + (sp[2] + sp[3]); rq = 1.0f / (((t[0] + t[1]) + (t[2] + t[3])) * (1.0f / 1024.f) + EPS); }
                bf16_t* hp = (bf16_t*)(ws + hid_tile_off(u.pm)) + (size_t)(r - u.pm * BM) * 4096 + col0;
#pragma unroll
                for (int bj = 0; bj < 2; ++bj) { f32x4 v0 = __builtin_elementwise_max(acc[ai][bj][m][0], (f32x4){0.f, 0.f, 0.f, 0.f}), v1 = __builtin_elementwise_max(acc[ai][bj][m][1], (f32x4){0.f, 0.f, 0.f, 0.f});
                    v0 = v0 * v0 * rq; v1 = v1 * v1 * rq; *(u32x4*)(hp + bj * HALF) = pack8_bf16(v0, v1); } }
    }
};
struct EpiFF2F {
    static constexpr bool PERM = true, AFTER_DRAIN = false, HAS_MID = false;
    bf16_t* XR;
    __device__ __forceinline__ void operator()(const f32x4 (&acc)[2][2][4][2], const Unit& u, int wr, int wc, int fr, int fq) const {
        const int row0 = u.pm * BM + wr * 64 + fr, col0 = u.pn * BM + 32 * wc + 8 * fq;
        u32x4 xin[2][4][2];
#pragma unroll
        for (int ai = 0; ai < 2; ++ai)
#pragma unroll
            for (int m = 0; m < 4; ++m)
#pragma unroll
                for (int bj = 0; bj < 2; ++bj) xin[ai][m][bj] = *(const u32x4*)(XR + (size_t)(row0 + ai * HALF + m * 16) * 1024 + col0 + bj * HALF);
#pragma unroll
        for (int ai = 0; ai < 2; ++ai)
#pragma unroll
            for (int m = 0; m < 4; ++m) { bf16_t* p = XR + (size_t)(row0 + ai * HALF + m * 16) * 1024 + col0;
#pragma unroll
                for (int bj = 0; bj < 2; ++bj) { const u32x4 xr = xin[ai][m][bj];
                    *(u32x4*)(p + bj * HALF) = pack8_bf16(bf_lo4(xr) + acc[ai][bj][m][0], bf_hi4(xr) + acc[ai][bj][m][1]); } }
    }
};
}

#include <hip/hip_bf16.h>
#include <cmath>
namespace attn_body {
using bf16=__hip_bfloat16;
using bf16x8=__attribute__((ext_vector_type(8)))short;
using s16x4=__attribute__((ext_vector_type(4)))short;
using f32x16=__attribute__((ext_vector_type(16)))float;
using u32x4=__attribute__((ext_vector_type(4)))unsigned;
constexpr int BATCH=8,NHEAD=8,SEQ=4096,D=64,DM=NHEAD*D;
constexpr int NW=8,QBLK=32,QB=QBLK*NW,KVBLK=64,NQB=SEQ/QB;
constexpr int ATTN_PITCH=DM, ATTN_UNIT_ROWS=QB, OPITCH=1024;
__device__ __forceinline__ int crow(int r,int hi){return (r&3)+8*(r>>2)+4*hi;}
#define SBAR() __builtin_amdgcn_sched_barrier(0)
constexpr int NSLOT=3, SLOTB=8192;
constexpr int LDS_K=0, LDS_V=NSLOT*SLOTB, LDS_WS=2*NSLOT*SLOTB, LDS_OST=LDS_WS+NW*64*4, LDS_MASK=LDS_OST+NW*4096, LDS_BYTES=LDS_MASK+NW*768;
constexpr float C2=0.125f*1.4426950408889634f;
__device__ __forceinline__ void glds16(const void*gsrc,unsigned lds_dst){unsigned keep;
  asm volatile("s_mov_b32 %0, m0\n\ts_mov_b32 m0, %2\n\ts_nop 0\n\tglobal_load_lds_dwordx4 %1, off\n\ts_mov_b32 m0, %0":"=&s"(keep):"v"(gsrc),"s"(lds_dst):"memory");}
__device__ __forceinline__ void glds4(const void*gsrc,unsigned lds_dst){unsigned keep;
  asm volatile("s_mov_b32 %0, m0\n\ts_mov_b32 m0, %2\n\ts_nop 0\n\tglobal_load_lds_dword %1, off\n\ts_mov_b32 m0, %0":"=&s"(keep):"v"(gsrc),"s"(lds_dst):"memory");}
template<int POS> __device__ __forceinline__ float mk1t(float x,unsigned m){unsigned t;asm("v_bfe_i32 %0, %1, %2, 1":"=v"(t):"v"(m),"n"(POS));return __uint_as_float(__float_as_uint(x)&t);}
#define mk1(x,m,pos) mk1t<(pos)>((x),(m))
__device__ __forceinline__ float mk1r(float x,unsigned m,int pos){return __uint_as_float(__float_as_uint(x)&(unsigned)__builtin_amdgcn_sbfe((int)m,pos,1));}
__device__ __forceinline__ float max3f(float a,float b,float c){float r;asm("v_max3_f32 %0, %1, %2, %3":"=v"(r):"v"(a),"v"(b),"v"(c));return r;}
__device__ __forceinline__ float max2f(float a,float b){float r;asm("v_max_f32_e32 %0, %1, %2":"=v"(r):"v"(a),"v"(b));return r;}
__device__ __forceinline__ float fadd_s(float a,float b){float r;asm("v_add_f32_e32 %0, %1, %2":"=v"(r):"v"(a),"v"(b));return r;}
__device__ __forceinline__ float fsub_s(float a,float b){float r;asm("v_sub_f32_e32 %0, %1, %2":"=v"(r):"v"(a),"v"(b));return r;}
typedef float f32x2_t __attribute__((ext_vector_type(2))); typedef __bf16 bf16x2_t __attribute__((ext_vector_type(2)));
__device__ __forceinline__ unsigned cvtpk_s(float lo,float hi){f32x2_t v={lo,hi};bf16x2_t b=__builtin_convertvector(v,bf16x2_t);return __builtin_bit_cast(unsigned,b);}
#define WAIT_BAR(N) asm volatile("s_waitcnt vmcnt(" #N ") lgkmcnt(0)\n\ts_barrier":::"memory")

__device__ __forceinline__ void qkt(f32x16&p0,f32x16&p1,const char*Kslot,const bf16x8*qr,const f32x16&negm,int r32,int hi){
  const char*kb=Kslot+hi*1024+r32*16;
  #pragma unroll
  for(int d0=0;d0<4;++d0){
    const bf16x8 b0=*reinterpret_cast<const bf16x8*>(kb+d0*2048);
    const bf16x8 b1=*reinterpret_cast<const bf16x8*>(kb+d0*2048+512);
    if(d0==0){p0=__builtin_amdgcn_mfma_f32_32x32x16_bf16(b0,qr[0],negm,0,0,0);p1=__builtin_amdgcn_mfma_f32_32x32x16_bf16(b1,qr[0],negm,0,0,0);}
    else{p0=__builtin_amdgcn_mfma_f32_32x32x16_bf16(b0,qr[d0],p0,0,0,0);p1=__builtin_amdgcn_mfma_f32_32x32x16_bf16(b1,qr[d0],p1,0,0,0);}}
}
typedef __attribute__((address_space(3))) const char* lds_cptr;
typedef short v4i16_t __attribute__((ext_vector_type(4)));
__device__ __forceinline__ void kload8(bf16x8*kf,lds_cptr kp){
  kf[0]=*(const __attribute__((address_space(3))) bf16x8*)(kp);      kf[1]=*(const __attribute__((address_space(3))) bf16x8*)(kp+512);
  kf[2]=*(const __attribute__((address_space(3))) bf16x8*)(kp+2048); kf[3]=*(const __attribute__((address_space(3))) bf16x8*)(kp+2560);
  kf[4]=*(const __attribute__((address_space(3))) bf16x8*)(kp+4096); kf[5]=*(const __attribute__((address_space(3))) bf16x8*)(kp+4608);
  kf[6]=*(const __attribute__((address_space(3))) bf16x8*)(kp+6144); kf[7]=*(const __attribute__((address_space(3))) bf16x8*)(kp+6656);
}
__device__ __forceinline__ void kload2(bf16x8*kf,lds_cptr kp,int j){ kf[2*j]=*(const __attribute__((address_space(3))) bf16x8*)(kp+j*2048); kf[2*j+1]=*(const __attribute__((address_space(3))) bf16x8*)(kp+j*2048+512); }
__device__ __forceinline__ s16x4 vtr(lds_cptr p){ return __builtin_bit_cast(s16x4,__builtin_amdgcn_ds_read_tr16_b64_v4i16((__attribute__((address_space(3))) v4i16_t*)p)); }
__device__ __forceinline__ float rowmax(const f32x16&p0,const f32x16&p1){
  float a=max3f(p0[0],p0[1],p1[0]),b=max3f(p0[2],p0[3],p1[1]);a=max3f(a,p1[2],p1[3]);
  #pragma unroll
  for(int r=4;r<16;r+=4){a=max3f(a,p0[r],p0[r+1]);b=max3f(b,p0[r+2],p0[r+3]);a=max3f(a,p1[r],p1[r+1]);b=max3f(b,p1[r+2],p1[r+3]);}
  const float m=max2f(a,b);
  auto rr=__builtin_amdgcn_permlane32_swap(__float_as_uint(m),__float_as_uint(m),false,false);
  return max2f(__uint_as_float(rr[0]),__uint_as_float(rr[1]));
}
__device__ __forceinline__ void pv(f32x16*o,int vb,bf16x8 pa0,bf16x8 pa1,bf16x8 pa2,bf16x8 pa3){
  #pragma unroll
  for(int d0=0;d0<2;++d0){s16x4 lo[4],hi[4];
    #pragma unroll
    for(int ks=0;ks<4;++ks){
      asm volatile("ds_read_b64_tr_b16 %0,%1 offset:%c2":"=&v"(lo[ks]):"v"(vb),"i"(d0*4096+ks*1024):"memory");
      asm volatile("ds_read_b64_tr_b16 %0,%1 offset:%c2":"=&v"(hi[ks]):"v"(vb),"i"(d0*4096+ks*1024+512):"memory");}
    asm volatile("s_waitcnt lgkmcnt(0)":::"memory");SBAR();
    #define PK(k) (bf16x8){lo[k][0],lo[k][1],lo[k][2],lo[k][3],hi[k][0],hi[k][1],hi[k][2],hi[k][3]}
    o[d0]=__builtin_amdgcn_mfma_f32_32x32x16_bf16(pa0,PK(0),o[d0],0,0,0);
    o[d0]=__builtin_amdgcn_mfma_f32_32x32x16_bf16(pa1,PK(1),o[d0],0,0,0);
    o[d0]=__builtin_amdgcn_mfma_f32_32x32x16_bf16(pa2,PK(2),o[d0],0,0,0);
    o[d0]=__builtin_amdgcn_mfma_f32_32x32x16_bf16(pa3,PK(3),o[d0],0,0,0);
    #undef PK
  }
}

#ifndef ATTN_STORE16
#define ATTN_STORE16(p,v) (*(u32x4*)(p)=(v))
#endif
template<int THRL> __device__ __forceinline__ void attn_unit(int b,int h,int qb,const bf16*Q,const bf16*__restrict__ K,const bf16*__restrict__ V,bf16*O,const unsigned long long*MK,char*shm,
    bool pre,const bf16*Qnb){
  const int tid=threadIdx.x,lane=tid&63,r32=lane&31,hi=lane>>5; const int wid=__builtin_amdgcn_readfirstlane(tid>>6);
  const long rowbase=(long)b*SEQ; const int q0=qb*QB;
  const bf16*Qw=Q+(rowbase+q0+wid*QBLK)*DM+h*D;
  const bf16*Kh=K+rowbase*DM+h*D,*Vh=V+rowbase*DM+h*D;
  const unsigned lds0=(unsigned)(uintptr_t)shm;
  float*wsf=(float*)(shm+LDS_WS)+wid*64;
  const bf16*ksrc=Kh+(long)lane*DM+wid*8;
  const bf16*vsrc=Vh+(long)(16*(wid&3)+(lane>>2))*DM+(wid>>2)*32+(lane&3)*8;
  const unsigned kdst=lds0+LDS_K+wid*1024, vdst=lds0+LDS_V+wid*1024;
  #define DMA_K(t,slot) glds16(ksrc+(long)(t)*KVBLK*DM,(unsigned)__builtin_amdgcn_readfirstlane(kdst+(slot)))
  #define DMA_V(t,slot) glds16(vsrc+(long)(t)*KVBLK*DM,(unsigned)__builtin_amdgcn_readfirstlane(vdst+(slot)))
  const char*msrc=(const char*)MK+((size_t)b*64*SEQ+q0+wid*QBLK)*8+lane*4;
  const unsigned mdst=lds0+LDS_MASK+wid*768;
  #define DMA_M(t,slot) glds4(msrc+(size_t)(t)*SEQ*8,(unsigned)__builtin_amdgcn_readfirstlane(mdst+((slot)>>5)))
  typedef __attribute__((address_space(3))) const unsigned long long* lds_u64p;
  const lds_cptr mp0=(lds_cptr)shm+LDS_MASK+wid*768+8*r32;
  unsigned mlo,mhi;
  #define MRD(slot) do{ const unsigned long long mw_=*(lds_u64p)(mp0+((slot)>>5)); mlo=((unsigned)mw_)>>(4*hi); mhi=((unsigned)(mw_>>32))>>(4*hi); }while(0)
  const int vb0=(int)(lds0+LDS_V)+((lane>>4)&1)*32+(lane&3)*8+(4*hi+((lane&15)>>2))*64;
  const char*Kbase=shm+LDS_K; bf16x8 kf[8];
  const lds_cptr shm3=(lds_cptr)shm; const lds_cptr kp0=shm3+LDS_K+hi*1024+r32*16; const lds_cptr vp0=shm3+LDS_V+((lane>>4)&1)*32+(lane&3)*8+(4*hi+((lane&15)>>2))*64;
  const int NT=(q0+QB)/KVBLK;
  constexpr int QPRE=((LDS_BYTES+1023)/1024)*1024;
  bf16x8 qr[4];
  DMA_M(0,0);DMA_K(0,0);DMA_V(0,0);DMA_K(1,SLOTB);
  if(pre){ asm volatile("s_waitcnt vmcnt(4)":::"memory");
    #pragma unroll
    for(int d0=0;d0<4;++d0)qr[d0]=*(const __attribute__((address_space(3))) bf16x8*)(shm3+QPRE+wid*4096+r32*128+(d0*16+hi*8)*2);
  } else {
    #pragma unroll
    for(int d0=0;d0<4;++d0)qr[d0]=*reinterpret_cast<const bf16x8*>(&Qw[(long)r32*DM+d0*16+hi*8]);
  }
  float mhat=0.f,l_reg=0.f;f32x16 o[2];o[0]=f32x16{};o[1]=f32x16{};f32x16 negm=f32x16{};asm volatile("":"+v"(negm));
  const int qrel=wid*QBLK+r32;
  bool resc=false;
  #define START(P0,P1) do{ const float rm=rowmax(P0,P1); resc=false; \
    { const float dl=rm; mhat=fadd_s(mhat,dl); \
      _Pragma("unroll") for(int r=0;r<16;++r){P0[r]=fsub_s(P0[r],dl);P1[r]=fsub_s(P1[r],dl);} \
      _Pragma("unroll") for(int r=0;r<16;++r)negm[r]=-mhat; asm volatile("":"+v"(negm)); } \
    _Pragma("unroll") for(int r=0;r<16;++r)P0[r]=__builtin_amdgcn_exp2f(P0[r]); }while(0)
  #define RESC() do{ if(resc){ asm volatile("s_waitcnt lgkmcnt(0)":::"memory"); \
      _Pragma("unroll") for(int d_=0;d_<2;++d_) _Pragma("unroll") for(int r=0;r<16;++r)o[d_][r]*=wsf[crow(r,hi)]; } }while(0)
  f32x16 pA0,pA1,pB0,pB1;
  int sl_prev=0,sl_cur=0,sl_next=SLOTB;
  #define ROT() do{sl_prev=sl_cur;sl_cur=sl_next;sl_next=(sl_next==(NSLOT-1)*SLOTB)?0:sl_next+SLOTB;}while(0)
  DMA_K(2,2*SLOTB);
  WAIT_BAR(3);
  qkt(pA0,pA1,Kbase,qr,negm,r32,hi);asm volatile("s_nop 15\n\ts_nop 7":"+v"(pA0),"+v"(pA1));
  START(pA0,pA1);
  _Pragma("unroll") for(int r=0;r<16;++r)pA1[r]=__builtin_amdgcn_exp2f(pA1[r]);
  MRD(0);
  _Pragma("unroll") for(int r=0;r<16;++r){pA0[r]=mk1r(pA0[r],mlo,(r&3)+8*(r>>2));pA1[r]=mk1r(pA1[r],mhi,(r&3)+8*(r>>2));}
  WAIT_BAR(0);
  DMA_M(1,SLOTB);DMA_M(2,2*SLOTB);DMA_K(3,0);DMA_V(1,SLOTB);
  ROT();
  kload8(kf,kp0+sl_cur);
  WAIT_BAR(2);
  s16x4 vlo[8],vhi[8]; u32x4 pw0,pw1,pw2,pw3;
  #define PKW(P,B) cvtpk_s(P[B],P[B+1])
  #define PAF(k) __builtin_bit_cast(bf16x8,pw##k)
  #define VFR(i) (bf16x8){vlo[i][0],vlo[i][1],vlo[i][2],vlo[i][3],vhi[i][0],vhi[i][1],vhi[i][2],vhi[i][3]}
  #define PIN(x) asm volatile("":"+v"(x))
  #define MX3(a,b,c) __builtin_fmaxf(__builtin_fmaxf((a),(b)),(c))
  #define GAPA(MF,A0,A1,A2,A3,W0,W1,PW) do{ MF; sacc+=A0; sacc+=A1; sacc+=A2; sacc+=A3; PIN(sacc); W0; W1; PIN(PW); SBAR(); }while(0)
  #define EX(v) __builtin_amdgcn_exp2f(v)
  #define GAPB(MF,X,B,MW) do{ MF; X[B]=mk1(EX(X[B]),MW,2*(B)); X[B+1]=mk1(EX(X[B+1]),MW,2*(B)+1); X[B+2]=mk1(EX(X[B+2]),MW,2*(B)+2); X[B+3]=mk1(EX(X[B+3]),MW,2*(B)+3); PIN(X); SBAR(); }while(0)
  #define VRD(i) do{ vlo[i]=vtr(vp_+(((i)>>2)*4096+((i)&3)*1024)); vhi[i]=vtr(vp_+(((i)>>2)*4096+((i)&3)*1024+512)); }while(0)
  #define KRD(G,j) do{ if(G){ kload2(kf,kp0+sl_next,j); SBAR(); } }while(0)
  #define STEP(C0,C1,P0,P1,t,GK,GV,GL,GM) do{ SBAR(); \
    const lds_cptr vp_=vp0+sl_prev; MRD(sl_cur); \
    VRD(0); SBAR(); float sacc=(P0[0]+P0[1]); \
    GAPA(C0=__builtin_amdgcn_mfma_f32_32x32x16_bf16(kf[0],qr[0],negm,0,0,0), P0[2],P0[3],P0[4],P0[5],     pw0[0]=PKW(P0,0), pw0[1]=PKW(P0,2), pw0); \
    VRD(4); SBAR(); GAPA(C1=__builtin_amdgcn_mfma_f32_32x32x16_bf16(kf[1],qr[0],negm,0,0,0), P0[6],P0[7],P0[8],P0[9],     pw0[2]=PKW(P0,4), pw0[3]=PKW(P0,6), pw0); \
    VRD(1); SBAR(); GAPA(C0=__builtin_amdgcn_mfma_f32_32x32x16_bf16(kf[2],qr[1],C0,0,0,0),   P0[10],P0[11],P0[12],P0[13], pw1[0]=PKW(P0,8), pw1[1]=PKW(P0,10), pw1); \
    VRD(5); SBAR(); GAPA(C1=__builtin_amdgcn_mfma_f32_32x32x16_bf16(kf[3],qr[1],C1,0,0,0),   P0[14],P0[15],P1[0],P1[1],   pw1[2]=PKW(P0,12),pw1[3]=PKW(P0,14), pw1); \
    VRD(2); SBAR(); GAPA(C0=__builtin_amdgcn_mfma_f32_32x32x16_bf16(kf[4],qr[2],C0,0,0,0),   P1[2],P1[3],P1[4],P1[5],     pw2[0]=PKW(P1,0), pw2[1]=PKW(P1,2), pw2); \
    VRD(6); SBAR(); GAPA(C1=__builtin_amdgcn_mfma_f32_32x32x16_bf16(kf[5],qr[2],C1,0,0,0),   P1[6],P1[7],P1[8],P1[9],     pw2[2]=PKW(P1,4), pw2[3]=PKW(P1,6), pw2); \
    VRD(3); SBAR(); GAPA(C0=__builtin_amdgcn_mfma_f32_32x32x16_bf16(kf[6],qr[3],C0,0,0,0),   P1[10],P1[11],P1[12],P1[13], pw3[0]=PKW(P1,8), pw3[1]=PKW(P1,10), pw3); \
    VRD(7); SBAR(); GAPA(C1=__builtin_amdgcn_mfma_f32_32x32x16_bf16(kf[7],qr[3],C1,0,0,0),   P1[14],P1[15],0.f,0.f,       pw3[2]=PKW(P1,12),pw3[3]=PKW(P1,14), pw3); \
    l_reg+=sacc; \
    if(GK){DMA_K((t)+3,sl_cur);} if(GV){DMA_V((t)+1,sl_next);} if(GM){DMA_M((t)+2,sl_prev);} \
    { float a=MX3(C0[0],C0[1],C1[0]),b=MX3(C0[2],C0[3],C1[1]); a=MX3(a,C1[2],C1[3]); \
      _Pragma("unroll") for(int r=4;r<16;r+=4){a=MX3(a,C0[r],C0[r+1]);b=MX3(b,C0[r+2],C0[r+3]);a=MX3(a,C1[r],C1[r+1]);b=MX3(b,C1[r+2],C1[r+3]);} \
      float rm=__builtin_fmaxf(a,b); { auto rr=__builtin_amdgcn_permlane32_swap(__float_as_uint(rm),__float_as_uint(rm),false,false); rm=__builtin_fmaxf(__uint_as_float(rr[0]),__uint_as_float(rr[1])); } \
      resc=false; \
      if(__builtin_expect(__any(rm>(float)THRL),0)){ const float dl=__builtin_fmaxf(rm,0.f); mhat+=dl; \
        _Pragma("unroll") for(int r=0;r<16;++r){C0[r]-=dl;C1[r]-=dl;} \
        _Pragma("unroll") for(int r=0;r<16;++r)negm[r]=-mhat; asm volatile("":"+v"(negm)); \
        const float f=__builtin_amdgcn_exp2f(-dl); l_reg*=f; if(hi==0)wsf[r32]=f; resc=true; } } \
    SBAR(); \
    GAPB(o[0]=__builtin_amdgcn_mfma_f32_32x32x16_bf16(PAF(0),VFR(0),o[0],0,0,0), C0,0,mlo); \
    GAPB(o[1]=__builtin_amdgcn_mfma_f32_32x32x16_bf16(PAF(0),VFR(4),o[1],0,0,0), C0,4,mlo); \
    KRD(GL,0); GAPB(o[0]=__builtin_amdgcn_mfma_f32_32x32x16_bf16(PAF(1),VFR(1),o[0],0,0,0), C0,8,mlo); \
    KRD(GL,1); GAPB(o[1]=__builtin_amdgcn_mfma_f32_32x32x16_bf16(PAF(1),VFR(5),o[1],0,0,0), C0,12,mlo); \
    KRD(GL,2); GAPB(o[0]=__builtin_amdgcn_mfma_f32_32x32x16_bf16(PAF(2),VFR(2),o[0],0,0,0), C1,0,mhi); \
    KRD(GL,3); GAPB(o[1]=__builtin_amdgcn_mfma_f32_32x32x16_bf16(PAF(2),VFR(6),o[1],0,0,0), C1,4,mhi); \
    GAPB(o[0]=__builtin_amdgcn_mfma_f32_32x32x16_bf16(PAF(3),VFR(3),o[0],0,0,0), C1,8,mhi); \
    GAPB(o[1]=__builtin_amdgcn_mfma_f32_32x32x16_bf16(PAF(3),VFR(7),o[1],0,0,0), C1,12,mhi); \
    }while(0)
  int t=1;
  for(;t+5<NT;t+=2){
    STEP(pB0,pB1,pA0,pA1,t,true,true,true,true);     WAIT_BAR(3); RESC(); ROT();
    STEP(pA0,pA1,pB0,pB1,t+1,true,true,true,true);   WAIT_BAR(3); RESC(); ROT();
  }
  #define ENDW(tt) do{ if((tt)+3<NT){WAIT_BAR(3);} else if((tt)+2<NT){WAIT_BAR(2);} else {WAIT_BAR(0);} }while(0)
  for(;t+1<NT;t+=2){
    STEP(pB0,pB1,pA0,pA1,t,(t+3<NT),(t+1<NT),(t+1<NT),(t+2<NT));       ENDW(t);   RESC(); ROT();
    STEP(pA0,pA1,pB0,pB1,t+1,(t+4<NT),(t+2<NT),(t+2<NT),(t+3<NT));     ENDW(t+1); RESC(); ROT();
  }
  if(Qnb){ const bf16*Qn=Qnb+((long)wid*QBLK+(lane>>3))*DM+(lane&7)*8;
    #pragma unroll
    for(int i=0;i<4;++i)glds16(Qn+(long)i*8*DM,(unsigned)__builtin_amdgcn_readfirstlane(lds0+QPRE+wid*4096+i*1024)); }
  STEP(pB0,pB1,pA0,pA1,NT-1,false,false,false,false); RESC();
  { float sacc=pB0[0]+pB0[1]; _Pragma("unroll") for(int r=2;r<16;++r)sacc+=pB0[r]; _Pragma("unroll") for(int r=0;r<16;++r)sacc+=pB1[r]; l_reg+=sacc;
    pw0=(u32x4){PKW(pB0,0),PKW(pB0,2),PKW(pB0,4),PKW(pB0,6)};pw1=(u32x4){PKW(pB0,8),PKW(pB0,10),PKW(pB0,12),PKW(pB0,14)};pw2=(u32x4){PKW(pB1,0),PKW(pB1,2),PKW(pB1,4),PKW(pB1,6)};pw3=(u32x4){PKW(pB1,8),PKW(pB1,10),PKW(pB1,12),PKW(pB1,14)};
    SBAR(); pv(o,vb0+sl_cur,PAF(0),PAF(1),PAF(2),PAF(3)); }
  #undef PKW
  #undef PAF
  #undef VFR
  #undef PIN
  #undef MX3
  #undef GAPA
  #undef GAPB
  #undef EX
  #undef VRD
  #undef KRD
  #undef STEP
  #undef ENDW
  {auto rr=__builtin_amdgcn_permlane32_swap(__float_as_uint(l_reg),__float_as_uint(l_reg),false,false);l_reg=__uint_as_float(rr[0])+__uint_as_float(rr[1]);}
  if(hi==0)wsf[32+r32]=l_reg;asm volatile("s_waitcnt lgkmcnt(0)":::"memory");
  float rli[16];
  #pragma unroll
  for(int r=0;r<16;++r)rli[r]=__builtin_amdgcn_rcpf(wsf[32+crow(r,hi)]);
  bf16*Ow=O+(rowbase+q0+wid*QBLK)*OPITCH+h*D;
  { bf16*stg=(bf16*)(shm+LDS_OST)+wid*2048;
    #pragma unroll
    for(int r=0;r<16;++r){const int orow=crow(r,hi);
      #pragma unroll
      for(int d0=0;d0<2;++d0)stg[orow*64+d0*32+r32]=__float2bfloat16(o[d0][r]*rli[r]);}
    asm volatile("s_waitcnt lgkmcnt(0)":::"memory");
    #pragma unroll
    for(int i=0;i<4;++i){const int row=i*8+(lane>>3),ch=lane&7; const u32x4 v=*(const u32x4*)(stg+row*64+ch*8); ATTN_STORE16(Ow+(long)row*OPITCH+ch*8,v);} }
  asm volatile("s_waitcnt lgkmcnt(0)\n\ts_barrier":::"memory");
  #undef DMA_K
  #undef DMA_V
  #undef DMA_M
  #undef MRD
  #undef START
  #undef RESC
  #undef ROT
}
constexpr int ATTN_LDS_BYTES=LDS_BYTES;
struct AttnTensors { const bf16* Q; const bf16* K; const bf16* V; bf16* O; const unsigned long long* MK; };
struct AttnUnit { int bh; int qb; };
struct StaticOrder {
  int vcu, G;
  __device__ __forceinline__ explicit StaticOrder(int grid,int block):vcu((grid%8==0)?(block%8)*(grid/8)+block/8:block),G(grid){}
  __device__ __forceinline__ bool next(int i,AttnUnit&u)const{
    if(G==256){ if(i>=4)return false; const int s=vcu&3; u.bh=vcu>>2; u.qb=(i==0)?s:(i==1)?15-s:(i==2)?4+s:11-s; return true; }
    const int id=i*G+vcu; if(id>=BATCH*NHEAD*NQB)return false; u.bh=id/NQB; u.qb=NQB-1-(id%NQB); return true; }
  __device__ __forceinline__ void a_ready(const AttnUnit&)const{}
  __device__ __forceinline__ void done(const AttnUnit&)const{}
};
template<class Sched,int THRL=8> __device__ __forceinline__ void attn_phase(char*lds,const AttnTensors&T,const Sched&S){
  AttnUnit u;
  AttnUnit un; bool pre=false; bool has=S.next(0,u);
  for(int i=0;has;++i){ const bool hn_=S.next(i+1,un); S.a_ready(u);
    attn_unit<THRL>(u.bh/NHEAD,u.bh%NHEAD,u.qb,T.Q,T.K,T.V,T.O,T.MK,lds,pre,hn_?T.Q+((long)(un.bh/NHEAD)*SEQ+un.qb*QB)*DM+(un.bh%NHEAD)*D:nullptr); S.done(u);
    pre=hn_; u=un; has=hn_; }
}
#undef SBAR
#undef WAIT_BAR
}

#define GAS __attribute__((address_space(1)))
#define XB_TMO      128
#define XB_XCNT(j)  (256  + 64 * (j))
#define XB_XSUB(j)  (1280 + 64 * (j))
#define XB_XGEN(j)  (2304 + 64 * (j))
#define XB_TOP      3328
#define XB_TOPGEN   3392
#define XCD_BAR_WORDS 3456
#define XB_SPIN_CAP (1u << 18)

__device__ __forceinline__ unsigned xb_ld(unsigned* p)              { return __hip_atomic_load(p, __ATOMIC_RELAXED, __HIP_MEMORY_SCOPE_AGENT); }
__device__ __forceinline__ unsigned xb_add(unsigned* p, unsigned v) { return __hip_atomic_fetch_add(p, v, __ATOMIC_RELAXED, __HIP_MEMORY_SCOPE_AGENT); }
__device__ __forceinline__ unsigned xb_xcc_id() { return (unsigned)__builtin_amdgcn_s_getreg((3 << 11) | 20) & 0xFu; }
#define XB_SPIN(cond, bar) do { unsigned _sp = 0; while (cond) { __builtin_amdgcn_s_sleep(1); \
    if ((++_sp & 255u) == 0u) { if (xb_ld(&(bar)[XB_TMO])) break; if (_sp > XB_SPIN_CAP) { atomicAdd(&(bar)[XB_TMO], 1u); break; } } } } while (0)

struct XcdBarrier {
    unsigned* bar; unsigned x;
    volatile LAS unsigned* st;
};

__device__ __forceinline__ XcdBarrier xcd_barrier_post(unsigned* bar, volatile LAS unsigned* st) {
    XcdBarrier b; b.bar = bar; b.x = xb_xcc_id(); b.st = st;
    if (threadIdx.x == 0) st[2] = xb_add(&bar[XB_XCNT(b.x)], 1u);
    return b;
}
__device__ __forceinline__ void xcd_barrier_complete(unsigned* bar, unsigned x, unsigned& nloc, unsigned& nx) {
    const unsigned G = gridDim.x * gridDim.y * gridDim.z;
    unsigned sum, cnt, mine, sp = 0u;
    for (;;) {
        sum = 0u; cnt = 0u; mine = 0u;
#pragma unroll
        for (unsigned j = 0; j < 16; ++j) { const unsigned c = xb_ld(&bar[XB_XCNT(j)]); sum += c; cnt += (c > 0u) ? 1u : 0u; mine = (j == x) ? c : mine; }
        if (sum == G) break;
        __builtin_amdgcn_s_sleep(1);
        if ((++sp & 255u) == 0u) { if (xb_ld(&bar[XB_TMO])) break; if (sp > XB_SPIN_CAP) { atomicAdd(&bar[XB_TMO], 1u); break; } }
    }
    nloc = mine > 0u ? mine : 1u; nx = cnt > 0u ? cnt : 1u;
}

#define XB_LSUB(j)  (3456 + 64 * (j))
__device__ __forceinline__ void xcd_local_barrier(const XcdBarrier& b, unsigned k, unsigned nloc) {
    asm volatile("s_waitcnt vmcnt(0)" ::: "memory");
    __syncthreads();
    if (threadIdx.x == 0) {
        unsigned* bar = b.bar;
        __builtin_amdgcn_s_waitcnt(0);
        xb_add(&bar[XB_LSUB(b.x)], 1u);
        const unsigned tg = k * nloc;
        XB_SPIN(xb_ld(&bar[XB_LSUB(b.x)]) < tg, bar);
        __builtin_amdgcn_fence(__ATOMIC_ACQUIRE, "agent");
        asm volatile("s_waitcnt vmcnt(0)" ::: "memory");
    }
    __syncthreads();
}
__device__ __forceinline__ void xcd_barrier(const XcdBarrier& b) {
    asm volatile("s_waitcnt vmcnt(0)" ::: "memory");
    __syncthreads();
    if (threadIdx.x == 0) {
        unsigned* bar = b.bar;
        __builtin_amdgcn_s_waitcnt(0);
        unsigned nloc = b.st[0], nx = b.st[1];
        if (nloc == 0u) { xcd_barrier_complete(bar, b.x, nloc, nx); b.st[0] = nloc; b.st[1] = nx; }
        const unsigned old = xb_add(&bar[XB_XSUB(b.x)], 1u);
        const unsigned gen = old / nloc;
        if (old + 1u == (gen + 1u) * nloc) {
            __builtin_amdgcn_fence(__ATOMIC_RELEASE, "agent");
            asm volatile("s_waitcnt vmcnt(0)" ::: "memory");
            const unsigned og = xb_add(&bar[XB_TOP], 1u);
            const unsigned tg = og / nx;
            if (og + 1u == (tg + 1u) * nx) xb_add(&bar[XB_TOPGEN], 1u);
            else XB_SPIN(xb_ld(&bar[XB_TOPGEN]) == tg, bar);
            __builtin_amdgcn_fence(__ATOMIC_ACQUIRE, "agent");
            xb_add(&bar[XB_XGEN(b.x)], 1u);
            asm volatile("s_waitcnt vmcnt(0)" ::: "memory");
        } else {
            XB_SPIN(xb_ld(&bar[XB_XGEN(b.x)]) == gen, bar);
            __builtin_amdgcn_fence(__ATOMIC_ACQUIRE, "agent");
            asm volatile("s_waitcnt vmcnt(0)" ::: "memory");
        }
    }
    __syncthreads();
}

constexpr int LDSCTL_OFF = 131072, MISC_OFF = LDSCTL_OFF + 320, RSL_OFF = 131072 + 2048;
constexpr size_t WS_BAR = 4096 * 4;
__global__ void __launch_bounds__(NT, 2) fwd_kernel(Args args) {
    extern __shared__ __attribute__((aligned(16))) unsigned char lds[];
    Frame F;
    F.lds = (LAS unsigned char*)lds;
    F.tid = threadIdx.x; F.lane = F.tid & 63; F.wave = __builtin_amdgcn_readfirstlane(F.tid >> 6);
    F.gw = blockIdx.x * NWAVES + F.wave; F.ngw = gridDim.x * NWAVES;
    F.vb = (int)blockIdx.x; F.evenx = 0;
    F.a = &args;
    F.out = args.out; F.ws = args.ws;
    unsigned char* ws = args.ws;
    for (int u = F.tid; u < (LDS_BYTES - LDSCTL_OFF) / 4; u += NT) ((LAS unsigned*)(F.lds + LDSCTL_OFF))[u] = 0u;
    __syncthreads();
    XcdBarrier bar = xcd_barrier_post((unsigned*)(args.ws + WS_BAR), (volatile LAS unsigned*)(F.lds + MISC_OFF) + 8);
    const int lo = args.ph_lo, hi = args.ph_hi;
#define IN(k) (lo <= (k) && (k) < hi)
#ifdef PROBE_PH
    unsigned long long pt0_ = 0;
#define PB(k) do { if (PROBE_MASK & (1 << (k))) { pt0_ = __builtin_amdgcn_s_memrealtime(); } } while (0)
#define PE(k) do { if (PROBE_MASK & (1 << (k))) { const unsigned long long t1_ = __builtin_amdgcn_s_memrealtime(); const unsigned long long d_ = t1_ - pt0_; while (__builtin_amdgcn_s_memrealtime() - t1_ < d_) __builtin_amdgcn_s_sleep(8); } } while (0)
#else
#define PB(k) do {} while (0)
#define PE(k) do {} while (0)
#endif
#if USE_CG_SYNC
#define SEAM(k) do { if (IN(k) && IN((k) + 1)) { __threadfence(); cg::this_grid().sync(); } } while (0)
#else
    unsigned nlb = 0u;
#define SEAM_LOCAL(k) ((k) >= 1)
#define SEAM(k) do { if (IN(k) && IN((k) + 1)) { if (SEAM_LOCAL(k) && F.evenx) xcd_local_barrier(bar, ++nlb, 32u); else xcd_barrier(bar); } asm volatile("" : "+v"(F.tid)); F.lane = F.tid & 63; } while (0)
#endif
    PB(0); if (IN(0)) p0_prologue(F);
    SEAM(0); PE(0);
    if (lo == 0 && hi == 11) {
        volatile LAS unsigned* ms = (volatile LAS unsigned*)(F.lds + MISC_OFF) + 8;
        if (F.tid == 0) { bool ev = gridDim.x == 256u; unsigned* bw = (unsigned*)(args.ws + WS_BAR);
            for (unsigned j = 0; j < 16; ++j) { const unsigned c = xb_ld(&bw[XB_XCNT(j)]); ev = ev && (c == (j < 8u ? 32u : 0u)); }
            ms[3] = ev ? 1u : 0u; ms[4] = ev ? bar.x + 8u * ms[2] : blockIdx.x; }
        __syncthreads();
        F.evenx = __builtin_amdgcn_readfirstlane((int)ms[3]); F.vb = __builtin_amdgcn_readfirstlane((int)ms[4]);
    }
    PB(1);
#define GEMM_FAST(EPI_T, EPI_INIT, AP, BP, NN, KK) do { pg8::Gemm g{AP, BP, M, NN, KK}; pg8::StaticOrder S; S.init(M, NN, (int)gridDim.x, F.vb); EPI_T E EPI_INIT; \
        pg8::gemm_phase<EPI_T, pg8::StaticOrder, PG8_ALIGN, PG8_SP2>(F.lds, g, S, E); } while (0)
    if (IN(1)) {
#if FAST_G1
        const PG8_LAS float* lrs = nullptr;
        if (gridDim.x == 256u) { const int pm0 = 16 * (F.vb & 7) + ((F.vb >> 3) & 7); LAS float* t_ = (LAS float*)(F.lds + RSL_OFF);
            t_[F.tid] = F.RS1()[(size_t)(pm0 + 8 * (F.tid >> 8)) * 256 + (F.tid & 255)]; __syncthreads(); lrs = (const PG8_LAS float*)t_; }
        GEMM_FAST(pg8::EpiProjF, ({F.ws, lrs}), F.XB(), F.WIN(), NP, 1024);
#else
        EpiProj E{F.RS1(), F.COS(), F.SIN(), F.U(), F.VG(), F.Q(), F.K(), F.V(), F.G(), F.QI(), F.KI(), F.WI()}; sgemm(F.XB(), F.WIN(), M, NP, 1024, E, F.gw, F.ngw, F.lane);
#endif
    }
    SEAM(1); PE(1); PB(2);
    if (IN(2)) {
#if FAST_SGU
        PB(11); sgu_fast(F); PE(11);
#else
        sgu_simple(F);
#endif
        __syncthreads();
#if FAST_IDX
        PB(12); indexer_fast(F); PE(12);
#else
        indexer_simple(F);
#endif
    }
    SEAM(2); PE(2); PB(3);
    if (IN(3)) {
#if FAST_ATTN
        const attn_body::AttnTensors AT{(const attn_body::bf16*)F.Q(), (const attn_body::bf16*)F.K(), (const attn_body::bf16*)F.V(), (attn_body::bf16*)(F.U() + 512), F.MASK()};
        const attn_body::StaticOrder S((int)gridDim.x, F.vb);
        attn_body::attn_phase<attn_body::StaticOrder>((char*)lds, AT, S);
#else
        attn_simple(F);
#endif
    }
    SEAM(3); PE(3); PB(4);
#if FAST_MERGE
    if (IN(4)) { GEMM_FAST(pg8::EpiMergeFused, ({(const unsigned char*)F.G(), F.MG()}), F.U(), F.WA(), 1024, 1024); }
#else
    if (IN(4)) { EpiMergeA E{F.G(), F.XB()}; sgemm(F.U(), F.WA(), M, 1024, 512, E, F.gw, F.ngw, F.lane); }
    SEAM(4);
    if (IN(5)) { EpiMergeB E{F.G(), F.XB()}; sgemm(F.Q(), F.WB(), M, 1024, 512, E, F.gw, F.ngw, F.lane); }
#endif
    SEAM(5); PE(4); PB(6);
    if (IN(6)) {
#if FAST_WO
        GEMM_FAST(pg8::EpiWoF, ({F.XB(), F.X1B(), F.SS2()}), F.MG(), F.WO(), 1024, 1024);
#else
        EpiWo E{F.x(), F.out, F.X1B()}; sgemm(F.XB(), F.WO(), M, 1024, 1024, E, F.gw, F.ngw, F.lane);
#endif
    }
    SEAM(6); PE(6); PB(8);
#if !(FAST_WO && FAST_FF1)
    if (IN(7)) rs2_rows(F);
    SEAM(7);
#endif
    if (IN(8)) {
#if FAST_FF1
        const PG8_LAS float* lrq = nullptr;
        if (gridDim.x == 256u) { const int pm0 = 16 * (F.vb & 7) + ((F.vb >> 3) & 7); LAS float* t_ = (LAS float*)(F.lds + RSL_OFF);
            const f32x4* sp = (const f32x4*)(F.SS2() + ((size_t)(pm0 + 8 * (F.tid >> 8)) * 256 + (F.tid & 255)) * 16); const f32x4 q_ = (sp[0] + sp[1]) + (sp[2] + sp[3]);
            t_[F.tid] = 1.0f / (((q_[0] + q_[1]) + (q_[2] + q_[3])) * (1.0f / 1024.f) + EPS); __syncthreads(); lrq = (const PG8_LAS float*)t_; }
        GEMM_FAST(pg8::EpiFF1F, ({F.SS2(), F.ws, lrq}), F.X1B(), F.W1(), 4096, 1024);
#else
        EpiFF1 E{F.RS2(), F.HID()}; sgemm(F.X1B(), F.W1(), M, 4096, 1024, E, F.gw, F.ngw, F.lane);
#endif
    }
    SEAM(8); PE(8); PB(9);
    if (IN(9)) {
#if FAST_FF2
        { pg8::Gemm g{(const pg8::bf16_t*)F.ws, F.W2(), M, 1024, 4096, 1}; pg8::StaticOrder S; S.init(M, 1024, (int)gridDim.x, F.vb); pg8::EpiFF2F E{F.X1B()};
          pg8::gemm_phase<pg8::EpiFF2F, pg8::StaticOrder, PG8_ALIGN, PG8_SP2>(F.lds, g, S, E); }
#else
        EpiFF2 E{F.out}; sgemm(F.HID(), F.W2(), M, 1024, 4096, E, F.gw, F.ngw, F.lane);
#endif
    }
    SEAM(9); PE(9); PB(10);
    if (IN(10)) final_norm(F);
    PE(10);
#undef SEAM
#undef IN
}

extern "C" void kernel_launch(void* const* d_in, const int* in_sizes, int n_in, void* d_out, int out_size, void* d_ws, size_t ws_size, hipStream_t stream) {
    static int grid = 0;
    if (grid == 0) {
        if (n_in != 14 || out_size != M * D || ws_size < WS_END) { fprintf(stderr, "kernel_launch: unexpected shapes (n_in %d out %d ws %zu)\n", n_in, out_size, ws_size); grid = -1; return; }
        int dev = 0, cus = 0, per_cu = 0;
        hipGetDevice(&dev); hipDeviceGetAttribute(&cus, hipDeviceAttributeMultiprocessorCount, dev);
        hipFuncSetAttribute((const void*)fwd_kernel, hipFuncAttributeMaxDynamicSharedMemorySize, LDS_BYTES);
        hipOccupancyMaxActiveBlocksPerMultiprocessor(&per_cu, (const void*)fwd_kernel, NT, LDS_BYTES);
        if (per_cu < 1) { fprintf(stderr, "kernel_launch: occupancy query says %d blocks per CU\n", per_cu); per_cu = 1; }
        (void)hipGetLastError();
        grid = cus * (per_cu < 1 ? 1 : 1);
    }
    if (grid < 0) return;
    Args a{};
    for (int i = 0; i < 14; ++i) a.in[i] = (const float*)d_in[i];
    a.out = (float*)d_out; a.ws = (unsigned char*)d_ws;
#if ONE_LAUNCH
    hipMemsetAsync((char*)d_ws + WS_CTL, 0, 64 * 1024, stream);
    a.ph_lo = 0; a.ph_hi = 11;
    void* kargs[] = {&a};
    hipError_t e = hipLaunchCooperativeKernel((const void*)fwd_kernel, dim3(grid), dim3(NT), kargs, LDS_BYTES, stream);
    if (e != hipSuccess) fprintf(stderr, "cooperative launch failed: %s (grid %d)\n", hipGetErrorString(e), grid);
#else
    for (int ph = 0; ph <= 10; ++ph) {
        a.ph_lo = ph; a.ph_hi = ph + 1;
        hipLaunchKernelGGL(fwd_kernel, dim3(grid), dim3(NT), LDS_BYTES, stream, a);
    }
#endif
}
```
